# Optimizing an MI355X kernel written in HIP

```python
import math
import jax, jax.numpy as jnp
from jax import lax
import numpy as np

D_MODEL = 1024
BATCH = 8
SEQ = 2048
DEPTH = 1
DEC_BATCH = 128
DEC_SEQ = 4
PAST_LEN = 16384
PAGE_SIZE = 128

M_HEADS = 16
M_HEAD_DIM = 64
M_INNER = M_HEADS * M_HEAD_DIM
M_GROUPS = 4
M_STATE = 128
M_CONV = 4
M_CONV_DIM = M_INNER + 2 * M_GROUPS * M_STATE
M_CHUNK = 64
M_DT_MIN = 0.001
M_DT_MAX = 0.1
H_HEADS = 8
H_KEY = 128
H_VAL = 128
H_QK = H_HEADS * H_KEY
H_INNER = H_HEADS * H_VAL
H_CHUNK = 32
D_FF = 2816
ALPHA = (2.0 * DEPTH) ** 0.25
BETA = (8.0 * DEPTH) ** -0.25
EPS = 1e-5
F32 = jnp.float32
_IN_SIZES = (M_INNER, M_CONV_DIM, M_HEADS, H_QK, H_QK, H_INNER, H_INNER, D_MODEL, D_MODEL)
IN_COLS = sum(_IN_SIZES)

kernel_name = 'hybrid_ssd_hgrn2_macaron_deepnorm_step'


def _split_points():
    pts, acc = [], 0
    for s in _IN_SIZES[:-1]:
        acc += s
        pts.append(acc)
    return pts


def _tm(t):
    return jnp.moveaxis(t, 1, 0)


def _layer_norm(x, g, b):
    xf = x.astype(F32)
    mu = jnp.mean(xf, -1, keepdims=True)
    var = jnp.mean(jnp.square(xf - mu), -1, keepdims=True)
    return ((xf - mu) * lax.rsqrt(var + EPS) * g.astype(F32) + b.astype(F32)).astype(x.dtype)


def _swiglu(x, wg, wu, wd):
    return (jax.nn.silu(x @ wg) * (x @ wu)) @ wd


def _causal_conv(u, buf, w, b):
    length = u.shape[1]
    up = jnp.concatenate([buf.astype(u.dtype), u], axis=1)
    out = b + sum(up[:, k:k + length] * w[k] for k in range(M_CONV))
    return jax.nn.silu(out), up[:, length:]


def _gated_rmsnorm(y, z, w):
    g = y * jax.nn.silu(z.astype(F32))
    gg = g.reshape(g.shape[:-1] + (M_GROUPS, M_INNER // M_GROUPS))
    gg = gg * lax.rsqrt(jnp.mean(gg * gg, -1, keepdims=True) + EPS)
    return gg.reshape(g.shape) * w.astype(F32)


def _ssd(xh, dt, a, b_in, c_in, h0):
    bsz, length = xh.shape[:2]
    csz = math.gcd(length, M_CHUNK)
    nc = length // csz
    rep = M_HEADS // M_GROUPS
    x = xh.reshape(bsz, nc, csz, M_GROUPS, rep, M_HEAD_DIM)
    dt = dt.reshape(bsz, nc, csz, M_GROUPS, rep)
    bm = b_in.reshape(bsz, nc, csz, M_GROUPS, M_STATE)
    cm = c_in.reshape(bsz, nc, csz, M_GROUPS, M_STATE)
    a_cum = jnp.cumsum(dt * a.reshape(M_GROUPS, rep), axis=2)
    causal = jnp.tril(jnp.ones((csz, csz), dtype=bool))[:, :, None, None]
    seg = a_cum[:, :, :, None] - a_cum[:, :, None, :]
    decay = jnp.exp(jnp.where(causal, seg, -jnp.inf))
    cb = jnp.einsum('bctgn,bcsgn->bctsg', cm, bm)
    w_ts = cb[..., None] * decay * dt[:, :, None]
    y_intra = jnp.einsum('bctsgr,bcsgrp->bctgrp', w_ts, x)
    a_last = a_cum[:, :, -1]
    to_end = jnp.exp(a_last[:, :, None] - a_cum) * dt
    chunk_states = jnp.einsum('bcsgn,bcsgrp->bcgrpn', bm, x * to_end[..., None])

    def step(h, inp):
        dec, st, c_c, acum_c = inp
        y_c = jnp.einsum('btgn,bgrpn->btgrp', c_c, h) * jnp.exp(acum_c)[..., None]
        return dec[..., None, None] * h + st, y_c

    h_init = h0.reshape(bsz, M_GROUPS, rep, M_HEAD_DIM, M_STATE)
    h_fin, y_inter = lax.scan(step, h_init, (_tm(jnp.exp(a_last)), _tm(chunk_states), _tm(cm), _tm(a_cum)))
    y = y_intra + _tm(y_inter)
    return y.reshape(bsz, length, M_HEADS, M_HEAD_DIM), h_fin.reshape(bsz, M_HEADS, M_HEAD_DIM, M_STATE)


def _hgrn2(q, log_f, k, v, s0):
    bsz, length = q.shape[:2]
    csz = math.gcd(length, H_CHUNK)
    nc = length // csz
    shp_k = (bsz, nc, csz, H_HEADS, H_KEY)
    q = q.reshape(shp_k)
    log_f = log_f.reshape(shp_k)
    k = k.reshape(shp_k)
    v = v.reshape(bsz, nc, csz, H_HEADS, H_VAL)
    b_cum = jnp.cumsum(log_f, axis=2)
    qd = q * jnp.exp(b_cum)
    kd = k * jnp.exp(-b_cum)
    causal = jnp.tril(jnp.ones((csz, csz), dtype=bool))
    scores = jnp.where(causal, jnp.einsum('bcthk,bcshk->bchts', qd, kd), 0.0)
    y_intra = jnp.einsum('bchts,bcshv->bcthv', scores, v)
    b_last = b_cum[:, :, -1]
    k_end = k * jnp.exp(b_last[:, :, None] - b_cum)

    def step(s, inp):
        dec, ke_c, v_c, qd_c = inp
        y_c = jnp.einsum('bthk,bhkv->bthv', qd_c, s)
        s_new = dec[..., None] * s + jnp.einsum('bshk,bshv->bhkv', ke_c, v_c)
        return s_new, y_c

    s_fin, y_inter = lax.scan(step, s0, (_tm(jnp.exp(b_last)), _tm(k_end), _tm(v), _tm(qd)))
    y = y_intra + _tm(y_inter)
    return y.reshape(bsz, length, H_HEADS, H_VAL), s_fin


def _layer(x, conv_buf, ssm_h, hgrn_s, lb, w):
    (f1_wg, f1_wu, f1_wd, ln1_g, ln1_b, w_in, conv_w, conv_b, dt_bias, a_log, d_skip, m_norm_w, w_m_out,
     h_norm_w, w_h_out, w_o, ln2_g, ln2_b, f2_wg, f2_wu, f2_wd, ln3_g, ln3_b) = w
    dtype = x.dtype
    bsz, length, _ = x.shape
    x = _layer_norm(ALPHA * x + 0.5 * _swiglu(x, f1_wg, f1_wu, f1_wd), ln1_g, ln1_b)
    proj = x @ w_in
    z, xbc, dt_raw, q, f_raw, i_in, og, gate_m, gate_h = jnp.split(proj, _split_points(), axis=-1)
    xbc, new_conv = _causal_conv(xbc, conv_buf, conv_w, conv_b)
    xm, b_in, c_in = jnp.split(xbc.astype(F32), [M_INNER, M_INNER + M_GROUPS * M_STATE], axis=-1)
    xm = xm.reshape(bsz, length, M_HEADS, M_HEAD_DIM)
    dt = jax.nn.softplus(dt_raw.astype(F32) + dt_bias.astype(F32))
    a = -jnp.exp(a_log.astype(F32))
    y_ssd, new_h = _ssd(xm, dt, a, b_in.reshape(bsz, length, M_GROUPS, M_STATE),
                        c_in.reshape(bsz, length, M_GROUPS, M_STATE), ssm_h.astype(F32))
    y_m = y_ssd + d_skip.astype(F32)[:, None] * xm
    y_m = _gated_rmsnorm(y_m.reshape(bsz, length, M_INNER), z, m_norm_w).astype(dtype) @ w_m_out
    fr = f_raw.astype(F32)
    log_f = jnp.log(lb + (1.0 - lb) * jax.nn.sigmoid(fr))
    k = (1.0 - lb) * jax.nn.sigmoid(-fr)
    o, new_s = _hgrn2(q.astype(F32).reshape(bsz, length, H_HEADS, H_KEY),
                      log_f.reshape(bsz, length, H_HEADS, H_KEY),
                      k.reshape(bsz, length, H_HEADS, H_KEY),
                      i_in.astype(F32).reshape(bsz, length, H_HEADS, H_VAL), hgrn_s.astype(F32))
    o = o * lax.rsqrt(jnp.mean(o * o, -1, keepdims=True) + EPS)
    o = o.reshape(bsz, length, H_INNER) * h_norm_w.astype(F32) * jax.nn.silu(og.astype(F32))
    y_h = o.astype(dtype) @ w_h_out
    mix = jax.nn.sigmoid(gate_m) * y_m + jax.nn.sigmoid(gate_h) * y_h
    x = _layer_norm(ALPHA * x + mix @ w_o, ln2_g, ln2_b)
    x = _layer_norm(ALPHA * x + 0.5 * _swiglu(x, f2_wg, f2_wu, f2_wd), ln3_g, ln3_b)
    return x, new_conv.astype(conv_buf.dtype), new_h.astype(ssm_h.dtype), new_s.astype(hgrn_s.dtype)


def setup_inputs(seed: int = 0) -> dict:
    key = jax.random.key(seed)
    ks = iter(jax.random.split(key, 48))

    def nrm(shape, scale):
        return scale * jax.random.normal(next(ks), shape, F32)

    L = DEPTH
    dt0 = jnp.exp(jax.random.uniform(next(ks), (L, M_HEADS), F32, math.log(M_DT_MIN), math.log(M_DT_MAX)))
    dt_bias = dt0 + jnp.log(-jnp.expm1(-dt0))
    a_log = jnp.log(jax.random.uniform(next(ks), (L, M_HEADS), F32, 1.0, 16.0))
    return {
        'x_prompt': nrm((BATCH, SEQ, D_MODEL), 1.0),
        'x_sample': nrm((DEC_BATCH, DEC_SEQ, D_MODEL), 1.0),
        'state_conv': nrm((L, DEC_BATCH, M_CONV - 1, M_CONV_DIM), 1.0),
        'state_ssm': nrm((L, DEC_BATCH, M_HEADS, M_HEAD_DIM, M_STATE), 0.3),
        'state_hgrn': nrm((L, DEC_BATCH, H_HEADS, H_KEY, H_VAL), 0.3),
        'ffn1_w_gate': nrm((L, D_MODEL, D_FF), D_MODEL ** -0.5),
        'ffn1_w_up': nrm((L, D_MODEL, D_FF), D_MODEL ** -0.5),
        'ffn1_w_down': nrm((L, D_FF, D_MODEL), BETA * D_FF ** -0.5),
        'ln1_g': 1.0 + nrm((L, D_MODEL), 0.02),
        'ln1_b': nrm((L, D_MODEL), 0.01),
        'w_in': nrm((L, D_MODEL, IN_COLS), D_MODEL ** -0.5),
        'conv_w': nrm((L, M_CONV, M_CONV_DIM), M_CONV ** -0.5),
        'conv_b': nrm((L, M_CONV_DIM), 0.01),
        'dt_bias': dt_bias,
        'a_log': a_log,
        'd_skip': 1.0 + nrm((L, M_HEADS), 0.1),
        'm_norm_w': 1.0 + nrm((L, M_INNER), 0.02),
        'w_m_out': nrm((L, M_INNER, D_MODEL), BETA * M_INNER ** -0.5),
        'hgrn_lb_param': nrm((L + 1, H_QK), 0.1),
        'h_norm_w': 1.0 + nrm((L, H_INNER), 0.02),
        'w_h_out': nrm((L, H_INNER, D_MODEL), BETA * H_INNER ** -0.5),
        'w_o': nrm((L, D_MODEL, D_MODEL), BETA * D_MODEL ** -0.5),
        'ln2_g': 1.0 + nrm((L, D_MODEL), 0.02),
        'ln2_b': nrm((L, D_MODEL), 0.01),
        'ffn2_w_gate': nrm((L, D_MODEL, D_FF), D_MODEL ** -0.5),
        'ffn2_w_up': nrm((L, D_MODEL, D_FF), D_MODEL ** -0.5),
        'ffn2_w_down': nrm((L, D_FF, D_MODEL), BETA * D_FF ** -0.5),
        'ln3_g': 1.0 + nrm((L, D_MODEL), 0.02),
        'ln3_b': nrm((L, D_MODEL), 0.01),
    }


def reference(x_prompt, x_sample, state_conv, state_ssm, state_hgrn,
              ffn1_w_gate, ffn1_w_up, ffn1_w_down, ln1_g, ln1_b, w_in, conv_w, conv_b, dt_bias, a_log,
              d_skip, m_norm_w, w_m_out, hgrn_lb_param, h_norm_w, w_h_out, w_o, ln2_g, ln2_b,
              ffn2_w_gate, ffn2_w_up, ffn2_w_down, ln3_g, ln3_b):
    lb_all = jnp.cumsum(jax.nn.softmax(hgrn_lb_param.astype(F32), axis=0), axis=0)
    bp = x_prompt.shape[0]
    xp, xs = x_prompt, x_sample
    conv_p, ssm_p, hg_p, conv_s, ssm_s, hg_s = [], [], [], [], [], []
    for l in range(DEPTH):
        w = (ffn1_w_gate[l], ffn1_w_up[l], ffn1_w_down[l], ln1_g[l], ln1_b[l], w_in[l], conv_w[l], conv_b[l],
             dt_bias[l], a_log[l], d_skip[l], m_norm_w[l], w_m_out[l], h_norm_w[l], w_h_out[l], w_o[l],
             ln2_g[l], ln2_b[l], ffn2_w_gate[l], ffn2_w_up[l], ffn2_w_down[l], ln3_g[l], ln3_b[l])
        lb = lb_all[l]
        zc = jnp.zeros((bp, M_CONV - 1, M_CONV_DIM), state_conv.dtype)
        zh = jnp.zeros((bp, M_HEADS, M_HEAD_DIM, M_STATE), state_ssm.dtype)
        zs = jnp.zeros((bp, H_HEADS, H_KEY, H_VAL), state_hgrn.dtype)
        xp, cp, sp, hp = _layer(xp, zc, zh, zs, lb, w)
        xs, cs, ss, hs = _layer(xs, state_conv[l], state_ssm[l], state_hgrn[l], lb, w)
        conv_p.append(cp); ssm_p.append(sp); hg_p.append(hp)
        conv_s.append(cs); ssm_s.append(ss); hg_s.append(hs)
    return (xp, xs, jnp.stack(conv_p), jnp.stack(ssm_p), jnp.stack(hg_p),
            jnp.stack(conv_s), jnp.stack(ssm_s), jnp.stack(hg_s))
```

```cpp
#include <hip/hip_runtime.h>
#include <cstdio>
#include <cstdint>
#define MK_N_LAUNCHES 1
namespace pg8 {
#define PG8_LAS __attribute__((address_space(3)))
typedef unsigned short bf16_t;
typedef short bf16x8 __attribute__((ext_vector_type(8)));
typedef float f32x4 __attribute__((ext_vector_type(4)));
typedef unsigned u32x4 __attribute__((ext_vector_type(4)));
typedef unsigned u32x2 __attribute__((ext_vector_type(2)));
constexpr int BM = 256, BK = 64, HALF = 128, HTB = HALF * BK * 2  , STAGE_BYTES = 8 * HTB, NXCD = 8, WGM = 8;

__host__ __device__ __forceinline__ int lds_byte(int r, int c) { const int st = (r >> 4) * 2 + (c >> 5), rr = r & 15, cc = c & 31, ob = rr * 64 + cc * 2; return st * 1024 + (ob ^ (((ob >> 9) & 1) << 5)); }
__host__ __device__ __forceinline__ void stage_rc(int b, int& R, int& C) { const int st = b / 1024, sb = b % 1024, swz = sb ^ (((sb >> 9) & 1) << 5); R = (st >> 1) * 16 + swz / 64; C = (st & 1) * 32 + (swz % 64) / 2; }
__host__ __device__ __forceinline__ int perm32(int rho) { const int n = rho >> 4, i = rho & 15; return 8 * (i >> 2) + 4 * n + (i & 3); }

struct Unit { int pm, pn; };
struct Gemm { const bf16_t* A; const bf16_t* Bt; int M, N, K, lda; };

struct StaticOrder {
    int nM, nN, nwg, G, c;
    __host__ __device__ void init(int M, int N, int G_, int c_) { nM = M / BM; nN = N / BM; nwg = nM * nN; G = G_; c = c_; }
    __host__ __device__ bool next(int i, Unit& u) const {
        const long L = (long)i * G + c; if (L >= nwg) return false;
        int wgid = (int)L; { const int q = nwg / NXCD, r = nwg % NXCD, xcd = wgid % NXCD, off = wgid / NXCD; wgid = (xcd < r ? xcd * (q + 1) : r * (q + 1) + (xcd - r) * q) + off; }
        const int nig = WGM * nN, gid = wgid / nig, fm = gid * WGM, gsz = (nM - fm) < WGM ? (nM - fm) : WGM;
        u.pm = fm + ((wgid % nig) % gsz); u.pn = (wgid % nig) / gsz; return true;
    }
};

__device__ __forceinline__ unsigned cvt_pk_bf16(float lo, float hi) { unsigned r; asm volatile("v_cvt_pk_bf16_f32 %0, %1, %2" : "=v"(r) : "v"(lo), "v"(hi)); return r; }

template <class Epi, class Sched, bool ALIGN_EPI = false, bool SP2 = false>
__device__ __forceinline__ void gemm_phase(PG8_LAS unsigned char* lds, const Gemm g, const Sched& S, const Epi& E) {
    const int tid = threadIdx.x, wid = __builtin_amdgcn_readfirstlane(tid >> 6), lane = tid & 63, wr = wid >> 2, wc = wid & 3, fr = lane & 15, fq = lane >> 4;
    const int K = g.K, nt = K / BK, lda = g.lda;
    unsigned voffA[2], voffB[2];
#pragma unroll
    for (int i = 0; i < 2; ++i) { int R, C; stage_rc(tid * 16 + i * 8192, R, C); const int Rb = Epi::PERM ? ((R & ~31) + perm32(R & 31)) : R;
        voffA[i] = (unsigned)(R * lda + C) * 2u; voffB[i] = (unsigned)(Rb * K + C) * 2u; }
    const size_t kstep = (size_t)(BK * 2);
    const size_t hstepA = (size_t)HALF * lda * 2, hstepB = (size_t)HALF * K * 2;
    const size_t tstepA = 2 * hstepA, tstepB = 2 * hstepB;
    const unsigned ldsw = (unsigned)wid * 1024u;
    const int aoff = lds_byte(wr * 64 + fr, fq * 8), boff = lds_byte(wc * 32 + fr, fq * 8);
#define PG8_SA(b, h) (((b) * 2 + (h)) * HTB)
#define PG8_SB(b, h) ((4 + (b) * 2 + (h)) * HTB)
#define PG8_STAGE(bufoff, gbase, voff) do { _Pragma("unroll") for (int _i = 0; _i < 2; ++_i) \
        __builtin_amdgcn_global_load_lds((const unsigned*)((const char*)(gbase) + (voff)[_i]), (PG8_LAS unsigned*)(lds + (bufoff) + ldsw + _i * 8192), 16, 0, 0); } while (0)
#define PG8_LDA(dst, b, h) do { _Pragma("unroll") for (int m = 0; m < 4; ++m) _Pragma("unroll") for (int k = 0; k < 2; ++k) dst[m][k] = *(const PG8_LAS bf16x8*)(lds + PG8_SA(b, h) + aoff + m * 2048 + k * 1024); } while (0)
#define PG8_LDB(dst, b, h) do { _Pragma("unroll") for (int n = 0; n < 2; ++n) _Pragma("unroll") for (int k = 0; k < 2; ++k) dst[n][k] = *(const PG8_LAS bf16x8*)(lds + PG8_SB(b, h) + boff + n * 2048 + k * 1024); } while (0)
#define PG8_MMA(ai, bj, At, Bt) do { __builtin_amdgcn_s_setprio(1); _Pragma("unroll") for (int m = 0; m < 4; ++m) _Pragma("unroll") for (int n = 0; n < 2; ++n) _Pragma("unroll") for (int k = 0; k < 2; ++k) \
        acc[ai][bj][m][n] = __builtin_amdgcn_mfma_f32_16x16x32_bf16(Bt[n][k], At[m][k], acc[ai][bj][m][n], 0, 0, 0); __builtin_amdgcn_s_setprio(0); } while (0)
#define PG8_WAIT_V(n) asm volatile("s_waitcnt vmcnt(" #n ")" ::: "memory")
#define PG8_WAIT_L(n) asm volatile("s_waitcnt lgkmcnt(" #n ")" ::: "memory")
#define PG8_BAR __builtin_amdgcn_s_barrier()
#define PG8_SCHED __builtin_amdgcn_sched_barrier(0)
    Unit cur, nxt; int ui = 0;
    if (!S.next(0, cur)) return;
    f32x4 acc[2][2][4][2];
#pragma unroll
    for (int a = 0; a < 2; ++a)
#pragma unroll
        for (int b = 0; b < 2; ++b)
#pragma unroll
            for (int m = 0; m < 4; ++m)
#pragma unroll
                for (int n = 0; n < 2; ++n) acc[a][b][m][n] = (f32x4){0.f, 0.f, 0.f, 0.f};
    bf16x8 At[4][2], B0[2][2], B1[2][2];
    const char* cA = (const char*)g.A + (size_t)cur.pm * tstepA; const char* cB = (const char*)g.Bt + (size_t)cur.pn * tstepB;
    if constexpr (SP2) {
        PG8_STAGE(PG8_SB(0, 0), cB, voffB); PG8_STAGE(PG8_SB(0, 1), cB + hstepB, voffB); PG8_STAGE(PG8_SA(0, 0), cA, voffA); PG8_STAGE(PG8_SA(0, 1), cA + hstepA, voffA);
        if (wr == 1) PG8_BAR;
        PG8_WAIT_V(2); PG8_BAR;
        PG8_STAGE(PG8_SB(1, 0), cB + kstep, voffB); PG8_STAGE(PG8_SA(1, 0), cA + kstep, voffA); PG8_STAGE(PG8_SB(1, 1), cB + hstepB + kstep, voffB);
        PG8_WAIT_V(6); PG8_BAR;
    } else {
        PG8_STAGE(PG8_SB(0, 0), cB, voffB); PG8_STAGE(PG8_SA(0, 0), cA, voffA); PG8_STAGE(PG8_SB(0, 1), cB + hstepB, voffB); PG8_STAGE(PG8_SA(0, 1), cA + hstepA, voffA);
        if (wr == 1) PG8_BAR;
        PG8_WAIT_V(4); PG8_BAR;
        PG8_STAGE(PG8_SB(1, 0), cB + kstep, voffB); PG8_STAGE(PG8_SA(1, 0), cA + kstep, voffA); PG8_STAGE(PG8_SB(1, 1), cB + hstepB + kstep, voffB);
        PG8_WAIT_V(6); PG8_BAR;
    }
    for (;;) {
        const bool has_next = S.next(ui + 1, nxt);
        const char* nA = has_next ? (const char*)g.A + (size_t)nxt.pm * tstepA : cA; const char* nB = has_next ? (const char*)g.Bt + (size_t)nxt.pn * tstepB : cB;
        for (int t = 0; t < nt; t += 2) {
            const bool last = (t == nt - 2);
            const char* a1 = cA + (size_t)(t + 1) * kstep;
            const char* a2 = last ? nA : cA + (size_t)(t + 2) * kstep; const char* b2 = last ? nB : cB + (size_t)(t + 2) * kstep;
            const char* a3 = a2 + kstep; const char* b3 = b2 + kstep;
            if constexpr (SP2) {
            PG8_LDB(B0, 0, 0); PG8_LDB(B1, 0, 1); PG8_SCHED; PG8_LDA(At, 0, 0); PG8_STAGE(PG8_SA(1, 1), a1 + hstepA, voffA);
            PG8_WAIT_V(8); PG8_WAIT_L(0); PG8_BAR; PG8_MMA(0, 0, At, B0); PG8_MMA(0, 1, At, B1); PG8_BAR; PG8_SCHED;
            PG8_LDA(At, 0, 1); PG8_STAGE(PG8_SB(0, 0), b2, voffB); PG8_STAGE(PG8_SB(0, 1), b2 + hstepB, voffB); PG8_STAGE(PG8_SA(0, 0), a2, voffA);
            PG8_WAIT_V(8); PG8_WAIT_L(0); PG8_BAR; PG8_MMA(1, 0, At, B0); PG8_MMA(1, 1, At, B1); PG8_BAR; PG8_SCHED;
            PG8_LDB(B0, 1, 0); PG8_LDB(B1, 1, 1); PG8_SCHED; PG8_LDA(At, 1, 0); PG8_STAGE(PG8_SA(0, 1), a2 + hstepA, voffA);
            PG8_WAIT_V(8); PG8_WAIT_L(0); PG8_BAR; PG8_MMA(0, 0, At, B0); PG8_MMA(0, 1, At, B1); PG8_BAR; PG8_SCHED;
            PG8_LDA(At, 1, 1); PG8_STAGE(PG8_SB(1, 0), b3, voffB); PG8_STAGE(PG8_SB(1, 1), b3 + hstepB, voffB); PG8_STAGE(PG8_SA(1, 0), a3, voffA);
            PG8_WAIT_V(8); PG8_WAIT_L(0); PG8_BAR; PG8_MMA(1, 0, At, B0); PG8_MMA(1, 1, At, B1); PG8_BAR; PG8_SCHED;
            } else {
            PG8_LDB(B0, 0, 0); PG8_SCHED; PG8_LDA(At, 0, 0); PG8_STAGE(PG8_SA(1, 1), a1 + hstepA, voffA);
            PG8_WAIT_L(8); PG8_BAR; PG8_WAIT_L(0); PG8_MMA(0, 0, At, B0); PG8_BAR; PG8_SCHED;
            PG8_LDB(B1, 0, 1); PG8_STAGE(PG8_SB(0, 0), b2, voffB);
            PG8_BAR; PG8_WAIT_L(0); PG8_MMA(0, 1, At, B1); PG8_BAR;
            PG8_LDA(At, 0, 1); PG8_STAGE(PG8_SA(0, 0), a2, voffA);
            PG8_BAR; PG8_WAIT_L(0); PG8_MMA(1, 0, At, B0); PG8_BAR; PG8_SCHED;
            PG8_STAGE(PG8_SB(0, 1), b2 + hstepB, voffB);
            PG8_WAIT_V(6); PG8_BAR; PG8_MMA(1, 1, At, B1); PG8_BAR;
            PG8_LDB(B0, 1, 0); PG8_SCHED; PG8_LDA(At, 1, 0); PG8_STAGE(PG8_SA(0, 1), a2 + hstepA, voffA);
            PG8_WAIT_L(8); PG8_BAR; PG8_WAIT_L(0); PG8_MMA(0, 0, At, B0); PG8_BAR; PG8_SCHED;
            PG8_LDB(B1, 1, 1); PG8_STAGE(PG8_SB(1, 0), b3, voffB);
            PG8_BAR; PG8_WAIT_L(0); PG8_MMA(0, 1, At, B1); PG8_BAR;
            PG8_LDA(At, 1, 1); PG8_STAGE(PG8_SA(1, 0), a3, voffA);
            PG8_BAR; PG8_WAIT_L(0); PG8_MMA(1, 0, At, B0); PG8_BAR; PG8_SCHED;
            PG8_STAGE(PG8_SB(1, 1), b3 + hstepB, voffB);
            PG8_WAIT_V(6); PG8_BAR; PG8_MMA(1, 1, At, B1); PG8_BAR;
            }
        }
        if constexpr (ALIGN_EPI) { if (wr == 0) PG8_BAR; }
        E(acc, cur, wr, wc, fr, fq);
        if (!has_next) break;
#pragma unroll
        for (int a = 0; a < 2; ++a)
#pragma unroll
            for (int b = 0; b < 2; ++b)
#pragma unroll
                for (int m = 0; m < 4; ++m)
#pragma unroll
                    for (int n = 0; n < 2; ++n) acc[a][b][m][n] = (f32x4){0.f, 0.f, 0.f, 0.f};
        cur = nxt; cA = nA; cB = nB; ++ui;
        if constexpr (ALIGN_EPI) { if (wr == 1) PG8_BAR; }
    }
    PG8_WAIT_V(0);
    if constexpr (!ALIGN_EPI) { if (wr == 0) PG8_BAR; }
    PG8_BAR;
#undef PG8_SA
#undef PG8_SB
#undef PG8_STAGE
#undef PG8_LDA
#undef PG8_LDB
#undef PG8_MMA
#undef PG8_WAIT_V
#undef PG8_WAIT_L
#undef PG8_BAR
#undef PG8_SCHED
}
}
#define GAS __attribute__((address_space(1)))
#define LAS __attribute__((address_space(3)))
typedef unsigned short bf16;
typedef unsigned v4u __attribute__((ext_vector_type(4)));
typedef unsigned v2u __attribute__((ext_vector_type(2)));
typedef float f32x4 __attribute__((ext_vector_type(4)));
typedef short bf16x8 __attribute__((ext_vector_type(8)));
typedef GAS unsigned gu32;
#define RLX_AGENT __ATOMIC_RELAXED, __HIP_MEMORY_SCOPE_AGENT
#define LDS_WAIT() asm volatile("s_waitcnt lgkmcnt(0)" ::: "memory")
#define VM_WAIT() asm volatile("s_waitcnt vmcnt(0)" ::: "memory")

constexpr int NWAVES = 8, NTHR = 512;
constexpr int T = 16896, TP = 16384, D = 1024, FF = 2816, NGU = 2 * FF, NIN = 9232, NINP = 9472;
constexpr int SEQ = 2048, NB = 8, DB = 128, DSEQ = 4;
constexpr float ALPHA = 1.189207115002721f, EPS = 1e-5f;
constexpr int C_Z = 0, C_XM = 1024, C_B = 2048, C_C = 2560, C_Q = 3072, C_F = 4096, C_I = 5120, C_OG = 6144, C_GM = 7168, C_GH = 8192, C_DT = 9216;
constexpr size_t O_Y = 0, O_CONVP = 17301504, O_SSMP = 17350656, O_HGP = 18399232, O_CONVS = 19447808, O_SSMS = 20234240, O_HGS = 37011456, O_END = 53788672;
constexpr size_t MiB = 1u << 20;
constexpr size_t OS_XB = O_SSMS * 4, OS_W1A = O_SSMS * 4 + 36 * MiB, OS_W1D = O_SSMS * 4 + 48 * MiB, OS_WIN = O_HGS * 4;
constexpr size_t WS_CTL = 0, CTL_ZERO_BYTES = 64 * 1024, WS_WMO = 1 * MiB, WS_WHO = 3 * MiB, WS_WO = 5 * MiB, WS_B = 8 * MiB;
constexpr size_t WS_PROJ = WS_B, WS_X2B = WS_B, WS_W2A = WS_B + 36 * MiB, WS_W2D = WS_B + 48 * MiB, WS_H = WS_B + 64 * MiB;
constexpr size_t WS_END = WS_B + (size_t)T * NIN * 2;
static_assert(WS_H + (size_t)T * FF * 2 <= WS_END, "H fits region B");
constexpr int CW_BAR = 1024;
constexpr int RING_BYTES = 131072, LDSCTL_OFF = RING_BYTES, MISC_OFF = LDSCTL_OFF + 320, LDS_BYTES = 147456;

__device__ __forceinline__ unsigned f2bf(float f) { unsigned u = __builtin_bit_cast(unsigned, f); return (u + 0x7fffu + ((u >> 16) & 1u)) >> 16; }
__device__ __forceinline__ unsigned pk2(float lo, float hi) { return f2bf(lo) | (f2bf(hi) << 16); }
__device__ __forceinline__ float bf2f(unsigned u16) { return __builtin_bit_cast(float, u16 << 16); }
__device__ __forceinline__ float bflo(unsigned w) { return __builtin_bit_cast(float, w << 16); }
__device__ __forceinline__ float bfhi(unsigned w) { return __builtin_bit_cast(float, w & 0xffff0000u); }
__device__ __forceinline__ float sigm(float x) { return __builtin_amdgcn_rcpf(1.f + __expf(-x)); }
__device__ __forceinline__ float siluf(float x) { return x * sigm(x); }
__device__ __forceinline__ float wave_sum(float v) {
#pragma unroll
    for (int o = 1; o < 64; o <<= 1) v += __shfl_xor(v, o);
    return v;
}

#define XB_TMO      128
#define XB_XCNT(j)  (256  + 64 * (j))
#define XB_XSUB(j)  (1280 + 64 * (j))
#define XB_XGEN(j)  (2304 + 64 * (j))
#define XB_TOP      3328
#define XB_TOPGEN   3392
#define XCD_BAR_WORDS 3456
#define XB_SPIN_CAP (1u << 20)
__device__ __forceinline__ unsigned xb_ld(unsigned* p)              { return __hip_atomic_load(p, __ATOMIC_RELAXED, __HIP_MEMORY_SCOPE_AGENT); }
__device__ __forceinline__ unsigned xb_add(unsigned* p, unsigned v) { return __hip_atomic_fetch_add(p, v, __ATOMIC_RELAXED, __HIP_MEMORY_SCOPE_AGENT); }
__device__ __forceinline__ unsigned xb_xcc_id() { return (unsigned)__builtin_amdgcn_s_getreg((3 << 11) | 20) & 0xFu; }
#define XB_SPIN(cond, bar) do { unsigned _sp = 0; while (cond) { __builtin_amdgcn_s_sleep(1); \
    if ((++_sp & 255u) == 0u) { if (xb_ld(&(bar)[XB_TMO])) break; if (_sp > XB_SPIN_CAP) { atomicAdd(&(bar)[XB_TMO], 1u); break; } } } } while (0)
struct XcdBarrier { unsigned* bar; unsigned x; volatile LAS unsigned* st; };
__device__ __forceinline__ XcdBarrier xcd_barrier_post(unsigned* bar, volatile LAS unsigned* st) {
    XcdBarrier b; b.bar = bar; b.x = xb_xcc_id(); b.st = st;
    if (threadIdx.x == 0) (void)xb_add(&bar[XB_XCNT(b.x)], 1u);
    return b;
}
__device__ __forceinline__ void xcd_barrier_complete(unsigned* bar, unsigned x, unsigned& nloc, unsigned& nx) {
    const unsigned G = gridDim.x * gridDim.y * gridDim.z;
    unsigned sum, cnt, mine, sp = 0u;
    for (;;) {
        sum = 0u; cnt = 0u; mine = 0u;
#pragma unroll
        for (unsigned j = 0; j < 16; ++j) { const unsigned c = xb_ld(&bar[XB_XCNT(j)]); sum += c; cnt += (c > 0u) ? 1u : 0u; mine = (j == x) ? c : mine; }
        if (sum == G) break;
        __builtin_amdgcn_s_sleep(1);
        if ((++sp & 255u) == 0u) { if (xb_ld(&bar[XB_TMO])) break; if (sp > XB_SPIN_CAP) { atomicAdd(&bar[XB_TMO], 1u); break; } }
    }
    nloc = mine > 0u ? mine : 1u; nx = cnt > 0u ? cnt : 1u;
}
__device__ __forceinline__ void xcd_barrier(const XcdBarrier& b) {
    asm volatile("s_waitcnt vmcnt(0)" ::: "memory");
    __syncthreads();
    if (threadIdx.x == 0) {
        unsigned* bar = b.bar;
        __builtin_amdgcn_s_waitcnt(0);
        unsigned nloc = b.st[0], nx = b.st[1];
        if (nloc == 0u) { xcd_barrier_complete(bar, b.x, nloc, nx); b.st[0] = nloc; b.st[1] = nx; }
        const unsigned old = xb_add(&bar[XB_XSUB(b.x)], 1u);
        const unsigned gen = old / nloc;
        if (old + 1u == (gen + 1u) * nloc) {
            __builtin_amdgcn_fence(__ATOMIC_RELEASE, "agent");
            asm volatile("s_waitcnt vmcnt(0)" ::: "memory");
            const unsigned og = xb_add(&bar[XB_TOP], 1u);
            const unsigned tg = og / nx;
            if (og + 1u == (tg + 1u) * nx) xb_add(&bar[XB_TOPGEN], 1u);
            else XB_SPIN(xb_ld(&bar[XB_TOPGEN]) == tg, bar);
            __builtin_amdgcn_fence(__ATOMIC_ACQUIRE, "agent");
            xb_add(&bar[XB_XGEN(b.x)], 1u);
            asm volatile("s_waitcnt vmcnt(0)" ::: "memory");
        } else {
            XB_SPIN(xb_ld(&bar[XB_XGEN(b.x)]) == gen, bar);
            __builtin_amdgcn_fence(__ATOMIC_ACQUIRE, "agent");
            asm volatile("s_waitcnt vmcnt(0)" ::: "memory");
        }
    }
    __syncthreads();
}

using pg8::Unit;
struct EpiSwiGLU {
    static constexpr bool PERM = true;
    bf16* H;
    __device__ __forceinline__ void operator()(const f32x4 (&acc)[2][2][4][2], const Unit& u, int wr, int wc, int fr, int fq) const {
        const int row0 = u.pm * 256 + wr * 64 + fr, col0 = u.pn * 128 + wc * 32 + 8 * fq;
#pragma unroll
        for (int ai = 0; ai < 2; ++ai)
#pragma unroll
            for (int m = 0; m < 4; ++m) {
                const f32x4 g0 = acc[ai][0][m][0], g1 = acc[ai][0][m][1], u0 = acc[ai][1][m][0], u1 = acc[ai][1][m][1];
                v4u w;
                w.x = pg8::cvt_pk_bf16(siluf(g0[0]) * u0[0], siluf(g0[1]) * u0[1]); w.y = pg8::cvt_pk_bf16(siluf(g0[2]) * u0[2], siluf(g0[3]) * u0[3]);
                w.z = pg8::cvt_pk_bf16(siluf(g1[0]) * u1[0], siluf(g1[1]) * u1[1]); w.w = pg8::cvt_pk_bf16(siluf(g1[2]) * u1[2], siluf(g1[3]) * u1[3]);
                *(v4u*)(H + (size_t)(row0 + ai * 128 + m * 16) * FF + col0) = w;
            }
    }
};
struct EpiBf16N {
    static constexpr bool PERM = true;
    bf16* O; int ldc, ncols;
    __device__ __forceinline__ void operator()(const f32x4 (&acc)[2][2][4][2], const Unit& u, int wr, int wc, int fr, int fq) const {
        const int row0 = u.pm * 256 + wr * 64 + fr, col0 = u.pn * 256 + wc * 32 + 8 * fq;
#pragma unroll
        for (int ai = 0; ai < 2; ++ai)
#pragma unroll
            for (int m = 0; m < 4; ++m) { bf16* rowp = O + (size_t)(row0 + ai * 128 + m * 16) * ldc + col0;
#pragma unroll
                for (int bj = 0; bj < 2; ++bj) { const f32x4 v0 = acc[ai][bj][m][0], v1 = acc[ai][bj][m][1];
                    v4u w; w.x = pg8::cvt_pk_bf16(v0[0], v0[1]); w.y = pg8::cvt_pk_bf16(v0[2], v0[3]); w.z = pg8::cvt_pk_bf16(v1[0], v1[1]); w.w = pg8::cvt_pk_bf16(v1[2], v1[3]);
                    if (col0 + bj * 128 < ncols) *(v4u*)(rowp + bj * 128) = w; } }
    }
};
struct EpiResid {
    static constexpr bool PERM = false;
    const float* res; const float* res2; float* out; float s;
    __device__ __forceinline__ void operator()(const f32x4 (&acc)[2][2][4][2], const Unit& u, int wr, int wc, int fr, int fq) const {
        const int row0 = u.pm * 256 + wr * 64 + fr, col0 = u.pn * 256 + wc * 32 + 4 * fq;
        const float* rb = (res2 != nullptr && u.pm >= TP / 256) ? res2 - (size_t)TP * D : res;
#pragma unroll
        for (int ai = 0; ai < 2; ++ai)
#pragma unroll
            for (int m = 0; m < 4; ++m) { const size_t off = (size_t)(row0 + ai * 128 + m * 16) * D + col0;
#pragma unroll
                for (int bj = 0; bj < 2; ++bj)
#pragma unroll
                    for (int n = 0; n < 2; ++n) { const f32x4 r = *(const f32x4*)(rb + off + bj * 128 + n * 16);
                        *(f32x4*)(out + off + bj * 128 + n * 16) = r * ALPHA + acc[ai][bj][m][n] * s; } }
    }
};
template <bool ADD> struct EpiGate {
    static constexpr bool PERM = true;
    const bf16* gate; bf16* dst;
    __device__ __forceinline__ void operator()(const f32x4 (&acc)[2][2][4][2], const Unit& u, int wr, int wc, int fr, int fq) const {
        const int row0 = u.pm * 256 + wr * 64 + fr, col0 = u.pn * 256 + wc * 32 + 8 * fq;
#pragma unroll
        for (int ai = 0; ai < 2; ++ai)
#pragma unroll
            for (int m = 0; m < 4; ++m) { const size_t off = (size_t)(row0 + ai * 128 + m * 16) * NIN + col0;
#pragma unroll
                for (int bj = 0; bj < 2; ++bj) { const f32x4 v0 = acc[ai][bj][m][0], v1 = acc[ai][bj][m][1];
                    const v4u gw = *(const v4u*)(gate + off + bj * 128);
                    float r[8] = { sigm(bflo(gw.x)) * v0[0], sigm(bfhi(gw.x)) * v0[1], sigm(bflo(gw.y)) * v0[2], sigm(bfhi(gw.y)) * v0[3],
                                   sigm(bflo(gw.z)) * v1[0], sigm(bfhi(gw.z)) * v1[1], sigm(bflo(gw.w)) * v1[2], sigm(bfhi(gw.w)) * v1[3] };
                    if (ADD) { const v4u dw = *(const v4u*)(dst + off + bj * 128);
                        r[0] += bflo(dw.x); r[1] += bfhi(dw.x); r[2] += bflo(dw.y); r[3] += bfhi(dw.y); r[4] += bflo(dw.z); r[5] += bfhi(dw.z); r[6] += bflo(dw.w); r[7] += bfhi(dw.w); }
                    v4u w; w.x = pg8::cvt_pk_bf16(r[0], r[1]); w.y = pg8::cvt_pk_bf16(r[2], r[3]); w.z = pg8::cvt_pk_bf16(r[4], r[5]); w.w = pg8::cvt_pk_bf16(r[6], r[7]);
                    *(v4u*)(dst + off + bj * 128) = w; } }
    }
};
__device__ __forceinline__ void transpose_item(const float* W, int ldw, int srccol0, int ncopy, bf16* WT, int dstrow0, int K, int k0, LAS float* scr, int lane) {
#pragma unroll 8
    for (int i = 0; i < 32; ++i) { const int kk = 2 * i + (lane >> 5), n = lane & 31; scr[kk * 33 + n] = (n < ncopy) ? W[(size_t)(k0 + kk) * ldw + srccol0 + n] : 0.f; }
    LDS_WAIT(); asm volatile("" ::: "memory");
    const int c = lane & 7;
#pragma unroll
    for (int j = 0; j < 4; ++j) { const int n = (lane >> 3) + 8 * j; const LAS float* s = scr + (8 * c) * 33 + n;
        v4u o; o.x = pk2(s[0 * 33], s[1 * 33]); o.y = pk2(s[2 * 33], s[3 * 33]); o.z = pk2(s[4 * 33], s[5 * 33]); o.w = pk2(s[6 * 33], s[7 * 33]);
        *(v4u*)(WT + (size_t)(dstrow0 + n) * K + k0 + 8 * c) = o; }
    LDS_WAIT(); asm volatile("" ::: "memory");
}
__device__ __forceinline__ void ffn_weight_items(const float* Wg, const float* Wu, const float* Wd, bf16* WA, bf16* WD, LAS float* scr, int gw, int NGW, int lane) {
    constexpr int I_A = (NGU / 32) * (D / 64), I_D = (D / 32) * (FF / 64);
    for (int it = gw; it < I_A + I_D; it += NGW) {
        if (it < I_A) { const int gi = it / (D / 64), kb = it % (D / 64), n0 = 32 * gi, pn = n0 >> 8, bj = (n0 >> 7) & 1, i0 = n0 & 127;
            transpose_item(bj ? Wu : Wg, FF, 128 * pn + i0, 32, WA, n0, D, 64 * kb, scr, lane); }
        else { const int r = it - I_A, gi = r / (FF / 64), kb = r % (FF / 64);
            transpose_item(Wd, D, 32 * gi, 32, WD, 32 * gi, FF, 64 * kb, scr, lane); }
    }
}
__device__ __forceinline__ void p0_prologue(const float* const* in, unsigned char* outb, unsigned char* ws, LAS unsigned char* lds, int vcu, int G, int wave, int lane) {
    LAS float* scr = (LAS float*)(lds + wave * 16384);
    const int gw = vcu * NWAVES + wave, NGW = G * NWAVES;
    ffn_weight_items(in[5], in[6], in[7], (bf16*)(outb + OS_W1A), (bf16*)(outb + OS_W1D), scr, gw, NGW, lane);
    constexpr int I_IN = (NINP / 32) * (D / 64), I_SQ = (D / 32) * (D / 64);
    for (int it = gw; it < I_IN + 3 * I_SQ; it += NGW) {
        if (it < I_IN) { const int gi = it / (D / 64), kb = it % (D / 64), n0 = 32 * gi;
            int src, ncopy;
            if (n0 < 3072) { src = n0; ncopy = 32; } else if (n0 < C_DT) { src = n0 + 16; ncopy = 32; } else if (n0 == C_DT) { src = 3072; ncopy = 16; } else { src = 0; ncopy = 0; }
            transpose_item(in[10], NIN, src, ncopy, (bf16*)(outb + OS_WIN), n0, D, 64 * kb, scr, lane); }
        else { const int r = it - I_IN, w = r / I_SQ, r2 = r % I_SQ, gi = r2 / (D / 64), kb = r2 % (D / 64);
            const float* W = in[w == 0 ? 17 : (w == 1 ? 20 : 21)]; bf16* WT = (bf16*)(ws + (w == 0 ? WS_WMO : (w == 1 ? WS_WHO : WS_WO)));
            transpose_item(W, D, 32 * gi, 32, WT, 32 * gi, D, 64 * kb, scr, lane); }
    }
    bf16* XB = (bf16*)(outb + OS_XB);
    const size_t n8 = (size_t)T * D / 8, nthr = (size_t)G * NTHR;
    for (size_t i = (size_t)vcu * NTHR + threadIdx.x; i < n8; i += nthr) {
        const size_t e = i * 8; const float* src = (e < (size_t)TP * D) ? in[0] + e : in[1] + (e - (size_t)TP * D);
        const f32x4 a = *(const f32x4*)src, b = *(const f32x4*)(src + 4);
        v4u w; w.x = pk2(a[0], a[1]); w.y = pk2(a[2], a[3]); w.z = pk2(b[0], b[1]); w.w = pk2(b[2], b[3]);
        *(v4u*)(XB + e) = w;
    }
}
__device__ __forceinline__ void ln_phase(float* X, bf16* XBo, const float* gam, const float* bet, int vcu, int G, int wave, int lane) {
    const int gw = vcu * NWAVES + wave, NGW = G * NWAVES;
    f32x4 gv[4], bv[4];
#pragma unroll
    for (int j = 0; j < 4; ++j) { gv[j] = *(const f32x4*)(gam + 4 * lane + 256 * j); bv[j] = *(const f32x4*)(bet + 4 * lane + 256 * j); }
    for (int m = gw; m < T; m += NGW) {
        f32x4* xr = (f32x4*)(X + (size_t)m * D) + lane;
        f32x4 v[4]; float s = 0.f;
#pragma unroll
        for (int j = 0; j < 4; ++j) { v[j] = xr[64 * j]; s += (v[j][0] + v[j][1]) + (v[j][2] + v[j][3]); }
        const float mean = wave_sum(s) * (1.f / D); float s2 = 0.f;
#pragma unroll
        for (int j = 0; j < 4; ++j) { v[j] = v[j] - mean; s2 += (v[j][0] * v[j][0] + v[j][1] * v[j][1]) + (v[j][2] * v[j][2] + v[j][3] * v[j][3]); }
        const float rstd = 1.f / sqrtf(wave_sum(s2) * (1.f / D) + EPS);
#pragma unroll
        for (int j = 0; j < 4; ++j) { const f32x4 o = v[j] * rstd * gv[j] + bv[j]; xr[64 * j] = o;
            if (XBo) { v2u w; w.x = pk2(o[0], o[1]); w.y = pk2(o[2], o[3]); *((v2u*)(XBo + (size_t)m * D) + lane + 64 * j) = w; } }
    }
}
__device__ __forceinline__ void norm_phase(bf16* PROJ, const float* mw, const float* hw, int vcu, int G, int wave, int lane) {
    const int gw = vcu * NWAVES + wave, NGW = G * NWAVES;
    float mwv[16], hwv[16];
#pragma unroll
    for (int j = 0; j < 16; ++j) { mwv[j] = mw[16 * lane + j]; hwv[j] = hw[16 * lane + j]; }
    for (int m = gw; m < T; m += NGW) {
        bf16* row = PROJ + (size_t)m * NIN;
        const v4u y0 = *(const v4u*)(row + C_XM + 16 * lane), y1 = *(const v4u*)(row + C_XM + 16 * lane + 8);
        const v4u z0 = *(const v4u*)(row + C_Z + 16 * lane), z1 = *(const v4u*)(row + C_Z + 16 * lane + 8);
        const v4u o0 = *(const v4u*)(row + C_I + 16 * lane), o1 = *(const v4u*)(row + C_I + 16 * lane + 8);
        const v4u g0 = *(const v4u*)(row + C_OG + 16 * lane), g1 = *(const v4u*)(row + C_OG + 16 * lane + 8);
        float a[16], b[16];
        const unsigned yw[8] = {y0.x, y0.y, y0.z, y0.w, y1.x, y1.y, y1.z, y1.w}, zw[8] = {z0.x, z0.y, z0.z, z0.w, z1.x, z1.y, z1.z, z1.w};
        const unsigned ow[8] = {o0.x, o0.y, o0.z, o0.w, o1.x, o1.y, o1.z, o1.w}, gww[8] = {g0.x, g0.y, g0.z, g0.w, g1.x, g1.y, g1.z, g1.w};
        float sa = 0.f, sb = 0.f;
#pragma unroll
        for (int j = 0; j < 8; ++j) {
            a[2 * j] = bflo(yw[j]) * siluf(bflo(zw[j])); a[2 * j + 1] = bfhi(yw[j]) * siluf(bfhi(zw[j]));
            b[2 * j] = bflo(ow[j]); b[2 * j + 1] = bfhi(ow[j]);
            sa += a[2 * j] * a[2 * j] + a[2 * j + 1] * a[2 * j + 1]; sb += b[2 * j] * b[2 * j] + b[2 * j + 1] * b[2 * j + 1];
        }
        sb += __shfl_xor(sb, 1); sb += __shfl_xor(sb, 2); sb += __shfl_xor(sb, 4);
        sa += __shfl_xor(sa, 1); sa += __shfl_xor(sa, 2); sa += __shfl_xor(sa, 4); sa += __shfl_xor(sa, 8);
        const float ra = 1.f / sqrtf(sa * (1.f / 256.f) + EPS), rb = 1.f / sqrtf(sb * (1.f / 128.f) + EPS);
        unsigned wa[8], wb[8];
#pragma unroll
        for (int j = 0; j < 8; ++j) {
            wa[j] = pk2(a[2 * j] * ra * mwv[2 * j], a[2 * j + 1] * ra * mwv[2 * j + 1]);
            wb[j] = pk2(b[2 * j] * rb * hwv[2 * j] * siluf(bflo(gww[j])), b[2 * j + 1] * rb * hwv[2 * j + 1] * siluf(bfhi(gww[j])));
        }
        *(v4u*)(row + C_XM + 16 * lane) = (v4u){wa[0], wa[1], wa[2], wa[3]}; *(v4u*)(row + C_XM + 16 * lane + 8) = (v4u){wa[4], wa[5], wa[6], wa[7]};
        *(v4u*)(row + C_I + 16 * lane) = (v4u){wb[0], wb[1], wb[2], wb[3]}; *(v4u*)(row + C_I + 16 * lane + 8) = (v4u){wb[4], wb[5], wb[6], wb[7]};
    }
}
constexpr int S_QC = 136, S_KT = 72, S_XN = 40;
constexpr int L_QC = 0, L_KB = 17408, L_KT = 34816, L_XT = 53248, L_WT = 57856, L_ST = 67072, L_XN = 75776, L_RB = 80896, L_RC = 98048, L_RX = 115200, L_F = 119488, L_XS = 122624, L_CW = 132096;
static_assert(L_XS + 32 * S_KT * 2 <= RING_BYTES && L_CW >= MISC_OFF + 128 && L_CW + 5 * 288 * 4 <= LDS_BYTES, "scan LDS map");

__device__ __forceinline__ f32x4 mma_rows(const LAS bf16* Ar, int sa, int r0, const LAS bf16* Br, int sb, int c0, int K, f32x4 acc, int fr, int fq) {
    const LAS bf16* pa = Ar + (r0 + fr) * sa + 8 * fq; const LAS bf16* pb = Br + (c0 + fr) * sb + 8 * fq;
    for (int k0 = 0; k0 < K; k0 += 32) {
        const bf16x8 a = *(const LAS bf16x8*)(pa + k0), b = *(const LAS bf16x8*)(pb + k0);
        acc = __builtin_amdgcn_mfma_f32_16x16x32_bf16(b, a, acc, 0, 0, 0);
    }
    return acc;
}
__device__ __forceinline__ void unpack8(const v4u w, float (&f)[8]) { f[0] = bflo(w.x); f[1] = bfhi(w.x); f[2] = bflo(w.y); f[3] = bfhi(w.y); f[4] = bflo(w.z); f[5] = bfhi(w.z); f[6] = bflo(w.w); f[7] = bfhi(w.w); }

__device__ __forceinline__ void unpack4(const v2u w, float (&f)[4]) { f[0] = bflo(w.x); f[1] = bfhi(w.x); f[2] = bflo(w.y); f[3] = bfhi(w.y); }
template <int PT>
__device__ __forceinline__ void ssd_prep_item(const LAS bf16* rsrc, int rstride, int ptq, int pn8, const LAS float* CWL,
                                              LAS bf16* nat, int nstride, LAS bf16* tr, LAS bf16* trs, const LAS float* ACUM, const LAS float* DT) {
    const float alast = (PT == 0) ? ACUM[63] : 0.f;
#pragma unroll 1
    for (int hf = 0; hf < 2; ++hf) {
        float win[4][4];
        const int chb = (PT == 0 ? 0 : (PT == 1 ? 32 : 160)) + pn8 * 8 + 4 * hf;
        const f32x4 cw0 = *(const LAS f32x4*)(CWL + chb), cw1 = *(const LAS f32x4*)(CWL + 288 + chb), cw2 = *(const LAS f32x4*)(CWL + 576 + chb), cw3 = *(const LAS f32x4*)(CWL + 864 + chb), cbv = *(const LAS f32x4*)(CWL + 1152 + chb);
#pragma unroll
        for (int i = 0; i < 3; ++i) unpack4(*(const LAS v2u*)(rsrc + (8 * ptq + i) * rstride + 4 * hf), win[i]);
        float prev[4], prevs[4];
#pragma unroll
        for (int i = 0; i < 8; ++i) {
            unpack4(*(const LAS v2u*)(rsrc + (8 * ptq + i + 3) * rstride + 4 * hf), win[(i + 3) & 3]);
            float o[4];
#pragma unroll
            for (int ch = 0; ch < 4; ++ch) { const float sacc = cbv[ch] + cw0[ch] * win[i & 3][ch] + cw1[ch] * win[(i + 1) & 3][ch] + cw2[ch] * win[(i + 2) & 3][ch] + cw3[ch] * win[(i + 3) & 3][ch];
                o[ch] = siluf(sacc); }
            const int t = 8 * ptq + i;
            *(LAS v2u*)(nat + t * nstride + pn8 * 8 + 4 * hf) = (v2u){pk2(o[0], o[1]), pk2(o[2], o[3])};
            if (PT != 2) {
                float sei = 0.f; if (PT == 0) sei = __expf(alast - ACUM[t]) * DT[t];
                if (i & 1) {
#pragma unroll
                    for (int ch = 0; ch < 4; ++ch) { *(LAS unsigned*)(tr + (pn8 * 8 + 4 * hf + ch) * S_KT + t - 1) = pk2(prev[ch], o[ch]);
                        if (PT == 0) *(LAS unsigned*)(trs + (pn8 * 8 + 4 * hf + ch) * S_KT + t - 1) = pk2(prevs[ch], o[ch] * sei); }
                } else {
#pragma unroll
                    for (int ch = 0; ch < 4; ++ch) { prev[ch] = o[ch]; if (PT == 0) prevs[ch] = o[ch] * sei; }
                }
            }
        }
    }
}

template <bool SSD>
__device__ __forceinline__ void scan_prompt_job(int job, bf16* PROJ, const float* const* in, float* out, LAS unsigned char* lds, int tid, int wave, int lane) {
    const int fr = lane & 15, fq = lane >> 4;
    LAS bf16* QC = (LAS bf16*)(lds + L_QC); LAS bf16* KB = (LAS bf16*)(lds + L_KB); LAS bf16* KT = (LAS bf16*)(lds + L_KT); LAS bf16* XT = (LAS bf16*)(lds + L_XT);
    LAS bf16* WT = (LAS bf16*)(lds + L_WT); LAS bf16* ST = (LAS bf16*)(lds + L_ST); LAS bf16* XN = (LAS bf16*)(lds + L_XN); LAS bf16* XS = SSD ? (LAS bf16*)(lds + L_XS) : XT;
    LAS bf16* RB = (LAS bf16*)(lds + L_RB); LAS bf16* RC = (LAS bf16*)(lds + L_RC); LAS bf16* RX = (LAS bf16*)(lds + L_RX);
    LAS float* DT = (LAS float*)(lds + L_F); LAS float* ACUM = DT + 64; LAS float* DEC = DT + 128; LAS float* SEG = DT + 256;
    int b, colB, colC, colX, coldt = 0, h = 0, half = 0, g = 0, hd = 0, vq = 0;
    if (SSD) { b = job >> 5; h = (job >> 1) & 15; half = job & 1; g = h >> 2; colX = C_XM + h * 64 + half * 32; colB = C_B + g * 128; colC = C_C + g * 128; coldt = C_DT + h; }
    else { b = job >> 5; hd = (job >> 2) & 7; vq = job & 3; colB = C_F + hd * 128; colC = C_Q + hd * 128; colX = C_I + hd * 128 + vq * 32; }
    const size_t rowbase = (size_t)b * SEQ;
    float a_neg = 0.f, Dh = 0.f, dtb = 0.f;
    int pn8 = 0, ptq = 0;
    float lbk = 0.f;
    LAS float* CWL = (LAS float*)(lds + L_CW);
    if (SSD) {
        a_neg = -__expf(in[14][h]); Dh = in[15][h]; dtb = in[13][h];
        if (wave == 0) { pn8 = lane & 3; ptq = (lane >> 2) & 7; }
        else if (wave <= 2) { const int i = tid - 64; pn8 = i & 15; ptq = i >> 4; }
        else if (wave <= 4) { const int i = tid - 192; pn8 = i & 15; ptq = i >> 4; }
        if (tid < 288) { const int cc = tid < 32 ? h * 64 + half * 32 + tid : (tid < 160 ? 1024 + g * 128 + (tid - 32) : 1536 + g * 128 + (tid - 160));
#pragma unroll
            for (int k = 0; k < 4; ++k) CWL[k * 288 + tid] = in[11][k * 2048 + cc];
            CWL[1152 + tid] = in[12][cc]; }
    } else {
        const int k = hd * 128 + (tid & 127); lbk = sigm(in[18][k] - in[18][1024 + k]);
    }
    v4u pf[5]; unsigned dtraw_next = 0, dtraw = 0;
#define LOAD_REGS(c_) do { const bf16* base_ = PROJ + (rowbase + (size_t)(c_) * 64) * NIN; \
        _Pragma("unroll") for (int j = 0; j < 4; ++j) { const int i = (tid + 512 * j) & 1023, row = i >> 4, c16 = i & 15; \
            pf[j] = *(const v4u*)(base_ + (size_t)row * NIN + (j < 2 ? colB : colC) + c16 * 8); } \
        if (tid < 256) pf[4] = *(const v4u*)(base_ + (size_t)(tid >> 2) * NIN + colX + (tid & 3) * 8); \
        if (SSD && tid < 64) dtraw_next = base_[(size_t)tid * NIN + coldt]; } while (0)
#define STORE_RAW() do { \
        _Pragma("unroll") for (int j = 0; j < 4; ++j) { const int i = (tid + 512 * j) & 1023, row = i >> 4, c16 = i & 15; \
            *(LAS v4u*)((j < 2 ? RB : RC) + (3 + row) * 128 + c16 * 8) = pf[j]; } \
        if (tid < 256) *(LAS v4u*)(RX + (3 + (tid >> 2)) * 32 + (tid & 3) * 8) = pf[4]; } while (0)
    f32x4 st[2] = {(f32x4){0.f, 0.f, 0.f, 0.f}, (f32x4){0.f, 0.f, 0.f, 0.f}};
    for (int i = tid; i < 32 * S_QC / 2; i += NTHR) ((LAS unsigned*)ST)[i] = 0u;
    if (SSD) { for (int i = tid; i < 3 * 128 / 2; i += NTHR) { ((LAS unsigned*)RB)[i] = 0u; ((LAS unsigned*)RC)[i] = 0u; } if (tid < 3 * 32 / 2) ((LAS unsigned*)RX)[tid] = 0u; }
    LOAD_REGS(0);
    v4u halo = (v4u){0u, 0u, 0u, 0u};
    for (int c = 0; c < SEQ / 64; ++c) {
        STORE_RAW(); dtraw = dtraw_next;
        __syncthreads();
        if (c + 1 < SEQ / 64) LOAD_REGS(c + 1);
        const size_t t0 = rowbase + (size_t)c * 64;
        if (SSD) {
            if (wave == 0) {
                const float xr = bf2f(dtraw) + dtb; const float dt = xr > 20.f ? xr : log1pf(__expf(xr));
                float v = dt * a_neg;
#pragma unroll
                for (int o = 1; o < 64; o <<= 1) { const float tt = __shfl_up(v, o); if (lane >= o) v += tt; }
                DT[lane] = dt; ACUM[lane] = v;
                asm volatile("s_waitcnt lgkmcnt(0)" ::: "memory");
            }
#ifndef NO_PREP
            if (wave == 0) { if (lane < 32) ssd_prep_item<0>(RX + pn8 * 8, 32, ptq, pn8, CWL, XN, S_XN, XT, XS, ACUM, DT); }
            else if (wave <= 2) ssd_prep_item<1>(RB + pn8 * 8, 128, ptq, pn8, CWL, KB, S_QC, KT, KT, ACUM, DT);
            else if (wave <= 4) ssd_prep_item<2>(RC + pn8 * 8, 128, ptq, pn8, CWL, QC, S_QC, KT, KT, ACUM, DT);
#endif
        } else {
            const int k = tid & 127, seg = tid >> 7;
            float pl[16], qv[16], kv[16]; float run = 0.f;
#pragma unroll
            for (int i = 0; i < 16; ++i) { const int t = 16 * seg + i;
                const float frw = bf2f(RB[(3 + t) * 128 + k]); qv[i] = bf2f(RC[(3 + t) * 128 + k]);
                const float sg = sigm(frw); const float f = lbk + (1.f - lbk) * sg; kv[i] = (1.f - lbk) * (1.f - sg);
                run += __logf(f); pl[i] = run; }
            SEG[seg * 128 + k] = run;
            { const int v = tid & 31, tg = tid >> 5;
                const unsigned a0 = RX[(3 + 4 * tg) * 32 + v], a1 = RX[(4 + 4 * tg) * 32 + v], a2 = RX[(5 + 4 * tg) * 32 + v], a3 = RX[(6 + 4 * tg) * 32 + v];
                *(LAS v2u*)(XT + v * S_KT + 4 * tg) = (v2u){a0 | (a1 << 16), a2 | (a3 << 16)}; }
            __syncthreads();
            float off = 0.f, tot = 0.f;
#pragma unroll
            for (int s = 0; s < 4; ++s) { const float sv = SEG[s * 128 + k]; tot += sv; if (s < seg) off += sv; }
            if (seg == 0) DEC[k] = __expf(tot);
            unsigned kew[8]; float kprev = 0.f;
#pragma unroll
            for (int i = 0; i < 16; ++i) { const int t = 16 * seg + i; const float bc = off + pl[i];
                QC[t * S_QC + k] = (bf16)f2bf(qv[i] * __expf(bc)); KB[t * S_QC + k] = (bf16)f2bf(kv[i] * __expf(-bc));
                const float ke = kv[i] * __expf(tot - bc);
                if (i & 1) kew[i >> 1] = pk2(kprev, ke); else kprev = ke; }
            *(LAS v4u*)(KT + k * S_KT + 16 * seg) = (v4u){kew[0], kew[1], kew[2], kew[3]}; *(LAS v4u*)(KT + k * S_KT + 16 * seg + 8) = (v4u){kew[4], kew[5], kew[6], kew[7]};
        }
        __syncthreads();
        { const int tb = wave >> 1;
#pragma unroll
            for (int q = 0; q < 2; ++q) { const int sb = 2 * (wave & 1) + q; const int t = 16 * tb + fr, s0 = 16 * sb + 4 * fq;
                f32x4 gacc = (f32x4){0.f, 0.f, 0.f, 0.f};
                v2u ow = (v2u){0u, 0u};
                if (sb <= tb) {
                    gacc = mma_rows(QC, S_QC, 16 * tb, KB, S_QC, 16 * sb, 128, gacc, fr, fq);
                    float w[4];
                    if (SSD) { const float at = ACUM[t]; const f32x4 as = *(const LAS f32x4*)(ACUM + s0), ds = *(const LAS f32x4*)(DT + s0);
#pragma unroll
                        for (int j = 0; j < 4; ++j) w[j] = (s0 + j <= t) ? gacc[j] * __expf(fminf(at - as[j], 0.f)) * ds[j] : 0.f;
                    } else {
#pragma unroll
                        for (int j = 0; j < 4; ++j) w[j] = (s0 + j <= t) ? gacc[j] : 0.f;
                    }
                    ow = (v2u){pk2(w[0], w[1]), pk2(w[2], w[3])};
                }
                *(LAS v2u*)(WT + t * S_KT + s0) = ow; } }
        __syncthreads();
        { const int tb = wave >> 1, pb = wave & 1; const int t = 16 * tb + fr, p0 = 16 * pb + 4 * fq;
            f32x4 y = (f32x4){0.f, 0.f, 0.f, 0.f};
            y = mma_rows(QC, S_QC, 16 * tb, ST, S_QC, 16 * pb, 128, y, fr, fq);
            if (SSD) y = y * __expf(ACUM[t]);
            y = mma_rows(WT, S_KT, 16 * tb, XT, S_KT, 16 * pb, 64, y, fr, fq);
            if (SSD) { const v2u xw = *(const LAS v2u*)(XN + t * S_XN + p0); y[0] += Dh * bflo(xw.x); y[1] += Dh * bfhi(xw.x); y[2] += Dh * bflo(xw.y); y[3] += Dh * bfhi(xw.y); }
            *(v2u*)(PROJ + (t0 + t) * NIN + colX + p0) = (v2u){pk2(y[0], y[1]), pk2(y[2], y[3])};
            f32x4 dec;
            if (SSD) { const float d = __expf(ACUM[63]); dec = (f32x4){d, d, d, d}; } else dec = *(const LAS f32x4*)(DEC + 16 * wave + 4 * fq);
#pragma unroll
            for (int q = 0; q < 2; ++q) st[q] = mma_rows(XS, S_KT, 16 * q, KT, S_KT, 16 * wave, 64, st[q] * dec, fr, fq);
            if (SSD && tid < 108) { const LAS bf16* src = tid < 48 ? RB + (64 + tid / 16) * 128 + (tid % 16) * 8 : (tid < 96 ? RC + (64 + (tid - 48) / 16) * 128 + ((tid - 48) % 16) * 8 : RX + (64 + (tid - 96) / 4) * 32 + ((tid - 96) % 4) * 8);
                halo = *(const LAS v4u*)src; }
        }
        __syncthreads();
#pragma unroll
        for (int q = 0; q < 2; ++q) *(LAS v2u*)(ST + (16 * q + fr) * S_QC + 16 * wave + 4 * fq) = (v2u){pk2(st[q][0], st[q][1]), pk2(st[q][2], st[q][3])};
        if (SSD && tid < 108) { LAS bf16* dst = tid < 48 ? RB + (tid / 16) * 128 + (tid % 16) * 8 : (tid < 96 ? RC + ((tid - 48) / 16) * 128 + ((tid - 48) % 16) * 8 : RX + ((tid - 96) / 4) * 32 + ((tid - 96) % 4) * 8);
            *(LAS v4u*)dst = halo; }
    }
    if (SSD) {
#pragma unroll
        for (int q = 0; q < 2; ++q) *(f32x4*)(out + O_SSMP + (((size_t)(b * 16 + h) * 64 + half * 32 + 16 * q + fr) * 128 + 16 * wave + 4 * fq)) = st[q];
        if (tid < 108) { int r, cc; bool wr_ = true;
            if (tid < 48) { r = tid / 16; cc = 1024 + g * 128 + (tid % 16) * 8; wr_ = ((h & 3) == 0 && half == 0); }
            else if (tid < 96) { r = (tid - 48) / 16; cc = 1536 + g * 128 + ((tid - 48) % 16) * 8; wr_ = ((h & 3) == 0 && half == 0); }
            else { r = (tid - 96) / 4; cc = h * 64 + half * 32 + ((tid - 96) % 4) * 8; }
            if (wr_) { float f[8]; unpack8(halo, f); float* o = out + O_CONVP + ((size_t)(b * 3 + r) * 2048 + cc);
                *(f32x4*)o = (f32x4){f[0], f[1], f[2], f[3]}; *(f32x4*)(o + 4) = (f32x4){f[4], f[5], f[6], f[7]}; } }
    } else {
#pragma unroll
        for (int q = 0; q < 2; ++q)
#pragma unroll
            for (int j = 0; j < 4; ++j) out[O_HGP + (((size_t)(b * 8 + hd) * 128 + 16 * wave + 4 * fq + j) * 128 + vq * 32 + 16 * q + fr)] = st[q][j];
    }
    __syncthreads();
#undef LOAD_REGS
#undef STORE_RAW
}

__device__ __forceinline__ void ssd_sample_job(int job, bf16* PROJ, const float* const* in, float* out, LAS unsigned char* lds, int tid) {
    const int sb = job >> 4, h = job & 15, g = h >> 2; const size_t row0 = (size_t)TP + 4 * sb;
    LAS float* SX = (LAS float*)lds; LAS float* SBm = SX + 4 * 64; LAS float* SCm = SBm + 4 * 128; LAS float* SDT = SCm + 4 * 128;
    if (tid < 320) {
        int col, cc; LAS float* dst; int dstride, di;
        if (tid < 64) { col = C_XM + h * 64 + tid; cc = h * 64 + tid; dst = SX; dstride = 64; di = tid; }
        else if (tid < 192) { col = C_B + g * 128 + (tid - 64); cc = 1024 + g * 128 + (tid - 64); dst = SBm; dstride = 128; di = tid - 64; }
        else { col = C_C + g * 128 + (tid - 192); cc = 1536 + g * 128 + (tid - 192); dst = SCm; dstride = 128; di = tid - 192; }
        float u[7];
#pragma unroll
        for (int j = 0; j < 3; ++j) u[j] = in[2][((size_t)sb * 3 + j) * 2048 + cc];
#pragma unroll
        for (int j = 0; j < 4; ++j) u[3 + j] = bf2f(PROJ[(row0 + j) * NIN + col]);
        const float w0 = in[11][cc], w1 = in[11][2048 + cc], w2 = in[11][4096 + cc], w3 = in[11][6144 + cc], bb = in[12][cc];
#pragma unroll
        for (int t = 0; t < 4; ++t) dst[t * dstride + di] = siluf(bb + w0 * u[t] + w1 * u[t + 1] + w2 * u[t + 2] + w3 * u[t + 3]);
        if (tid < 64 || (h & 3) == 0) {
#pragma unroll
            for (int j = 0; j < 3; ++j) out[O_CONVS + ((size_t)sb * 3 + j) * 2048 + cc] = u[4 + j];
        }
    } else if (tid < 324) { const int t = tid - 320; const float xr = bf2f(PROJ[(row0 + t) * NIN + C_DT + h]) + in[13][h]; SDT[t] = xr > 20.f ? xr : log1pf(__expf(xr)); }
    __syncthreads();
    const int p = tid >> 3, nq = tid & 7;
    const float a_neg = -__expf(in[14][h]), Dh = in[15][h];
    const size_t sbase = (((size_t)sb * 16 + h) * 64 + p) * 128 + 16 * nq;
    float hs[16];
#pragma unroll
    for (int i = 0; i < 4; ++i) { const f32x4 v = *(const f32x4*)(in[3] + sbase + 4 * i); hs[4 * i] = v[0]; hs[4 * i + 1] = v[1]; hs[4 * i + 2] = v[2]; hs[4 * i + 3] = v[3]; }
#pragma unroll
    for (int t = 0; t < 4; ++t) {
        const float dt = SDT[t], dec = __expf(dt * a_neg), xv = SX[t * 64 + p], xb = dt * xv; float part = 0.f;
#pragma unroll
        for (int i = 0; i < 16; ++i) { hs[i] = dec * hs[i] + xb * SBm[t * 128 + 16 * nq + i]; part += hs[i] * SCm[t * 128 + 16 * nq + i]; }
        part += __shfl_xor(part, 1); part += __shfl_xor(part, 2); part += __shfl_xor(part, 4);
        if (nq == 0) PROJ[(row0 + t) * NIN + C_XM + h * 64 + p] = (bf16)f2bf(part + Dh * xv);
    }
#pragma unroll
    for (int i = 0; i < 4; ++i) *(f32x4*)(out + O_SSMS + sbase + 4 * i) = (f32x4){hs[4 * i], hs[4 * i + 1], hs[4 * i + 2], hs[4 * i + 3]};
    __syncthreads();
}
__device__ __forceinline__ void hgrn_sample_job(int job, bf16* PROJ, const float* const* in, float* out, LAS unsigned char* lds, int tid) {
    const int sb = job >> 3, hd = job & 7; const size_t row0 = (size_t)TP + 4 * sb;
    LAS float* SQ = (LAS float*)lds; LAS float* SF = SQ + 512; LAS float* SK = SF + 512; LAS float* SV = SK + 512; LAS float* PP = SV + 512;
    if (tid < 128) { const int k = tid; const float lb = sigm(in[18][hd * 128 + k] - in[18][1024 + hd * 128 + k]);
#pragma unroll
        for (int t = 0; t < 4; ++t) { const float frw = bf2f(PROJ[(row0 + t) * NIN + C_F + hd * 128 + k]), q = bf2f(PROJ[(row0 + t) * NIN + C_Q + hd * 128 + k]);
            const float sg = sigm(frw); SF[t * 128 + k] = lb + (1.f - lb) * sg; SK[t * 128 + k] = (1.f - lb) * (1.f - sg); SQ[t * 128 + k] = q; } }
    else if (tid < 256) { const int v = tid - 128;
#pragma unroll
        for (int t = 0; t < 4; ++t) SV[t * 128 + v] = bf2f(PROJ[(row0 + t) * NIN + C_I + hd * 128 + v]); }
    __syncthreads();
    const int v4 = tid & 31, kq = tid >> 5;
    const size_t sbase = (((size_t)sb * 8 + hd) * 128 + 8 * kq) * 128 + 4 * v4;
    f32x4 s[8];
#pragma unroll
    for (int i = 0; i < 8; ++i) s[i] = *(const f32x4*)(in[4] + sbase + (size_t)i * 128);
#pragma unroll
    for (int t = 0; t < 4; ++t) { const f32x4 vv = *(const LAS f32x4*)(SV + t * 128 + 4 * v4); f32x4 part = (f32x4){0.f, 0.f, 0.f, 0.f};
#pragma unroll
        for (int i = 0; i < 8; ++i) { const float f = SF[t * 128 + 8 * kq + i], kk = SK[t * 128 + 8 * kq + i], q = SQ[t * 128 + 8 * kq + i];
            s[i] = s[i] * f + vv * kk; part += s[i] * q; }
        *(LAS f32x4*)(PP + (t * 16 + kq) * 128 + 4 * v4) = part; }
#pragma unroll
    for (int i = 0; i < 8; ++i) *(f32x4*)(out + O_HGS + sbase + (size_t)i * 128) = s[i];
    __syncthreads();
    { const int t = tid >> 7, v = tid & 127; float o = 0.f;
#pragma unroll
        for (int q = 0; q < 16; ++q) o += PP[(t * 16 + q) * 128 + v];
        PROJ[(row0 + t) * NIN + C_I + hd * 128 + v] = (bf16)f2bf(o); }
    __syncthreads();
}
#ifndef MK_N_LAUNCHES
#define MK_N_LAUNCHES 1
#endif
constexpr int NPH = 14;
struct Args { const float* in[29]; float* out; unsigned char* ws; int ph_lo, ph_hi; };
static_assert(sizeof(Args) == 29 * 8 + 8 + 8 + 8, "Args has no padding");

__global__ void __launch_bounds__(NTHR, 2) mk_fwd(Args args) {
    extern __shared__ __attribute__((aligned(16))) unsigned char lds_raw[];
    LAS unsigned char* lds = (LAS unsigned char*)lds_raw;
    volatile LAS unsigned* MISC = (volatile LAS unsigned*)(lds + MISC_OFF);
    const int tid = threadIdx.x, lane = tid & 63, wave = __builtin_amdgcn_readfirstlane(tid >> 6);
    const int G = gridDim.x; const int bx = blockIdx.x; const int vcu = (G % 8 == 0) ? (bx % 8) * (G / 8) + bx / 8 : bx;
    const float* const* in = args.in; float* out = args.out; unsigned char* outb = (unsigned char*)args.out; unsigned char* ws = args.ws;
    for (int u = tid; u < (LDS_BYTES - LDSCTL_OFF) / 4; u += NTHR) ((LAS unsigned*)(lds + LDSCTL_OFF))[u] = 0u;
    __syncthreads();
    const int lo = args.ph_lo, hi = args.ph_hi;
    XcdBarrier bar; bar.bar = (unsigned*)(ws + WS_CTL) + CW_BAR; bar.x = 0; bar.st = nullptr;
    if (hi - lo > 1) bar = xcd_barrier_post((unsigned*)(ws + WS_CTL) + CW_BAR, MISC + 8);
#ifndef PH_MASK
#define PH_MASK 0x3fff
#endif
#define IN(k) ((((PH_MASK) >> (k)) & 1) && lo <= (k) && (k) < hi)
#define SEAM(k) do { if (IN(k) && IN((k) + 1)) xcd_barrier(bar); } while (0)
    bf16* PROJ = (bf16*)(ws + WS_PROJ);
    float* Y = out + O_Y;

    if (IN(0)) { p0_prologue(in, outb, ws, lds, vcu, G, wave, lane); } SEAM(0);
    if (IN(1)) { pg8::Gemm g{(const bf16*)(outb + OS_XB), (const bf16*)(outb + OS_W1A), T, NGU, D, D}; pg8::StaticOrder S; S.init(T, NGU, G, bx);
        EpiSwiGLU E{(bf16*)(ws + WS_H)}; pg8::gemm_phase<EpiSwiGLU, pg8::StaticOrder, true, true>(lds, g, S, E); } SEAM(1);
    if (IN(2)) { pg8::Gemm g{(const bf16*)(ws + WS_H), (const bf16*)(outb + OS_W1D), T, D, FF, FF}; pg8::StaticOrder S; S.init(T, D, G, bx);
        EpiResid E{in[0], in[1], Y, 0.5f}; pg8::gemm_phase<EpiResid, pg8::StaticOrder, true, true>(lds, g, S, E); } SEAM(2);
    if (IN(3)) { ln_phase(Y, (bf16*)(outb + OS_XB), in[8], in[9], vcu, G, wave, lane); } SEAM(3);
    if (IN(4)) { pg8::Gemm g{(const bf16*)(outb + OS_XB), (const bf16*)(outb + OS_WIN), T, NINP, D, D}; pg8::StaticOrder S; S.init(T, NINP, G, bx);
        EpiBf16N E{PROJ, NIN, NIN}; pg8::gemm_phase<EpiBf16N, pg8::StaticOrder, true, true>(lds, g, S, E); } SEAM(4);
    if (IN(5)) {
#ifndef SCAN_MASK
#define SCAN_MASK 15
#endif
        if (SCAN_MASK & 1) for (int job = bx; job < 256; job += G) scan_prompt_job<true>(job, PROJ, in, out, lds, tid, wave, lane);
        if (SCAN_MASK & 2) for (int job = bx; job < 256; job += G) scan_prompt_job<false>(job, PROJ, in, out, lds, tid, wave, lane);
        if (SCAN_MASK & 4) for (int job = bx; job < DB * 16; job += G) ssd_sample_job(job, PROJ, in, out, lds, tid);
        if (SCAN_MASK & 8) for (int job = bx; job < DB * 8; job += G) hgrn_sample_job(job, PROJ, in, out, lds, tid);
    } SEAM(5);
    if (IN(6)) { norm_phase(PROJ, in[16], in[19], vcu, G, wave, lane); } SEAM(6);
    if (IN(7)) { pg8::Gemm g{PROJ + C_XM, (const bf16*)(ws + WS_WMO), T, D, D, NIN}; pg8::StaticOrder S; S.init(T, D, G, bx);
        EpiGate<false> E{PROJ + C_GM, PROJ + C_Z}; pg8::gemm_phase<EpiGate<false>, pg8::StaticOrder, true, true>(lds, g, S, E); } SEAM(7);
    if (IN(8)) { pg8::Gemm g{PROJ + C_I, (const bf16*)(ws + WS_WHO), T, D, D, NIN}; pg8::StaticOrder S; S.init(T, D, G, bx);
        EpiGate<true> E{PROJ + C_GH, PROJ + C_Z}; pg8::gemm_phase<EpiGate<true>, pg8::StaticOrder, true, true>(lds, g, S, E); } SEAM(8);
    if (IN(9)) { pg8::Gemm g{PROJ + C_Z, (const bf16*)(ws + WS_WO), T, D, D, NIN}; pg8::StaticOrder S; S.init(T, D, G, bx);
        EpiResid E{Y, nullptr, Y, 1.0f}; pg8::gemm_phase<EpiResid, pg8::StaticOrder, true, true>(lds, g, S, E); } SEAM(9);
    if (IN(10)) { ln_phase(Y, (bf16*)(ws + WS_X2B), in[22], in[23], vcu, G, wave, lane);
        ffn_weight_items(in[24], in[25], in[26], (bf16*)(ws + WS_W2A), (bf16*)(ws + WS_W2D), (LAS float*)(lds + wave * 16384), vcu * NWAVES + wave, G * NWAVES, lane); } SEAM(10);
    if (IN(11)) { pg8::Gemm g{(const bf16*)(ws + WS_X2B), (const bf16*)(ws + WS_W2A), T, NGU, D, D}; pg8::StaticOrder S; S.init(T, NGU, G, bx);
        EpiSwiGLU E{(bf16*)(ws + WS_H)}; pg8::gemm_phase<EpiSwiGLU, pg8::StaticOrder, true, true>(lds, g, S, E); } SEAM(11);
    if (IN(12)) { pg8::Gemm g{(const bf16*)(ws + WS_H), (const bf16*)(ws + WS_W2D), T, D, FF, FF}; pg8::StaticOrder S; S.init(T, D, G, bx);
        EpiResid E{Y, nullptr, Y, 0.5f}; pg8::gemm_phase<EpiResid, pg8::StaticOrder, true, true>(lds, g, S, E); } SEAM(12);
    if (IN(13)) { ln_phase(Y, nullptr, in[27], in[28], vcu, G, wave, lane); }
#undef IN
#undef SEAM
}

extern "C" void kernel_launch(void* const* d_in, const int* in_sizes, int n_in, void* d_out, int out_size, void* d_ws, size_t ws_size, hipStream_t stream) {
    static int grid = 0;
    if (grid == 0) {
        if (n_in != 29 || out_size != (int)O_END || ws_size < WS_END) { fprintf(stderr, "kernel_launch: unexpected shapes (n_in %d, out %d, ws %zu < %zu)\n", n_in, out_size, ws_size, (size_t)WS_END); grid = -1; return; }
        int dev = 0, cus = 0, per_cu = 0;
        if (hipGetDevice(&dev) != hipSuccess || hipDeviceGetAttribute(&cus, hipDeviceAttributeMultiprocessorCount, dev) != hipSuccess) { grid = -1; return; }
        if (hipFuncSetAttribute((const void*)mk_fwd, hipFuncAttributeMaxDynamicSharedMemorySize, LDS_BYTES) != hipSuccess) { fprintf(stderr, "kernel_launch: hipFuncSetAttribute failed\n"); grid = -1; return; }
        if (hipOccupancyMaxActiveBlocksPerMultiprocessor(&per_cu, (const void*)mk_fwd, NTHR, LDS_BYTES) != hipSuccess || per_cu < 1) { fprintf(stderr, "kernel_launch: occupancy query says %d\n", per_cu); }
        (void)hipGetLastError();
        grid = cus;
    }
    if (grid < 0) return;
    (void)hipMemsetAsync((char*)d_ws + WS_CTL, 0, CTL_ZERO_BYTES, stream);
    Args a{};
    for (int i = 0; i < 29; ++i) a.in[i] = (const float*)d_in[i];
    a.out = (float*)d_out; a.ws = (unsigned char*)d_ws;
    if (MK_N_LAUNCHES == 1) { a.ph_lo = 0; a.ph_hi = NPH; hipLaunchKernelGGL(mk_fwd, dim3(grid), dim3(NTHR), LDS_BYTES, stream, a); }
    else { for (int p = 0; p < NPH; ++p) { a.ph_lo = p; a.ph_hi = p + 1; hipLaunchKernelGGL(mk_fwd, dim3(grid), dim3(NTHR), LDS_BYTES, stream, a); } }
}
```

```cpp
#include <hip/hip_runtime.h>
#include <cstdio>
#include <cstdint>
#define MK_N_LAUNCHES 1
#define DUP_MASK 0
#define DRY_SCAN_MASK 15
namespace pg8 {
#define PG8_LAS __attribute__((address_space(3)))
typedef unsigned short bf16_t;
typedef short bf16x8 __attribute__((ext_vector_type(8)));
typedef float f32x4 __attribute__((ext_vector_type(4)));
typedef unsigned u32x4 __attribute__((ext_vector_type(4)));
typedef unsigned u32x2 __attribute__((ext_vector_type(2)));
constexpr int BM = 256, BK = 64, HALF = 128, HTB = HALF * BK * 2  , STAGE_BYTES = 8 * HTB, NXCD = 8, WGM = 8;

__host__ __device__ __forceinline__ int lds_byte(int r, int c) { const int st = (r >> 4) * 2 + (c >> 5), rr = r & 15, cc = c & 31, ob = rr * 64 + cc * 2; return st * 1024 + (ob ^ (((ob >> 9) & 1) << 5)); }
__host__ __device__ __forceinline__ void stage_rc(int b, int& R, int& C) { const int st = b / 1024, sb = b % 1024, swz = sb ^ (((sb >> 9) & 1) << 5); R = (st >> 1) * 16 + swz / 64; C = (st & 1) * 32 + (swz % 64) / 2; }
__host__ __device__ __forceinline__ int perm32(int rho) { const int n = rho >> 4, i = rho & 15; return 8 * (i >> 2) + 4 * n + (i & 3); }

struct Unit { int pm, pn; };
struct Gemm { const bf16_t* A; const bf16_t* Bt; int M, N, K, lda; };

struct StaticOrder {
    int nM, nN, nwg, G, c;
    __host__ __device__ void init(int M, int N, int G_, int c_) { nM = M / BM; nN = N / BM; nwg = nM * nN; G = G_; c = c_; }
    __host__ __device__ bool next(int i, Unit& u) const {
        const long L = (long)i * G + c; if (L >= nwg) return false;
        int wgid = (int)L; { const int q = nwg / NXCD, r = nwg % NXCD, xcd = wgid % NXCD, off = wgid / NXCD; wgid = (xcd < r ? xcd * (q + 1) : r * (q + 1) + (xcd - r) * q) + off; }
        const int nig = WGM * nN, gid = wgid / nig, fm = gid * WGM, gsz = (nM - fm) < WGM ? (nM - fm) : WGM;
        u.pm = fm + ((wgid % nig) % gsz); u.pn = (wgid % nig) / gsz; return true;
    }
};

__device__ __forceinline__ unsigned cvt_pk_bf16(float lo, float hi) { unsigned r; asm volatile("v_cvt_pk_bf16_f32 %0, %1, %2" : "=v"(r) : "v"(lo), "v"(hi)); return r; }

template <class Epi, class Sched, bool ALIGN_EPI = false, bool SP2 = false>
__device__ __forceinline__ void gemm_phase(PG8_LAS unsigned char* lds, const Gemm g, const Sched& S, const Epi& E) {
    const int tid = threadIdx.x, wid = __builtin_amdgcn_readfirstlane(tid >> 6), lane = tid & 63, wr = wid >> 2, wc = wid & 3, fr = lane & 15, fq = lane >> 4;
    const int K = g.K, nt = K / BK, lda = g.lda;
    unsigned voffA[2], voffB[2];
#pragma unroll
    for (int i = 0; i < 2; ++i) { int R, C; stage_rc(tid * 16 + i * 8192, R, C); const int Rb = Epi::PERM ? ((R & ~31) + perm32(R & 31)) : R;
        voffA[i] = (unsigned)(R * lda + C) * 2u; voffB[i] = (unsigned)(Rb * K + C) * 2u; }
    const size_t kstep = (size_t)(BK * 2);
    const size_t hstepA = (size_t)HALF * lda * 2, hstepB = (size_t)HALF * K * 2;
    const size_t tstepA = 2 * hstepA, tstepB = 2 * hstepB;
    const unsigned ldsw = (unsigned)wid * 1024u;
    const int aoff = lds_byte(wr * 64 + fr, fq * 8), boff = lds_byte(wc * 32 + fr, fq * 8);
#define PG8_SA(b, h) (((b) * 2 + (h)) * HTB)
#define PG8_SB(b, h) ((4 + (b) * 2 + (h)) * HTB)
#define PG8_STAGE(bufoff, gbase, voff) do { _Pragma("unroll") for (int _i = 0; _i < 2; ++_i) \
        __builtin_amdgcn_global_load_lds((const unsigned*)((const char*)(gbase) + (voff)[_i]), (PG8_LAS unsigned*)(lds + (bufoff) + ldsw + _i * 8192), 16, 0, 0); } while (0)
#define PG8_LDA(dst, b, h) do { _Pragma("unroll") for (int m = 0; m < 4; ++m) _Pragma("unroll") for (int k = 0; k < 2; ++k) dst[m][k] = *(const PG8_LAS bf16x8*)(lds + PG8_SA(b, h) + aoff + m * 2048 + k * 1024); } while (0)
#define PG8_LDB(dst, b, h) do { _Pragma("unroll") for (int n = 0; n < 2; ++n) _Pragma("unroll") for (int k = 0; k < 2; ++k) dst[n][k] = *(const PG8_LAS bf16x8*)(lds + PG8_SB(b, h) + boff + n * 2048 + k * 1024); } while (0)
#define PG8_MMA(ai, bj, At, Bt) do { __builtin_amdgcn_s_setprio(1); _Pragma("unroll") for (int m = 0; m < 4; ++m) _Pragma("unroll") for (int n = 0; n < 2; ++n) _Pragma("unroll") for (int k = 0; k < 2; ++k) \
        acc[ai][bj][m][n] = __builtin_amdgcn_mfma_f32_16x16x32_bf16(Bt[n][k], At[m][k], acc[ai][bj][m][n], 0, 0, 0); __builtin_amdgcn_s_setprio(0); } while (0)
#define PG8_WAIT_V(n) asm volatile("s_waitcnt vmcnt(" #n ")" ::: "memory")
#define PG8_WAIT_L(n) asm volatile("s_waitcnt lgkmcnt(" #n ")" ::: "memory")
#define PG8_BAR __builtin_amdgcn_s_barrier()
#define PG8_SCHED __builtin_amdgcn_sched_barrier(0)
    Unit cur, nxt; int ui = 0;
    if (!S.next(0, cur)) return;
    f32x4 acc[2][2][4][2];
#pragma unroll
    for (int a = 0; a < 2; ++a)
#pragma unroll
        for (int b = 0; b < 2; ++b)
#pragma unroll
            for (int m = 0; m < 4; ++m)
#pragma unroll
                for (int n = 0; n < 2; ++n) acc[a][b][m][n] = (f32x4){0.f, 0.f, 0.f, 0.f};
    bf16x8 At[4][2], B0[2][2], B1[2][2];
    const char* cA = (const char*)g.A + (size_t)cur.pm * tstepA; const char* cB = (const char*)g.Bt + (size_t)cur.pn * tstepB;
    if constexpr (SP2) {
        PG8_STAGE(PG8_SB(0, 0), cB, voffB); PG8_STAGE(PG8_SB(0, 1), cB + hstepB, voffB); PG8_STAGE(PG8_SA(0, 0), cA, voffA); PG8_STAGE(PG8_SA(0, 1), cA + hstepA, voffA);
        if (wr == 1) PG8_BAR;
        PG8_WAIT_V(2); PG8_BAR;
        PG8_STAGE(PG8_SB(1, 0), cB + kstep, voffB); PG8_STAGE(PG8_SA(1, 0), cA + kstep, voffA); PG8_STAGE(PG8_SB(1, 1), cB + hstepB + kstep, voffB);
        PG8_WAIT_V(6); PG8_BAR;
    } else {
        PG8_STAGE(PG8_SB(0, 0), cB, voffB); PG8_STAGE(PG8_SA(0, 0), cA, voffA); PG8_STAGE(PG8_SB(0, 1), cB + hstepB, voffB); PG8_STAGE(PG8_SA(0, 1), cA + hstepA, voffA);
        if (wr == 1) PG8_BAR;
        PG8_WAIT_V(4); PG8_BAR;
        PG8_STAGE(PG8_SB(1, 0), cB + kstep, voffB); PG8_STAGE(PG8_SA(1, 0), cA + kstep, voffA); PG8_STAGE(PG8_SB(1, 1), cB + hstepB + kstep, voffB);
        PG8_WAIT_V(6); PG8_BAR;
    }
    for (;;) {
        const bool has_next = S.next(ui + 1, nxt);
        const char* nA = has_next ? (const char*)g.A + (size_t)nxt.pm * tstepA : cA; const char* nB = has_next ? (const char*)g.Bt + (size_t)nxt.pn * tstepB : cB;
        for (int t = 0; t < nt; t += 2) {
            const bool last = (t == nt - 2);
            const char* a1 = cA + (size_t)(t + 1) * kstep;
            const char* a2 = last ? nA : cA + (size_t)(t + 2) * kstep; const char* b2 = last ? nB : cB + (size_t)(t + 2) * kstep;
            const char* a3 = a2 + kstep; const char* b3 = b2 + kstep;
            if constexpr (SP2) {
            PG8_LDB(B0, 0, 0); PG8_LDB(B1, 0, 1); PG8_SCHED; PG8_LDA(At, 0, 0); PG8_STAGE(PG8_SA(1, 1), a1 + hstepA, voffA);
            PG8_WAIT_V(8); PG8_WAIT_L(0); PG8_BAR; PG8_MMA(0, 0, At, B0); PG8_MMA(0, 1, At, B1); PG8_BAR; PG8_SCHED;
            PG8_LDA(At, 0, 1); PG8_STAGE(PG8_SB(0, 0), b2, voffB); PG8_STAGE(PG8_SB(0, 1), b2 + hstepB, voffB); PG8_STAGE(PG8_SA(0, 0), a2, voffA);
            PG8_WAIT_V(8); PG8_WAIT_L(0); PG8_BAR; PG8_MMA(1, 0, At, B0); PG8_MMA(1, 1, At, B1); PG8_BAR; PG8_SCHED;
            PG8_LDB(B0, 1, 0); PG8_LDB(B1, 1, 1); PG8_SCHED; PG8_LDA(At, 1, 0); PG8_STAGE(PG8_SA(0, 1), a2 + hstepA, voffA);
            PG8_WAIT_V(8); PG8_WAIT_L(0); PG8_BAR; PG8_MMA(0, 0, At, B0); PG8_MMA(0, 1, At, B1); PG8_BAR; PG8_SCHED;
            PG8_LDA(At, 1, 1); PG8_STAGE(PG8_SB(1, 0), b3, voffB); PG8_STAGE(PG8_SB(1, 1), b3 + hstepB, voffB); PG8_STAGE(PG8_SA(1, 0), a3, voffA);
            PG8_WAIT_V(8); PG8_WAIT_L(0); PG8_BAR; PG8_MMA(1, 0, At, B0); PG8_MMA(1, 1, At, B1); PG8_BAR; PG8_SCHED;
            } else {
            PG8_LDB(B0, 0, 0); PG8_SCHED; PG8_LDA(At, 0, 0); PG8_STAGE(PG8_SA(1, 1), a1 + hstepA, voffA);
            PG8_WAIT_L(8); PG8_BAR; PG8_WAIT_L(0); PG8_MMA(0, 0, At, B0); PG8_BAR; PG8_SCHED;
            PG8_LDB(B1, 0, 1); PG8_STAGE(PG8_SB(0, 0), b2, voffB);
            PG8_BAR; PG8_WAIT_L(0); PG8_MMA(0, 1, At, B1); PG8_BAR;
            PG8_LDA(At, 0, 1); PG8_STAGE(PG8_SA(0, 0), a2, voffA);
            PG8_BAR; PG8_WAIT_L(0); PG8_MMA(1, 0, At, B0); PG8_BAR; PG8_SCHED;
            PG8_STAGE(PG8_SB(0, 1), b2 + hstepB, voffB);
            PG8_WAIT_V(6); PG8_BAR; PG8_MMA(1, 1, At, B1); PG8_BAR;
            PG8_LDB(B0, 1, 0); PG8_SCHED; PG8_LDA(At, 1, 0); PG8_STAGE(PG8_SA(0, 1), a2 + hstepA, voffA);
            PG8_WAIT_L(8); PG8_BAR; PG8_WAIT_L(0); PG8_MMA(0, 0, At, B0); PG8_BAR; PG8_SCHED;
            PG8_LDB(B1, 1, 1); PG8_STAGE(PG8_SB(1, 0), b3, voffB);
            PG8_BAR; PG8_WAIT_L(0); PG8_MMA(0, 1, At, B1); PG8_BAR;
            PG8_LDA(At, 1, 1); PG8_STAGE(PG8_SA(1, 0), a3, voffA);
            PG8_BAR; PG8_WAIT_L(0); PG8_MMA(1, 0, At, B0); PG8_BAR; PG8_SCHED;
            PG8_STAGE(PG8_SB(1, 1), b3 + hstepB, voffB);
            PG8_WAIT_V(6); PG8_BAR; PG8_MMA(1, 1, At, B1); PG8_BAR;
            }
        }
        if constexpr (ALIGN_EPI) { if (wr == 0) PG8_BAR; }
        E(acc, cur, wr, wc, fr, fq);
        if (!has_next) break;
#pragma unroll
        for (int a = 0; a < 2; ++a)
#pragma unroll
            for (int b = 0; b < 2; ++b)
#pragma unroll
                for (int m = 0; m < 4; ++m)
#pragma unroll
                    for (int n = 0; n < 2; ++n) acc[a][b][m][n] = (f32x4){0.f, 0.f, 0.f, 0.f};
        cur = nxt; cA = nA; cB = nB; ++ui;
        if constexpr (ALIGN_EPI) { if (wr == 1) PG8_BAR; }
    }
    PG8_WAIT_V(0);
    if constexpr (!ALIGN_EPI) { if (wr == 0) PG8_BAR; }
    PG8_BAR;
#undef PG8_SA
#undef PG8_SB
#undef PG8_STAGE
#undef PG8_LDA
#undef PG8_LDB
#undef PG8_MMA
#undef PG8_WAIT_V
#undef PG8_WAIT_L
#undef PG8_BAR
#undef PG8_SCHED
}
}
#define GAS __attribute__((address_space(1)))
#define LAS __attribute__((address_space(3)))
typedef unsigned short bf16;
typedef unsigned v4u __attribute__((ext_vector_type(4)));
typedef unsigned v2u __attribute__((ext_vector_type(2)));
typedef float f32x4 __attribute__((ext_vector_type(4)));
typedef short bf16x8 __attribute__((ext_vector_type(8)));
typedef GAS unsigned gu32;
#define RLX_AGENT __ATOMIC_RELAXED, __HIP_MEMORY_SCOPE_AGENT
#define LDS_WAIT() asm volatile("s_waitcnt lgkmcnt(0)" ::: "memory")
#define VM_WAIT() asm volatile("s_waitcnt vmcnt(0)" ::: "memory")

constexpr int NWAVES = 8, NTHR = 512;
constexpr int T = 16896, TP = 16384, D = 1024, FF = 2816, NGU = 2 * FF, NIN = 9232, NINP = 9472;
constexpr int SEQ = 2048, NB = 8, DB = 128, DSEQ = 4;
constexpr float ALPHA = 1.189207115002721f, EPS = 1e-5f;
constexpr int C_Z = 0, C_XM = 1024, C_B = 2048, C_C = 2560, C_Q = 3072, C_F = 4096, C_I = 5120, C_OG = 6144, C_GM = 7168, C_GH = 8192, C_DT = 9216;
constexpr size_t O_Y = 0, O_CONVP = 17301504, O_SSMP = 17350656, O_HGP = 18399232, O_CONVS = 19447808, O_SSMS = 20234240, O_HGS = 37011456, O_END = 53788672;
constexpr size_t MiB = 1u << 20;
constexpr size_t OS_XB = O_SSMS * 4, OS_W1A = O_SSMS * 4 + 36 * MiB, OS_W1D = O_SSMS * 4 + 48 * MiB, OS_WIN = O_HGS * 4;
constexpr size_t WS_CTL = 0, CTL_ZERO_BYTES = 64 * 1024, WS_WMO = 1 * MiB, WS_WHO = 3 * MiB, WS_WO = 5 * MiB, WS_B = 8 * MiB;
constexpr size_t WS_PROJ = WS_B, WS_X2B = WS_B, WS_W2A = WS_B + 36 * MiB, WS_W2D = WS_B + 48 * MiB, WS_H = WS_B + 64 * MiB;
constexpr size_t WS_END = WS_B + (size_t)T * NIN * 2;
static_assert(WS_H + (size_t)T * FF * 2 <= WS_END, "H fits region B");
constexpr int CW_BAR = 1024;
constexpr int RING_BYTES = 131072, LDSCTL_OFF = RING_BYTES, MISC_OFF = LDSCTL_OFF + 320, LDS_BYTES = 147456;

__device__ __forceinline__ unsigned f2bf(float f) { unsigned u = __builtin_bit_cast(unsigned, f); return (u + 0x7fffu + ((u >> 16) & 1u)) >> 16; }
__device__ __forceinline__ unsigned pk2(float lo, float hi) { return f2bf(lo) | (f2bf(hi) << 16); }
__device__ __forceinline__ float bf2f(unsigned u16) { return __builtin_bit_cast(float, u16 << 16); }
__device__ __forceinline__ float bflo(unsigned w) { return __builtin_bit_cast(float, w << 16); }
__device__ __forceinline__ float bfhi(unsigned w) { return __builtin_bit_cast(float, w & 0xffff0000u); }
__device__ __forceinline__ float sigm(float x) { return __builtin_amdgcn_rcpf(1.f + __expf(-x)); }
__device__ __forceinline__ float siluf(float x) { return x * sigm(x); }
__device__ __forceinline__ float wave_sum(float v) {
#pragma unroll
    for (int o = 1; o < 64; o <<= 1) v += __shfl_xor(v, o);
    return v;
}

#define XB_TMO      128
#define XB_XCNT(j)  (256  + 64 * (j))
#define XB_XSUB(j)  (1280 + 64 * (j))
#define XB_XGEN(j)  (2304 + 64 * (j))
#define XB_TOP      3328
#define XB_TOPGEN   3392
#define XCD_BAR_WORDS 3456
#define XB_SPIN_CAP (1u << 20)
__device__ __forceinline__ unsigned xb_ld(unsigned* p)              { return __hip_atomic_load(p, __ATOMIC_RELAXED, __HIP_MEMORY_SCOPE_AGENT); }
__device__ __forceinline__ unsigned xb_add(unsigned* p, unsigned v) { return __hip_atomic_fetch_add(p, v, __ATOMIC_RELAXED, __HIP_MEMORY_SCOPE_AGENT); }
__device__ __forceinline__ unsigned xb_xcc_id() { return (unsigned)__builtin_amdgcn_s_getreg((3 << 11) | 20) & 0xFu; }
#define XB_SPIN(cond, bar) do { unsigned _sp = 0; while (cond) { __builtin_amdgcn_s_sleep(1); \
    if ((++_sp & 255u) == 0u) { if (xb_ld(&(bar)[XB_TMO])) break; if (_sp > XB_SPIN_CAP) { atomicAdd(&(bar)[XB_TMO], 1u); break; } } } } while (0)
struct XcdBarrier { unsigned* bar; unsigned x; volatile LAS unsigned* st; };
__device__ __forceinline__ XcdBarrier xcd_barrier_post(unsigned* bar, volatile LAS unsigned* st) {
    XcdBarrier b; b.bar = bar; b.x = xb_xcc_id(); b.st = st;
    if (threadIdx.x == 0) (void)xb_add(&bar[XB_XCNT(b.x)], 1u);
    return b;
}
__device__ __forceinline__ void xcd_barrier_complete(unsigned* bar, unsigned x, unsigned& nloc, unsigned& nx) {
    const unsigned G = gridDim.x * gridDim.y * gridDim.z;
    unsigned sum, cnt, mine, sp = 0u;
    for (;;) {
        sum = 0u; cnt = 0u; mine = 0u;
#pragma unroll
        for (unsigned j = 0; j < 16; ++j) { const unsigned c = xb_ld(&bar[XB_XCNT(j)]); sum += c; cnt += (c > 0u) ? 1u : 0u; mine = (j == x) ? c : mine; }
        if (sum == G) break;
        __builtin_amdgcn_s_sleep(1);
        if ((++sp & 255u) == 0u) { if (xb_ld(&bar[XB_TMO])) break; if (sp > XB_SPIN_CAP) { atomicAdd(&bar[XB_TMO], 1u); break; } }
    }
    nloc = mine > 0u ? mine : 1u; nx = cnt > 0u ? cnt : 1u;
}
__device__ __forceinline__ void xcd_barrier(const XcdBarrier& b) {
    asm volatile("s_waitcnt vmcnt(0)" ::: "memory");
    __syncthreads();
    if (threadIdx.x == 0) {
        unsigned* bar = b.bar;
        __builtin_amdgcn_s_waitcnt(0);
        unsigned nloc = b.st[0], nx = b.st[1];
        if (nloc == 0u) { xcd_barrier_complete(bar, b.x, nloc, nx); b.st[0] = nloc; b.st[1] = nx; }
        const unsigned old = xb_add(&bar[XB_XSUB(b.x)], 1u);
        const unsigned gen = old / nloc;
        if (old + 1u == (gen + 1u) * nloc) {
            __builtin_amdgcn_fence(__ATOMIC_RELEASE, "agent");
            asm volatile("s_waitcnt vmcnt(0)" ::: "memory");
            const unsigned og = xb_add(&bar[XB_TOP], 1u);
            const unsigned tg = og / nx;
            if (og + 1u == (tg + 1u) * nx) xb_add(&bar[XB_TOPGEN], 1u);
            else XB_SPIN(xb_ld(&bar[XB_TOPGEN]) == tg, bar);
            __builtin_amdgcn_fence(__ATOMIC_ACQUIRE, "agent");
            xb_add(&bar[XB_XGEN(b.x)], 1u);
            asm volatile("s_waitcnt vmcnt(0)" ::: "memory");
        } else {
            XB_SPIN(xb_ld(&bar[XB_XGEN(b.x)]) == gen, bar);
            __builtin_amdgcn_fence(__ATOMIC_ACQUIRE, "agent");
            asm volatile("s_waitcnt vmcnt(0)" ::: "memory");
        }
    }
    __syncthreads();
}

using pg8::Unit;
struct EpiSwiGLU {
    static constexpr bool PERM = true;
    bf16* H;
    __device__ __forceinline__ void operator()(const f32x4 (&acc)[2][2][4][2], const Unit& u, int wr, int wc, int fr, int fq) const {
        const int row0 = u.pm * 256 + wr * 64 + fr, col0 = u.pn * 128 + wc * 32 + 8 * fq;
#pragma unroll
        for (int ai = 0; ai < 2; ++ai)
#pragma unroll
            for (int m = 0; m < 4; ++m) {
                const f32x4 g0 = acc[ai][0][m][0], g1 = acc[ai][0][m][1], u0 = acc[ai][1][m][0], u1 = acc[ai][1][m][1];
                v4u w;
                w.x = pg8::cvt_pk_bf16(siluf(g0[0]) * u0[0], siluf(g0[1]) * u0[1]); w.y = pg8::cvt_pk_bf16(siluf(g0[2]) * u0[2], siluf(g0[3]) * u0[3]);
                w.z = pg8::cvt_pk_bf16(siluf(g1[0]) * u1[0], siluf(g1[1]) * u1[1]); w.w = pg8::cvt_pk_bf16(siluf(g1[2]) * u1[2], siluf(g1[3]) * u1[3]);
                *(v4u*)(H + (size_t)(row0 + ai * 128 + m * 16) * FF + col0) = w;
            }
    }
};
struct EpiBf16N {
    static constexpr bool PERM = true;
    bf16* O; int ldc, ncols;
    __device__ __forceinline__ void operator()(const f32x4 (&acc)[2][2][4][2], const Unit& u, int wr, int wc, int fr, int fq) const {
        const int row0 = u.pm * 256 + wr * 64 + fr, col0 = u.pn * 256 + wc * 32 + 8 * fq;
#pragma unroll
        for (int ai = 0; ai < 2; ++ai)
#pragma unroll
            for (int m = 0; m < 4; ++m) { bf16* rowp = O + (size_t)(row0 + ai * 128 + m * 16) * ldc + col0;
#pragma unroll
                for (int bj = 0; bj < 2; ++bj) { const f32x4 v0 = acc[ai][bj][m][0], v1 = acc[ai][bj][m][1];
                    v4u w; w.x = pg8::cvt_pk_bf16(v0[0], v0[1]); w.y = pg8::cvt_pk_bf16(v0[2], v0[3]); w.z = pg8::cvt_pk_bf16(v1[0], v1[1]); w.w = pg8::cvt_pk_bf16(v1[2], v1[3]);
                    if (col0 + bj * 128 < ncols) *(v4u*)(rowp + bj * 128) = w; } }
    }
};
struct EpiResid {
    static constexpr bool PERM = false;
    const float* res; const float* res2; float* out; float s; bool dry;
    __device__ __forceinline__ void operator()(const f32x4 (&acc)[2][2][4][2], const Unit& u, int wr, int wc, int fr, int fq) const {
        const int row0 = u.pm * 256 + wr * 64 + fr, col0 = u.pn * 256 + wc * 32 + 4 * fq;
        const float* rb = (res2 != nullptr && u.pm >= TP / 256) ? res2 - (size_t)TP * D : res;
#pragma unroll
        for (int ai = 0; ai < 2; ++ai)
#pragma unroll
            for (int m = 0; m < 4; ++m) { const size_t off = (size_t)(row0 + ai * 128 + m * 16) * D + col0;
#pragma unroll
                for (int bj = 0; bj < 2; ++bj)
#pragma unroll
                    for (int n = 0; n < 2; ++n) { const f32x4 r = *(const f32x4*)(rb + off + bj * 128 + n * 16);
                        if (!dry) *(f32x4*)(out + off + bj * 128 + n * 16) = r * ALPHA + acc[ai][bj][m][n] * s; } }
    }
};
template <bool ADD> struct EpiGate {
    static constexpr bool PERM = true;
    const bf16* gate; bf16* dst; bool dry;
    __device__ __forceinline__ void operator()(const f32x4 (&acc)[2][2][4][2], const Unit& u, int wr, int wc, int fr, int fq) const {
        const int row0 = u.pm * 256 + wr * 64 + fr, col0 = u.pn * 256 + wc * 32 + 8 * fq;
#pragma unroll
        for (int ai = 0; ai < 2; ++ai)
#pragma unroll
            for (int m = 0; m < 4; ++m) { const size_t off = (size_t)(row0 + ai * 128 + m * 16) * NIN + col0;
#pragma unroll
                for (int bj = 0; bj < 2; ++bj) { const f32x4 v0 = acc[ai][bj][m][0], v1 = acc[ai][bj][m][1];
                    const v4u gw = *(const v4u*)(gate + off + bj * 128);
                    float r[8] = { sigm(bflo(gw.x)) * v0[0], sigm(bfhi(gw.x)) * v0[1], sigm(bflo(gw.y)) * v0[2], sigm(bfhi(gw.y)) * v0[3],
                                   sigm(bflo(gw.z)) * v1[0], sigm(bfhi(gw.z)) * v1[1], sigm(bflo(gw.w)) * v1[2], sigm(bfhi(gw.w)) * v1[3] };
                    if (ADD) { const v4u dw = *(const v4u*)(dst + off + bj * 128);
                        r[0] += bflo(dw.x); r[1] += bfhi(dw.x); r[2] += bflo(dw.y); r[3] += bfhi(dw.y); r[4] += bflo(dw.z); r[5] += bfhi(dw.z); r[6] += bflo(dw.w); r[7] += bfhi(dw.w); }
                    v4u w; w.x = pg8::cvt_pk_bf16(r[0], r[1]); w.y = pg8::cvt_pk_bf16(r[2], r[3]); w.z = pg8::cvt_pk_bf16(r[4], r[5]); w.w = pg8::cvt_pk_bf16(r[6], r[7]);
                    if (!dry) *(v4u*)(dst + off + bj * 128) = w; } }
    }
};
__device__ __forceinline__ void transpose_item(const float* W, int ldw, int srccol0, int ncopy, bf16* WT, int dstrow0, int K, int k0, LAS float* scr, int lane) {
#pragma unroll 8
    for (int i = 0; i < 32; ++i) { const int kk = 2 * i + (lane >> 5), n = lane & 31; scr[kk * 33 + n] = (n < ncopy) ? W[(size_t)(k0 + kk) * ldw + srccol0 + n] : 0.f; }
    LDS_WAIT(); asm volatile("" ::: "memory");
    const int c = lane & 7;
#pragma unroll
    for (int j = 0; j < 4; ++j) { const int n = (lane >> 3) + 8 * j; const LAS float* s = scr + (8 * c) * 33 + n;
        v4u o; o.x = pk2(s[0 * 33], s[1 * 33]); o.y = pk2(s[2 * 33], s[3 * 33]); o.z = pk2(s[4 * 33], s[5 * 33]); o.w = pk2(s[6 * 33], s[7 * 33]);
        *(v4u*)(WT + (size_t)(dstrow0 + n) * K + k0 + 8 * c) = o; }
    LDS_WAIT(); asm volatile("" ::: "memory");
}
__device__ __forceinline__ void ffn_weight_items(const float* Wg, const float* Wu, const float* Wd, bf16* WA, bf16* WD, LAS float* scr, int gw, int NGW, int lane) {
    constexpr int I_A = (NGU / 32) * (D / 64), I_D = (D / 32) * (FF / 64);
    for (int it = gw; it < I_A + I_D; it += NGW) {
        if (it < I_A) { const int gi = it / (D / 64), kb = it % (D / 64), n0 = 32 * gi, pn = n0 >> 8, bj = (n0 >> 7) & 1, i0 = n0 & 127;
            transpose_item(bj ? Wu : Wg, FF, 128 * pn + i0, 32, WA, n0, D, 64 * kb, scr, lane); }
        else { const int r = it - I_A, gi = r / (FF / 64), kb = r % (FF / 64);
            transpose_item(Wd, D, 32 * gi, 32, WD, 32 * gi, FF, 64 * kb, scr, lane); }
    }
}
__device__ __forceinline__ void p0_prologue(const float* const* in, unsigned char* outb, unsigned char* ws, LAS unsigned char* lds, int vcu, int G, int wave, int lane) {
    LAS float* scr = (LAS float*)(lds + wave * 16384);
    const int gw = vcu * NWAVES + wave, NGW = G * NWAVES;
    ffn_weight_items(in[5], in[6], in[7], (bf16*)(outb + OS_W1A), (bf16*)(outb + OS_W1D), scr, gw, NGW, lane);
    constexpr int I_IN = (NINP / 32) * (D / 64), I_SQ = (D / 32) * (D / 64);
    for (int it = gw; it < I_IN + 3 * I_SQ; it += NGW) {
        if (it < I_IN) { const int gi = it / (D / 64), kb = it % (D / 64), n0 = 32 * gi;
            int src, ncopy;
            if (n0 < 3072) { src = n0; ncopy = 32; } else if (n0 < C_DT) { src = n0 + 16; ncopy = 32; } else if (n0 == C_DT) { src = 3072; ncopy = 16; } else { src = 0; ncopy = 0; }
            transpose_item(in[10], NIN, src, ncopy, (bf16*)(outb + OS_WIN), n0, D, 64 * kb, scr, lane); }
        else { const int r = it - I_IN, w = r / I_SQ, r2 = r % I_SQ, gi = r2 / (D / 64), kb = r2 % (D / 64);
            const float* W = in[w == 0 ? 17 : (w == 1 ? 20 : 21)]; bf16* WT = (bf16*)(ws + (w == 0 ? WS_WMO : (w == 1 ? WS_WHO : WS_WO)));
            transpose_item(W, D, 32 * gi, 32, WT, 32 * gi, D, 64 * kb, scr, lane); }
    }
    bf16* XB = (bf16*)(outb + OS_XB);
    const size_t n8 = (size_t)T * D / 8, nthr = (size_t)G * NTHR;
    for (size_t i = (size_t)vcu * NTHR + threadIdx.x; i < n8; i += nthr) {
        const size_t e = i * 8; const float* src = (e < (size_t)TP * D) ? in[0] + e : in[1] + (e - (size_t)TP * D);
        const f32x4 a = *(const f32x4*)src, b = *(const f32x4*)(src + 4);
        v4u w; w.x = pk2(a[0], a[1]); w.y = pk2(a[2], a[3]); w.z = pk2(b[0], b[1]); w.w = pk2(b[2], b[3]);
        *(v4u*)(XB + e) = w;
    }
}
__device__ __forceinline__ void ln_phase(float* X, bf16* XBo, const float* gam, const float* bet, int vcu, int G, int wave, int lane, bool dry) {
    const int gw = vcu * NWAVES + wave, NGW = G * NWAVES;
    f32x4 gv[4], bv[4];
#pragma unroll
    for (int j = 0; j < 4; ++j) { gv[j] = *(const f32x4*)(gam + 4 * lane + 256 * j); bv[j] = *(const f32x4*)(bet + 4 * lane + 256 * j); }
    for (int m = gw; m < T; m += NGW) {
        f32x4* xr = (f32x4*)(X + (size_t)m * D) + lane;
        f32x4 v[4]; float s = 0.f;
#pragma unroll
        for (int j = 0; j < 4; ++j) { v[j] = xr[64 * j]; s += (v[j][0] + v[j][1]) + (v[j][2] + v[j][3]); }
        const float mean = wave_sum(s) * (1.f / D); float s2 = 0.f;
#pragma unroll
        for (int j = 0; j < 4; ++j) { v[j] = v[j] - mean; s2 += (v[j][0] * v[j][0] + v[j][1] * v[j][1]) + (v[j][2] * v[j][2] + v[j][3] * v[j][3]); }
        const float rstd = 1.f / sqrtf(wave_sum(s2) * (1.f / D) + EPS);
#pragma unroll
        for (int j = 0; j < 4; ++j) { const f32x4 o = v[j] * rstd * gv[j] + bv[j]; if (dry) continue; xr[64 * j] = o;
            if (XBo) { v2u w; w.x = pk2(o[0], o[1]); w.y = pk2(o[2], o[3]); *((v2u*)(XBo + (size_t)m * D) + lane + 64 * j) = w; } }
    }
}
__device__ __forceinline__ void norm_phase(bf16* PROJ, const float* mw, const float* hw, int vcu, int G, int wave, int lane, bool dry) {
    const int gw = vcu * NWAVES + wave, NGW = G * NWAVES;
    float mwv[16], hwv[16];
#pragma unroll
    for (int j = 0; j < 16; ++j) { mwv[j] = mw[16 * lane + j]; hwv[j] = hw[16 * lane + j]; }
    for (int m = gw; m < T; m += NGW) {
        bf16* row = PROJ + (size_t)m * NIN;
        const v4u y0 = *(const v4u*)(row + C_XM + 16 * lane), y1 = *(const v4u*)(row + C_XM + 16 * lane + 8);
        const v4u z0 = *(const v4u*)(row + C_Z + 16 * lane), z1 = *(const v4u*)(row + C_Z + 16 * lane + 8);
        const v4u o0 = *(const v4u*)(row + C_I + 16 * lane), o1 = *(const v4u*)(row + C_I + 16 * lane + 8);
        const v4u g0 = *(const v4u*)(row + C_OG + 16 * lane), g1 = *(const v4u*)(row + C_OG + 16 * lane + 8);
        float a[16], b[16];
        const unsigned yw[8] = {y0.x, y0.y, y0.z, y0.w, y1.x, y1.y, y1.z, y1.w}, zw[8] = {z0.x, z0.y, z0.z, z0.w, z1.x, z1.y, z1.z, z1.w};
        const unsigned ow[8] = {o0.x, o0.y, o0.z, o0.w, o1.x, o1.y, o1.z, o1.w}, gww[8] = {g0.x, g0.y, g0.z, g0.w, g1.x, g1.y, g1.z, g1.w};
        float sa = 0.f, sb = 0.f;
#pragma unroll
        for (int j = 0; j < 8; ++j) {
            a[2 * j] = bflo(yw[j]) * siluf(bflo(zw[j])); a[2 * j + 1] = bfhi(yw[j]) * siluf(bfhi(zw[j]));
            b[2 * j] = bflo(ow[j]); b[2 * j + 1] = bfhi(ow[j]);
            sa += a[2 * j] * a[2 * j] + a[2 * j + 1] * a[2 * j + 1]; sb += b[2 * j] * b[2 * j] + b[2 * j + 1] * b[2 * j + 1];
        }
        sb += __shfl_xor(sb, 1); sb += __shfl_xor(sb, 2); sb += __shfl_xor(sb, 4);
        sa += __shfl_xor(sa, 1); sa += __shfl_xor(sa, 2); sa += __shfl_xor(sa, 4); sa += __shfl_xor(sa, 8);
        const float ra = 1.f / sqrtf(sa * (1.f / 256.f) + EPS), rb = 1.f / sqrtf(sb * (1.f / 128.f) + EPS);
        unsigned wa[8], wb[8];
#pragma unroll
        for (int j = 0; j < 8; ++j) {
            wa[j] = pk2(a[2 * j] * ra * mwv[2 * j], a[2 * j + 1] * ra * mwv[2 * j + 1]);
            wb[j] = pk2(b[2 * j] * rb * hwv[2 * j] * siluf(bflo(gww[j])), b[2 * j + 1] * rb * hwv[2 * j + 1] * siluf(bfhi(gww[j])));
        }
        if (dry) continue;
        *(v4u*)(row + C_XM + 16 * lane) = (v4u){wa[0], wa[1], wa[2], wa[3]}; *(v4u*)(row + C_XM + 16 * lane + 8) = (v4u){wa[4], wa[5], wa[6], wa[7]};
        *(v4u*)(row + C_I + 16 * lane) = (v4u){wb[0], wb[1], wb[2], wb[3]}; *(v4u*)(row + C_I + 16 * lane + 8) = (v4u){wb[4], wb[5], wb[6], wb[7]};
    }
}
typedef short v4s __attribute__((ext_vector_type(4)));
constexpr size_t WS_DECH = 7 * MiB, WS_DTF = WS_END, WS_ACF = WS_DTF + (size_t)T * 16 * 4, WS_TAIL = WS_ACF + (size_t)T * 16 * 4, WS_END2 = WS_TAIL + (size_t)256 * 3 * 2048 * 2;

__device__ __forceinline__ void unpack4(const v2u w, float (&f)[4]) { f[0] = bflo(w.x); f[1] = bfhi(w.x); f[2] = bflo(w.y); f[3] = bfhi(w.y); }

__device__ __forceinline__ void prep_chunk(int ci, bf16* PROJ, const float* const* in, float* out, unsigned char* ws, int tid, int wave, int lane) {
    const int b = ci >> 5, c = ci & 31; const size_t r0 = (size_t)b * SEQ + (size_t)c * 64;
    float* DTF = (float*)(ws + WS_DTF); float* ACF = (float*)(ws + WS_ACF); float* DECH = (float*)(ws + WS_DECH); bf16* TAIL = (bf16*)(ws + WS_TAIL);
#pragma unroll
    for (int q = 0; q < 2; ++q) { const int h = 2 * wave + q;
        const float xr = bf2f(PROJ[(r0 + lane) * NIN + C_DT + h]) + in[13][h]; const float dt = xr > 20.f ? xr : log1pf(__expf(xr));
        float v = -__expf(in[14][h]) * dt;
#pragma unroll
        for (int o = 1; o < 64; o <<= 1) { const float tt = __shfl_up(v, o); if (lane >= o) v += tt; }
        DTF[(r0 + lane) * 16 + h] = dt; ACF[(r0 + lane) * 16 + h] = v; }
    { const int ch4 = 4 * tid; bf16* colp = PROJ + r0 * NIN + C_XM + ch4;
        const f32x4 cw0 = *(const f32x4*)(in[11] + ch4), cw1 = *(const f32x4*)(in[11] + 2048 + ch4), cw2 = *(const f32x4*)(in[11] + 4096 + ch4), cw3 = *(const f32x4*)(in[11] + 6144 + ch4), cbv = *(const f32x4*)(in[12] + ch4);
        float w0[4] = {0.f, 0.f, 0.f, 0.f}, w1[4] = {0.f, 0.f, 0.f, 0.f}, w2[4] = {0.f, 0.f, 0.f, 0.f};
        if (c > 0) { unpack4(*(const v2u*)(colp - 3 * (size_t)NIN), w0); unpack4(*(const v2u*)(colp - 2 * (size_t)NIN), w1); unpack4(*(const v2u*)(colp - (size_t)NIN), w2); }
#pragma unroll 1
        for (int tb = 0; tb < 64; tb += 16) {
            v2u raw[16];
#pragma unroll
            for (int i = 0; i < 16; ++i) raw[i] = *(const v2u*)(colp + (size_t)(tb + i) * NIN);
#pragma unroll
            for (int i = 0; i < 16; ++i) { float x[4]; unpack4(raw[i], x); float o[4];
#pragma unroll
                for (int j = 0; j < 4; ++j) { o[j] = siluf(cbv[j] + cw0[j] * w0[j] + cw1[j] * w1[j] + cw2[j] * w2[j] + cw3[j] * x[j]); w0[j] = w1[j]; w1[j] = w2[j]; w2[j] = x[j]; }
                const v2u ow = (v2u){pk2(o[0], o[1]), pk2(o[2], o[3])}; const int t = tb + i;
                if (t < 61) *(v2u*)(colp + (size_t)t * NIN) = ow; else *(v2u*)(TAIL + ((size_t)ci * 3 + (t - 61)) * 2048 + ch4) = ow;
                if (c == 31 && t >= 61) *(f32x4*)(out + O_CONVP + ((size_t)b * 3 + (t - 61)) * 2048 + ch4) = (f32x4){x[0], x[1], x[2], x[3]}; }
        } }
    { const int k2 = 2 * tid; bf16* qp = PROJ + r0 * NIN + C_Q + k2; bf16* fp = PROJ + r0 * NIN + C_F + k2;
        const float lb0 = sigm(in[18][k2] - in[18][1024 + k2]), lb1 = sigm(in[18][k2 + 1] - in[18][1024 + k2 + 1]);
        float run0 = 0.f, run1 = 0.f;
#pragma unroll 1
        for (int tb = 0; tb < 64; tb += 16) {
            unsigned qr[16], fr_[16];
#pragma unroll
            for (int i = 0; i < 16; ++i) { qr[i] = *(const unsigned*)(qp + (size_t)(tb + i) * NIN); fr_[i] = *(const unsigned*)(fp + (size_t)(tb + i) * NIN); }
#pragma unroll
            for (int i = 0; i < 16; ++i) {
                const float s0 = sigm(bflo(fr_[i])), s1 = sigm(bfhi(fr_[i]));
                run0 += __logf(lb0 + (1.f - lb0) * s0); run1 += __logf(lb1 + (1.f - lb1) * s1);
                const float e0 = __expf(run0), e1 = __expf(run1);
                *(unsigned*)(qp + (size_t)(tb + i) * NIN) = pk2(bflo(qr[i]) * e0, bfhi(qr[i]) * e1);
                *(unsigned*)(fp + (size_t)(tb + i) * NIN) = pk2((1.f - lb0) * (1.f - s0) * __builtin_amdgcn_rcpf(e0), (1.f - lb1) * (1.f - s1) * __builtin_amdgcn_rcpf(e1)); }
        }
        DECH[(size_t)ci * 1024 + k2] = __expf(run0); DECH[(size_t)ci * 1024 + k2 + 1] = __expf(run1); }
}

constexpr int S_QC = 136, S_X = 40, S_WT = 72;
constexpr int G_QC = 0, G_KB = 17408, G_X = 34816, G_XS = 39936, G_WT = 45056, G_ST = 54272, G_FA = 62976, GRP_BYTES = 64000;
static_assert(2 * GRP_BYTES <= RING_BYTES, "scan LDS map");
__device__ __forceinline__ bf16x8 row_frag(const LAS bf16* img, int stride, int row, int k) { return *(const LAS bf16x8*)(img + row * stride + k); }
__device__ __forceinline__ bf16x8 tr_frag(const LAS bf16* img, int stride, int k0, int c0, int fr) {
    const LAS bf16* p = img + (k0 + (fr >> 2)) * stride + c0 + 4 * (fr & 3);
    const v4s lo = __builtin_amdgcn_ds_read_tr16_b64_v4i16((LAS v4s*)p), hi = __builtin_amdgcn_ds_read_tr16_b64_v4i16((LAS v4s*)(p + 4 * stride));
    return (bf16x8){lo[0], lo[1], lo[2], lo[3], hi[0], hi[1], hi[2], hi[3]};
}
constexpr unsigned pack2(const int (&a)[10]) { unsigned r = 0; for (int i = 0; i < 10; ++i) r |= (unsigned)a[i] << (2 * i); return r; }
constexpr int TB_LIST[10] = {3, 3, 2, 2, 3, 3, 2, 1, 0, 1}, SB_LIST[10] = {0, 2, 0, 2, 1, 3, 1, 1, 0, 0};
constexpr unsigned TB_PK = pack2(TB_LIST), SB_PK = pack2(SB_LIST);

__device__ __forceinline__ void scan_pair_job(int pj, bf16* PROJ, float* out, unsigned char* ws, const float* const* in, LAS unsigned char* lds, int tid0, int wave, bool dry) {
    const bool ssd = wave < 4; const int w4 = wave & 3;
    LAS unsigned char* gl = lds + (ssd ? 0 : GRP_BYTES);
    LAS bf16* QC = (LAS bf16*)(gl + G_QC); LAS bf16* KB = (LAS bf16*)(gl + G_KB); LAS bf16* XN = (LAS bf16*)(gl + G_X); LAS bf16* XS = (LAS bf16*)(gl + (ssd ? G_XS : G_X));
    LAS bf16* WT = (LAS bf16*)(gl + G_WT); LAS bf16* ST = (LAS bf16*)(gl + G_ST); LAS float* ACUM = (LAS float*)(gl + G_FA); LAS float* DT = ACUM + 64; LAS float* DEC = ACUM + 128;
    const float* DTF = (const float*)(ws + WS_DTF); const float* ACF = (const float*)(ws + WS_ACF); const float* DECH = (const float*)(ws + WS_DECH); const bf16* TAIL = (const bf16*)(ws + WS_TAIL);
    int b, colC, colB, colX, chC = 0, chB = 0, chX = 0, h = 0, half = 0, hd = 0, vq = 0;
    if (ssd) { b = pj >> 5; h = (pj >> 1) & 15; half = pj & 1; const int g = h >> 2; colX = C_XM + h * 64 + half * 32; colB = C_B + g * 128; colC = C_C + g * 128; chX = h * 64 + half * 32; chB = 1024 + g * 128; chC = 1536 + g * 128; }
    else { b = pj >> 5; hd = (pj >> 2) & 7; vq = pj & 3; colB = C_F + hd * 128; colC = C_Q + hd * 128; colX = C_I + hd * 128 + vq * 32; }
    const size_t rowbase = (size_t)b * SEQ;
    const float Dh = ssd ? in[15][h] : 0.f;
    f32x4 st[4];
#pragma unroll
    for (int i = 0; i < 4; ++i) st[i] = (f32x4){0.f, 0.f, 0.f, 0.f};
    { const int gt = tid0 & 255; for (int i = gt; i < (G_FA - G_WT) / 4; i += 256) ((LAS unsigned*)(gl + G_WT))[i] = 0u; }
    v4u pfC[4], pfB[4], pfX; float fa = 0.f, fb = 0.f;
#define LOAD_REGS(c_) do { const int ci_ = b * 32 + (c_); const bf16* base_ = PROJ + (rowbase + (size_t)(c_) * 64) * NIN; \
        _Pragma("unroll") for (int j = 0; j < 4; ++j) { const int i = gt + 256 * j, row = i >> 4, c16 = i & 15; const bool tl = ssd && row >= 61; \
            const bf16* tb_ = TAIL + ((size_t)ci_ * 3 + (row - 61)) * 2048 + c16 * 8; \
            pfC[j] = *(const v4u*)(tl ? tb_ + chC : base_ + (size_t)row * NIN + colC + c16 * 8); pfB[j] = *(const v4u*)(tl ? tb_ + chB : base_ + (size_t)row * NIN + colB + c16 * 8); } \
        { const int row = gt >> 2, c16 = gt & 3; const bool tl = ssd && row >= 61; \
            pfX = *(const v4u*)(tl ? TAIL + ((size_t)ci_ * 3 + (row - 61)) * 2048 + chX + c16 * 8 : base_ + (size_t)row * NIN + colX + c16 * 8); } \
        if (ssd) { if (gt < 64) { fa = ACF[(rowbase + (size_t)(c_) * 64 + gt) * 16 + h]; fb = DTF[(rowbase + (size_t)(c_) * 64 + gt) * 16 + h]; } } \
        else if (gt < 128) fa = DECH[(size_t)ci_ * 1024 + hd * 128 + gt]; } while (0)
#define STORE_REGS() do { \
        _Pragma("unroll") for (int j = 0; j < 4; ++j) { const int i = gt + 256 * j, row = i >> 4, c16 = i & 15; \
            *(LAS v4u*)(QC + row * S_QC + c16 * 8) = pfC[j]; *(LAS v4u*)(KB + row * S_QC + c16 * 8) = pfB[j]; } \
        *(LAS v4u*)(XN + (gt >> 2) * S_X + (gt & 3) * 8) = pfX; \
        if (ssd) { if (gt < 64) { ACUM[gt] = fa; DT[gt] = fb; } } else if (gt < 128) DEC[gt] = fa; } while (0)
    { const int gt = tid0 & 255; LOAD_REGS(0); }
    for (int c = 0; c < SEQ / 64; ++c) {
        int tid_v = tid0; asm volatile("" : "+v"(tid_v));
        const int gt = tid_v & 255, lane = tid_v & 63, fr = lane & 15, fq = lane >> 4;
        STORE_REGS();
        __syncthreads();
        if (c + 1 < SEQ / 64) LOAD_REGS(c + 1);
        const size_t t0 = rowbase + (size_t)c * 64;
        const float alast = ssd ? ACUM[63] : 0.f;
        if (ssd) {
            const int s = gt >> 2, p8 = (gt & 3) * 8; const float sc = __expf(alast - ACUM[s]) * DT[s];
            float x[8]; const v4u xw = *(const LAS v4u*)(XN + s * S_X + p8);
            x[0] = bflo(xw.x); x[1] = bfhi(xw.x); x[2] = bflo(xw.y); x[3] = bfhi(xw.y); x[4] = bflo(xw.z); x[5] = bfhi(xw.z); x[6] = bflo(xw.w); x[7] = bfhi(xw.w);
            *(LAS v4u*)(XS + s * S_X + p8) = (v4u){pk2(x[0] * sc, x[1] * sc), pk2(x[2] * sc, x[3] * sc), pk2(x[4] * sc, x[5] * sc), pk2(x[6] * sc, x[7] * sc)};
        }
        for (int idx = w4; idx < 10; idx += 4) { const int tb = (TB_PK >> (2 * idx)) & 3, sb = (SB_PK >> (2 * idx)) & 3; const int t = 16 * tb + fr, s0 = 16 * sb + 4 * fq;
            f32x4 g = (f32x4){0.f, 0.f, 0.f, 0.f};
#pragma unroll
            for (int k0 = 0; k0 < 128; k0 += 32) g = __builtin_amdgcn_mfma_f32_16x16x32_bf16(row_frag(KB, S_QC, 16 * sb + fr, k0 + 8 * fq), row_frag(QC, S_QC, t, k0 + 8 * fq), g, 0, 0, 0);
            float w[4];
            if (ssd) { const float at = ACUM[t]; const f32x4 as = *(const LAS f32x4*)(ACUM + s0), ds = *(const LAS f32x4*)(DT + s0);
#pragma unroll
                for (int j = 0; j < 4; ++j) w[j] = (s0 + j <= t) ? g[j] * __expf(fminf(at - as[j], 0.f)) * ds[j] : 0.f;
            } else {
#pragma unroll
                for (int j = 0; j < 4; ++j) w[j] = (s0 + j <= t) ? g[j] : 0.f;
            }
            *(LAS v2u*)(WT + t * S_WT + s0) = (v2u){pk2(w[0], w[1]), pk2(w[2], w[3])}; }
        __syncthreads();
        { const int t = 16 * w4 + fr; const float rs = ssd ? __expf(ACUM[t]) : 1.f;
            bf16x8 qa[4];
#pragma unroll
            for (int ks = 0; ks < 4; ++ks) qa[ks] = row_frag(QC, S_QC, t, 32 * ks + 8 * fq);
            const bf16x8 wa0 = row_frag(WT, S_WT, t, 8 * fq), wa1 = row_frag(WT, S_WT, t, 32 + 8 * fq);
#pragma unroll
            for (int pb = 0; pb < 2; ++pb) {
                f32x4 y = (f32x4){0.f, 0.f, 0.f, 0.f};
#pragma unroll
                for (int ks = 0; ks < 4; ++ks) y = __builtin_amdgcn_mfma_f32_16x16x32_bf16(row_frag(ST, S_QC, 16 * pb + fr, 32 * ks + 8 * fq), qa[ks], y, 0, 0, 0);
                y = y * rs;
                y = __builtin_amdgcn_mfma_f32_16x16x32_bf16(tr_frag(XN, S_X, 8 * fq, 16 * pb, fr), wa0, y, 0, 0, 0);
                if (w4 >= 2) y = __builtin_amdgcn_mfma_f32_16x16x32_bf16(tr_frag(XN, S_X, 32 + 8 * fq, 16 * pb, fr), wa1, y, 0, 0, 0);
                const int p0 = 16 * pb + 4 * fq;
                if (ssd) { const v2u xw = *(const LAS v2u*)(XN + t * S_X + p0); y[0] += Dh * bflo(xw.x); y[1] += Dh * bfhi(xw.x); y[2] += Dh * bflo(xw.y); y[3] += Dh * bfhi(xw.y); }
                if (!dry) *(v2u*)(PROJ + (t0 + t) * NIN + colX + p0) = (v2u){pk2(y[0], y[1]), pk2(y[2], y[3])};
            } }
        { const float dsc = ssd ? __expf(alast) : 1.f;
#pragma unroll
            for (int q = 0; q < 2; ++q) { const int n0 = 16 * (2 * w4 + q);
                const bf16x8 kb0 = tr_frag(KB, S_QC, 8 * fq, n0, fr), kb1 = tr_frag(KB, S_QC, 32 + 8 * fq, n0, fr);
                f32x4 dv = (f32x4){1.f, 1.f, 1.f, 1.f}; if (!ssd) dv = *(const LAS f32x4*)(DEC + n0 + 4 * fq);
#pragma unroll
                for (int pb = 0; pb < 2; ++pb) { f32x4 a = st[2 * q + pb] * dsc;
                    a = __builtin_amdgcn_mfma_f32_16x16x32_bf16(kb0, tr_frag(XS, S_X, 8 * fq, 16 * pb, fr), a, 0, 0, 0);
                    a = __builtin_amdgcn_mfma_f32_16x16x32_bf16(kb1, tr_frag(XS, S_X, 32 + 8 * fq, 16 * pb, fr), a, 0, 0, 0);
                    st[2 * q + pb] = a * dv; } } }
        __syncthreads();
#pragma unroll
        for (int q = 0; q < 2; ++q)
#pragma unroll
            for (int pb = 0; pb < 2; ++pb) *(LAS v2u*)(ST + (16 * pb + fr) * S_QC + 16 * (2 * w4 + q) + 4 * fq) = (v2u){pk2(st[2 * q + pb][0], st[2 * q + pb][1]), pk2(st[2 * q + pb][2], st[2 * q + pb][3])};
    }
#undef LOAD_REGS
#undef STORE_REGS
    if (!dry) { const int lane = tid0 & 63, fr = lane & 15, fq = lane >> 4;
#pragma unroll
        for (int q = 0; q < 2; ++q)
#pragma unroll
            for (int pb = 0; pb < 2; ++pb) { const int n0 = 16 * (2 * w4 + q) + 4 * fq, p = 16 * pb + fr; const f32x4 v = st[2 * q + pb];
                if (ssd) *(f32x4*)(out + O_SSMP + (((size_t)(b * 16 + h) * 64 + half * 32 + p) * 128 + n0)) = v;
                else {
#pragma unroll
                    for (int j = 0; j < 4; ++j) out[O_HGP + (((size_t)(b * 8 + hd) * 128 + n0 + j) * 128 + vq * 32 + p)] = v[j]; } } }
    __syncthreads();
}

__device__ __forceinline__ void ssd_sample_job(int job, bf16* PROJ, const float* const* in, float* out, LAS unsigned char* lds, int tid, bool dry) {
    const int sb = job >> 4, h = job & 15, g = h >> 2; const size_t row0 = (size_t)TP + 4 * sb;
    LAS float* SX = (LAS float*)lds; LAS float* SBm = SX + 4 * 64; LAS float* SCm = SBm + 4 * 128; LAS float* SDT = SCm + 4 * 128;
    if (tid < 320) {
        int col, cc; LAS float* dst; int dstride, di;
        if (tid < 64) { col = C_XM + h * 64 + tid; cc = h * 64 + tid; dst = SX; dstride = 64; di = tid; }
        else if (tid < 192) { col = C_B + g * 128 + (tid - 64); cc = 1024 + g * 128 + (tid - 64); dst = SBm; dstride = 128; di = tid - 64; }
        else { col = C_C + g * 128 + (tid - 192); cc = 1536 + g * 128 + (tid - 192); dst = SCm; dstride = 128; di = tid - 192; }
        float u[7];
#pragma unroll
        for (int j = 0; j < 3; ++j) u[j] = in[2][((size_t)sb * 3 + j) * 2048 + cc];
#pragma unroll
        for (int j = 0; j < 4; ++j) u[3 + j] = bf2f(PROJ[(row0 + j) * NIN + col]);
        const float w0 = in[11][cc], w1 = in[11][2048 + cc], w2 = in[11][4096 + cc], w3 = in[11][6144 + cc], bb = in[12][cc];
#pragma unroll
        for (int t = 0; t < 4; ++t) dst[t * dstride + di] = siluf(bb + w0 * u[t] + w1 * u[t + 1] + w2 * u[t + 2] + w3 * u[t + 3]);
        if (!dry && (tid < 64 || (h & 3) == 0)) {
#pragma unroll
            for (int j = 0; j < 3; ++j) out[O_CONVS + ((size_t)sb * 3 + j) * 2048 + cc] = u[4 + j];
        }
    } else if (tid < 324) { const int t = tid - 320; const float xr = bf2f(PROJ[(row0 + t) * NIN + C_DT + h]) + in[13][h]; SDT[t] = xr > 20.f ? xr : log1pf(__expf(xr)); }
    __syncthreads();
    const int p = tid >> 3, nq = tid & 7;
    const float a_neg = -__expf(in[14][h]), Dh = in[15][h];
    const size_t sbase = (((size_t)sb * 16 + h) * 64 + p) * 128 + 16 * nq;
    float hs[16];
#pragma unroll
    for (int i = 0; i < 4; ++i) { const f32x4 v = *(const f32x4*)(in[3] + sbase + 4 * i); hs[4 * i] = v[0]; hs[4 * i + 1] = v[1]; hs[4 * i + 2] = v[2]; hs[4 * i + 3] = v[3]; }
#pragma unroll
    for (int t = 0; t < 4; ++t) {
        const float dt = SDT[t], dec = __expf(dt * a_neg), xv = SX[t * 64 + p], xb = dt * xv; float part = 0.f;
#pragma unroll
        for (int i = 0; i < 16; ++i) { hs[i] = dec * hs[i] + xb * SBm[t * 128 + 16 * nq + i]; part += hs[i] * SCm[t * 128 + 16 * nq + i]; }
        part += __shfl_xor(part, 1); part += __shfl_xor(part, 2); part += __shfl_xor(part, 4);
        if (nq == 0 && !dry) PROJ[(row0 + t) * NIN + C_XM + h * 64 + p] = (bf16)f2bf(part + Dh * xv);
    }
    if (!dry)
#pragma unroll
    for (int i = 0; i < 4; ++i) *(f32x4*)(out + O_SSMS + sbase + 4 * i) = (f32x4){hs[4 * i], hs[4 * i + 1], hs[4 * i + 2], hs[4 * i + 3]};
    __syncthreads();
}
__device__ __forceinline__ void hgrn_sample_job(int job, bf16* PROJ, const float* const* in, float* out, LAS unsigned char* lds, int tid, bool dry) {
    const int sb = job >> 3, hd = job & 7; const size_t row0 = (size_t)TP + 4 * sb;
    LAS float* SQ = (LAS float*)lds; LAS float* SF = SQ + 512; LAS float* SK = SF + 512; LAS float* SV = SK + 512; LAS float* PP = SV + 512;
    if (tid < 128) { const int k = tid; const float lb = sigm(in[18][hd * 128 + k] - in[18][1024 + hd * 128 + k]);
#pragma unroll
        for (int t = 0; t < 4; ++t) { const float frw = bf2f(PROJ[(row0 + t) * NIN + C_F + hd * 128 + k]), q = bf2f(PROJ[(row0 + t) * NIN + C_Q + hd * 128 + k]);
            const float sg = sigm(frw); SF[t * 128 + k] = lb + (1.f - lb) * sg; SK[t * 128 + k] = (1.f - lb) * (1.f - sg); SQ[t * 128 + k] = q; } }
    else if (tid < 256) { const int v = tid - 128;
#pragma unroll
        for (int t = 0; t < 4; ++t) SV[t * 128 + v] = bf2f(PROJ[(row0 + t) * NIN + C_I + hd * 128 + v]); }
    __syncthreads();
    const int v4 = tid & 31, kq = tid >> 5;
    const size_t sbase = (((size_t)sb * 8 + hd) * 128 + 8 * kq) * 128 + 4 * v4;
    f32x4 s[8];
#pragma unroll
    for (int i = 0; i < 8; ++i) s[i] = *(const f32x4*)(in[4] + sbase + (size_t)i * 128);
#pragma unroll
    for (int t = 0; t < 4; ++t) { const f32x4 vv = *(const LAS f32x4*)(SV + t * 128 + 4 * v4); f32x4 part = (f32x4){0.f, 0.f, 0.f, 0.f};
#pragma unroll
        for (int i = 0; i < 8; ++i) { const float f = SF[t * 128 + 8 * kq + i], kk = SK[t * 128 + 8 * kq + i], q = SQ[t * 128 + 8 * kq + i];
            s[i] = s[i] * f + vv * kk; part += s[i] * q; }
        *(LAS f32x4*)(PP + (t * 16 + kq) * 128 + 4 * v4) = part; }
    if (!dry)
#pragma unroll
    for (int i = 0; i < 8; ++i) *(f32x4*)(out + O_HGS + sbase + (size_t)i * 128) = s[i];
    __syncthreads();
    { const int t = tid >> 7, v = tid & 127; float o = 0.f;
#pragma unroll
        for (int q = 0; q < 16; ++q) o += PP[(t * 16 + q) * 128 + v];
        if (!dry) PROJ[(row0 + t) * NIN + C_I + hd * 128 + v] = (bf16)f2bf(o); }
    __syncthreads();
}
#ifndef MK_N_LAUNCHES
#define MK_N_LAUNCHES 1
#endif
constexpr int NPH = 15;
struct Args { const float* in[29]; float* out; unsigned char* ws; int ph_lo, ph_hi; };
static_assert(sizeof(Args) == 29 * 8 + 8 + 8 + 8, "Args has no padding");

__global__ void __launch_bounds__(NTHR, 2) mk_fwd(Args args) {
    extern __shared__ __attribute__((aligned(16))) unsigned char lds_raw[];
    LAS unsigned char* lds = (LAS unsigned char*)lds_raw;
    volatile LAS unsigned* MISC = (volatile LAS unsigned*)(lds + MISC_OFF);
    const int tid = threadIdx.x, lane = tid & 63, wave = __builtin_amdgcn_readfirstlane(tid >> 6);
    const int G = gridDim.x; const int bx = blockIdx.x; const int vcu = (G % 8 == 0) ? (bx % 8) * (G / 8) + bx / 8 : bx;
    const float* const* in = args.in; float* out = args.out; unsigned char* outb = (unsigned char*)args.out; unsigned char* ws = args.ws;
    for (int u = tid; u < (LDS_BYTES - LDSCTL_OFF) / 4; u += NTHR) ((LAS unsigned*)(lds + LDSCTL_OFF))[u] = 0u;
    __syncthreads();
    const int lo = args.ph_lo, hi = args.ph_hi;
    XcdBarrier bar; bar.bar = (unsigned*)(ws + WS_CTL) + CW_BAR; bar.x = 0; bar.st = nullptr;
    if (hi - lo > 1) bar = xcd_barrier_post((unsigned*)(ws + WS_CTL) + CW_BAR, MISC + 8);
#ifndef PH_MASK
#define PH_MASK 0x7fff
#endif
#define IN(k) ((((PH_MASK) >> (k)) & 1) && lo <= (k) && (k) < hi)
#ifndef DUP_MASK
#define DUP_MASK 0
#endif
#define DUPN(k) ((((DUP_MASK) >> (k)) & 1) ? 2 : 1)
#define SEAM(k) do { if (IN(k) && IN((k) + 1)) xcd_barrier(bar); } while (0)
    bf16* PROJ = (bf16*)(ws + WS_PROJ);
    float* Y = out + O_Y;

#define REPS(k) _Pragma("unroll 1") for (int rep_ = DUPN(k) - 1; rep_ >= 0; --rep_)
#define DRY ((rep_ > 0) && (args.ph_hi != 12345))
    if (IN(0)) REPS(0) { p0_prologue(in, outb, ws, lds, vcu, G, wave, lane); } SEAM(0);
    if (IN(1)) REPS(1) { pg8::Gemm g{(const bf16*)(outb + OS_XB), (const bf16*)(outb + OS_W1A), T, NGU, D, D}; pg8::StaticOrder S; S.init(T, NGU, G, bx);
        EpiSwiGLU E{(bf16*)(ws + WS_H)}; pg8::gemm_phase<EpiSwiGLU, pg8::StaticOrder, true, true>(lds, g, S, E); } SEAM(1);
    if (IN(2)) REPS(2) { pg8::Gemm g{(const bf16*)(ws + WS_H), (const bf16*)(outb + OS_W1D), T, D, FF, FF}; pg8::StaticOrder S; S.init(T, D, G, bx);
        EpiResid E{in[0], in[1], Y, 0.5f, false}; pg8::gemm_phase<EpiResid, pg8::StaticOrder, true, true>(lds, g, S, E); } SEAM(2);
    if (IN(3)) REPS(3) { ln_phase(Y, (bf16*)(outb + OS_XB), in[8], in[9], vcu, G, wave, lane, DRY); } SEAM(3);
    if (IN(4)) REPS(4) { pg8::Gemm g{(const bf16*)(outb + OS_XB), (const bf16*)(outb + OS_WIN), T, NINP, D, D}; pg8::StaticOrder S; S.init(T, NINP, G, bx);
        EpiBf16N E{PROJ, NIN, NIN}; pg8::gemm_phase<EpiBf16N, pg8::StaticOrder, true, true>(lds, g, S, E); } SEAM(4);
    if (IN(5)) REPS(5) { for (int ci = bx; ci < 256; ci += G) prep_chunk(ci, PROJ, in, out, ws, tid, wave, lane); } SEAM(5);
    if (IN(6)) REPS(6) {
        const bool dry = DRY;
#ifndef DRY_SCAN_MASK
#define DRY_SCAN_MASK 7
#endif
        const int smask = (rep_ > 0) ? (DRY_SCAN_MASK) : 7;
        if (smask & 1) for (int pj = bx; pj < 256; pj += G) scan_pair_job(pj, PROJ, out, ws, in, lds, tid, wave, dry);
        if (smask & 2) for (int job = bx; job < DB * 16; job += G) ssd_sample_job(job, PROJ, in, out, lds, tid, dry);
        if (smask & 4) for (int job = bx; job < DB * 8; job += G) hgrn_sample_job(job, PROJ, in, out, lds, tid, dry);
    } SEAM(6);
    if (IN(7)) REPS(7) { norm_phase(PROJ, in[16], in[19], vcu, G, wave, lane, DRY); } SEAM(7);
    if (IN(8)) REPS(8) { pg8::Gemm g{PROJ + C_XM, (const bf16*)(ws + WS_WMO), T, D, D, NIN}; pg8::StaticOrder S; S.init(T, D, G, bx);
        EpiGate<false> E{PROJ + C_GM, PROJ + C_Z, false}; pg8::gemm_phase<EpiGate<false>, pg8::StaticOrder, true, true>(lds, g, S, E); } SEAM(8);
    if (IN(9)) REPS(9) { pg8::Gemm g{PROJ + C_I, (const bf16*)(ws + WS_WHO), T, D, D, NIN}; pg8::StaticOrder S; S.init(T, D, G, bx);
        EpiGate<true> E{PROJ + C_GH, PROJ + C_Z, DRY}; pg8::gemm_phase<EpiGate<true>, pg8::StaticOrder, true, true>(lds, g, S, E); } SEAM(9);
    if (IN(10)) REPS(10) { pg8::Gemm g{PROJ + C_Z, (const bf16*)(ws + WS_WO), T, D, D, NIN}; pg8::StaticOrder S; S.init(T, D, G, bx);
        EpiResid E{Y, nullptr, Y, 1.0f, DRY}; pg8::gemm_phase<EpiResid, pg8::StaticOrder, true, true>(lds, g, S, E); } SEAM(10);
    if (IN(11)) REPS(11) { ln_phase(Y, (bf16*)(ws + WS_X2B), in[22], in[23], vcu, G, wave, lane, DRY);
        ffn_weight_items(in[24], in[25], in[26], (bf16*)(ws + WS_W2A), (bf16*)(ws + WS_W2D), (LAS float*)(lds + wave * 16384), vcu * NWAVES + wave, G * NWAVES, lane); } SEAM(11);
    if (IN(12)) REPS(12) { pg8::Gemm g{(const bf16*)(ws + WS_X2B), (const bf16*)(ws + WS_W2A), T, NGU, D, D}; pg8::StaticOrder S; S.init(T, NGU, G, bx);
        EpiSwiGLU E{(bf16*)(ws + WS_H)}; pg8::gemm_phase<EpiSwiGLU, pg8::StaticOrder, true, true>(lds, g, S, E); } SEAM(12);
    if (IN(13)) REPS(13) { pg8::Gemm g{(const bf16*)(ws + WS_H), (const bf16*)(ws + WS_W2D), T, D, FF, FF}; pg8::StaticOrder S; S.init(T, D, G, bx);
        EpiResid E{Y, nullptr, Y, 0.5f, DRY}; pg8::gemm_phase<EpiResid, pg8::StaticOrder, true, true>(lds, g, S, E); } SEAM(13);
    if (IN(14)) REPS(14) { ln_phase(Y, nullptr, in[27], in[28], vcu, G, wave, lane, DRY); }
#undef REPS
#undef DRY
#undef IN
#undef SEAM
}

extern "C" void kernel_launch(void* const* d_in, const int* in_sizes, int n_in, void* d_out, int out_size, void* d_ws, size_t ws_size, hipStream_t stream) {
    static int grid = 0;
    if (grid == 0) {
        if (n_in != 29 || out_size != (int)O_END || ws_size < WS_END2) { fprintf(stderr, "kernel_launch: unexpected shapes (n_in %d, out %d, ws %zu < %zu)\n", n_in, out_size, ws_size, (size_t)WS_END2); grid = -1; return; }
        int dev = 0, cus = 0, per_cu = 0;
        if (hipGetDevice(&dev) != hipSuccess || hipDeviceGetAttribute(&cus, hipDeviceAttributeMultiprocessorCount, dev) != hipSuccess) { grid = -1; return; }
        if (hipFuncSetAttribute((const void*)mk_fwd, hipFuncAttributeMaxDynamicSharedMemorySize, LDS_BYTES) != hipSuccess) { fprintf(stderr, "kernel_launch: hipFuncSetAttribute failed\n"); grid = -1; return; }
        if (hipOccupancyMaxActiveBlocksPerMultiprocessor(&per_cu, (const void*)mk_fwd, NTHR, LDS_BYTES) != hipSuccess || per_cu < 1) { fprintf(stderr, "kernel_launch: occupancy query says %d\n", per_cu); }
        (void)hipGetLastError();
        grid = cus;
    }
    if (grid < 0) return;
    (void)hipMemsetAsync((char*)d_ws + WS_CTL, 0, CTL_ZERO_BYTES, stream);
    Args a{};
    for (int i = 0; i < 29; ++i) a.in[i] = (const float*)d_in[i];
    a.out = (float*)d_out; a.ws = (unsigned char*)d_ws;
    if (MK_N_LAUNCHES == 1) { a.ph_lo = 0; a.ph_hi = NPH; hipLaunchKernelGGL(mk_fwd, dim3(grid), dim3(NTHR), LDS_BYTES, stream, a); }
    else { for (int p = 0; p < NPH; ++p) { a.ph_lo = p; a.ph_hi = p + 1; hipLaunchKernelGGL(mk_fwd, dim3(grid), dim3(NTHR), LDS_BYTES, stream, a); } }
}
```

```cpp
#include <hip/hip_runtime.h>
#include <cstdio>
#include <cstdint>
#define MK_N_LAUNCHES 1
#define DUP_MASK 0
#define DRY_SCAN_MASK 15
namespace pg8 {
#define PG8_LAS __attribute__((address_space(3)))
typedef unsigned short bf16_t;
typedef short bf16x8 __attribute__((ext_vector_type(8)));
typedef float f32x4 __attribute__((ext_vector_type(4)));
typedef unsigned u32x4 __attribute__((ext_vector_type(4)));
typedef unsigned u32x2 __attribute__((ext_vector_type(2)));
constexpr int BM = 256, BK = 64, HALF = 128, HTB = HALF * BK * 2  , STAGE_BYTES = 8 * HTB, NXCD = 8, WGM = 8;

__host__ __device__ __forceinline__ int lds_byte(int r, int c) { const int st = (r >> 4) * 2 + (c >> 5), rr = r & 15, cc = c & 31, ob = rr * 64 + cc * 2; return st * 1024 + (ob ^ (((ob >> 9) & 1) << 5)); }
__host__ __device__ __forceinline__ void stage_rc(int b, int& R, int& C) { const int st = b / 1024, sb = b % 1024, swz = sb ^ (((sb >> 9) & 1) << 5); R = (st >> 1) * 16 + swz / 64; C = (st & 1) * 32 + (swz % 64) / 2; }
__host__ __device__ __forceinline__ int perm32(int rho) { const int n = rho >> 4, i = rho & 15; return 8 * (i >> 2) + 4 * n + (i & 3); }

struct Unit { int pm, pn; };
struct Gemm { const bf16_t* A; const bf16_t* Bt; int M, N, K, lda; };

struct StaticOrder {
    int nM, nN, nwg, G, c;
    __host__ __device__ void init(int M, int N, int G_, int c_) { nM = M / BM; nN = N / BM; nwg = nM * nN; G = G_; c = c_; }
    __host__ __device__ bool next(int i, Unit& u) const {
        const long L = (long)i * G + c; if (L >= nwg) return false;
        int wgid = (int)L; { const int q = nwg / NXCD, r = nwg % NXCD, xcd = wgid % NXCD, off = wgid / NXCD; wgid = (xcd < r ? xcd * (q + 1) : r * (q + 1) + (xcd - r) * q) + off; }
        const int nig = WGM * nN, gid = wgid / nig, fm = gid * WGM, gsz = (nM - fm) < WGM ? (nM - fm) : WGM;
        u.pm = fm + ((wgid % nig) % gsz); u.pn = (wgid % nig) / gsz; return true;
    }
};

__device__ __forceinline__ unsigned cvt_pk_bf16(float lo, float hi) { unsigned r; asm volatile("v_cvt_pk_bf16_f32 %0, %1, %2" : "=v"(r) : "v"(lo), "v"(hi)); return r; }

template <class Epi, class Sched, bool ALIGN_EPI = false, bool SP2 = false>
__device__ __forceinline__ void gemm_phase(PG8_LAS unsigned char* lds, const Gemm g, const Sched& S, const Epi& E) {
    const int tid = threadIdx.x, wid = __builtin_amdgcn_readfirstlane(tid >> 6), lane = tid & 63, wr = wid >> 2, wc = wid & 3, fr = lane & 15, fq = lane >> 4;
    const int K = g.K, nt = K / BK, lda = g.lda;
    unsigned voffA[2], voffB[2];
#pragma unroll
    for (int i = 0; i < 2; ++i) { int R, C; stage_rc(tid * 16 + i * 8192, R, C); const int Rb = Epi::PERM ? ((R & ~31) + perm32(R & 31)) : R;
        voffA[i] = (unsigned)(R * lda + C) * 2u; voffB[i] = (unsigned)(Rb * K + C) * 2u; }
    const size_t kstep = (size_t)(BK * 2);
    const size_t hstepA = (size_t)HALF * lda * 2, hstepB = (size_t)HALF * K * 2;
    const size_t tstepA = 2 * hstepA, tstepB = 2 * hstepB;
    const unsigned ldsw = (unsigned)wid * 1024u;
    const int aoff = lds_byte(wr * 64 + fr, fq * 8), boff = lds_byte(wc * 32 + fr, fq * 8);
#define PG8_SA(b, h) (((b) * 2 + (h)) * HTB)
#define PG8_SB(b, h) ((4 + (b) * 2 + (h)) * HTB)
#define PG8_STAGE(bufoff, gbase, voff) do { _Pragma("unroll") for (int _i = 0; _i < 2; ++_i) \
        __builtin_amdgcn_global_load_lds((const unsigned*)((const char*)(gbase) + (voff)[_i]), (PG8_LAS unsigned*)(lds + (bufoff) + ldsw + _i * 8192), 16, 0, 0); } while (0)
#define PG8_LDA(dst, b, h) do { _Pragma("unroll") for (int m = 0; m < 4; ++m) _Pragma("unroll") for (int k = 0; k < 2; ++k) dst[m][k] = *(const PG8_LAS bf16x8*)(lds + PG8_SA(b, h) + aoff + m * 2048 + k * 1024); } while (0)
#define PG8_LDB(dst, b, h) do { _Pragma("unroll") for (int n = 0; n < 2; ++n) _Pragma("unroll") for (int k = 0; k < 2; ++k) dst[n][k] = *(const PG8_LAS bf16x8*)(lds + PG8_SB(b, h) + boff + n * 2048 + k * 1024); } while (0)
#define PG8_MMA(ai, bj, At, Bt) do { __builtin_amdgcn_s_setprio(1); _Pragma("unroll") for (int m = 0; m < 4; ++m) _Pragma("unroll") for (int n = 0; n < 2; ++n) _Pragma("unroll") for (int k = 0; k < 2; ++k) \
        acc[ai][bj][m][n] = __builtin_amdgcn_mfma_f32_16x16x32_bf16(Bt[n][k], At[m][k], acc[ai][bj][m][n], 0, 0, 0); __builtin_amdgcn_s_setprio(0); } while (0)
#define PG8_WAIT_V(n) asm volatile("s_waitcnt vmcnt(" #n ")" ::: "memory")
#define PG8_WAIT_L(n) asm volatile("s_waitcnt lgkmcnt(" #n ")" ::: "memory")
#define PG8_BAR __builtin_amdgcn_s_barrier()
#define PG8_SCHED __builtin_amdgcn_sched_barrier(0)
    Unit cur, nxt; int ui = 0;
    if (!S.next(0, cur)) return;
    f32x4 acc[2][2][4][2];
#pragma unroll
    for (int a = 0; a < 2; ++a)
#pragma unroll
        for (int b = 0; b < 2; ++b)
#pragma unroll
            for (int m = 0; m < 4; ++m)
#pragma unroll
                for (int n = 0; n < 2; ++n) acc[a][b][m][n] = (f32x4){0.f, 0.f, 0.f, 0.f};
    bf16x8 At[4][2], B0[2][2], B1[2][2];
    const char* cA = (const char*)g.A + (size_t)cur.pm * tstepA; const char* cB = (const char*)g.Bt + (size_t)cur.pn * tstepB;
    if constexpr (SP2) {
        PG8_STAGE(PG8_SB(0, 0), cB, voffB); PG8_STAGE(PG8_SB(0, 1), cB + hstepB, voffB); PG8_STAGE(PG8_SA(0, 0), cA, voffA); PG8_STAGE(PG8_SA(0, 1), cA + hstepA, voffA);
        if (wr == 1) PG8_BAR;
        PG8_WAIT_V(2); PG8_BAR;
        PG8_STAGE(PG8_SB(1, 0), cB + kstep, voffB); PG8_STAGE(PG8_SA(1, 0), cA + kstep, voffA); PG8_STAGE(PG8_SB(1, 1), cB + hstepB + kstep, voffB);
        PG8_WAIT_V(6); PG8_BAR;
    } else {
        PG8_STAGE(PG8_SB(0, 0), cB, voffB); PG8_STAGE(PG8_SA(0, 0), cA, voffA); PG8_STAGE(PG8_SB(0, 1), cB + hstepB, voffB); PG8_STAGE(PG8_SA(0, 1), cA + hstepA, voffA);
        if (wr == 1) PG8_BAR;
        PG8_WAIT_V(4); PG8_BAR;
        PG8_STAGE(PG8_SB(1, 0), cB + kstep, voffB); PG8_STAGE(PG8_SA(1, 0), cA + kstep, voffA); PG8_STAGE(PG8_SB(1, 1), cB + hstepB + kstep, voffB);
        PG8_WAIT_V(6); PG8_BAR;
    }
    for (;;) {
        const bool has_next = S.next(ui + 1, nxt);
        const char* nA = has_next ? (const char*)g.A + (size_t)nxt.pm * tstepA : cA; const char* nB = has_next ? (const char*)g.Bt + (size_t)nxt.pn * tstepB : cB;
        for (int t = 0; t < nt; t += 2) {
            const bool last = (t == nt - 2);
            const char* a1 = cA + (size_t)(t + 1) * kstep;
            const char* a2 = last ? nA : cA + (size_t)(t + 2) * kstep; const char* b2 = last ? nB : cB + (size_t)(t + 2) * kstep;
            const char* a3 = a2 + kstep; const char* b3 = b2 + kstep;
            if constexpr (SP2) {
            PG8_LDB(B0, 0, 0); PG8_LDB(B1, 0, 1); PG8_SCHED; PG8_LDA(At, 0, 0); PG8_STAGE(PG8_SA(1, 1), a1 + hstepA, voffA);
            PG8_WAIT_V(8); PG8_WAIT_L(0); PG8_BAR; PG8_MMA(0, 0, At, B0); PG8_MMA(0, 1, At, B1); PG8_BAR; PG8_SCHED;
            PG8_LDA(At, 0, 1); PG8_STAGE(PG8_SB(0, 0), b2, voffB); PG8_STAGE(PG8_SB(0, 1), b2 + hstepB, voffB); PG8_STAGE(PG8_SA(0, 0), a2, voffA);
            PG8_WAIT_V(8); PG8_WAIT_L(0); PG8_BAR; PG8_MMA(1, 0, At, B0); PG8_MMA(1, 1, At, B1); PG8_BAR; PG8_SCHED;
            PG8_LDB(B0, 1, 0); PG8_LDB(B1, 1, 1); PG8_SCHED; PG8_LDA(At, 1, 0); PG8_STAGE(PG8_SA(0, 1), a2 + hstepA, voffA);
            PG8_WAIT_V(8); PG8_WAIT_L(0); PG8_BAR; PG8_MMA(0, 0, At, B0); PG8_MMA(0, 1, At, B1); PG8_BAR; PG8_SCHED;
            PG8_LDA(At, 1, 1); PG8_STAGE(PG8_SB(1, 0), b3, voffB); PG8_STAGE(PG8_SB(1, 1), b3 + hstepB, voffB); PG8_STAGE(PG8_SA(1, 0), a3, voffA);
            PG8_WAIT_V(8); PG8_WAIT_L(0); PG8_BAR; PG8_MMA(1, 0, At, B0); PG8_MMA(1, 1, At, B1); PG8_BAR; PG8_SCHED;
            } else {
            PG8_LDB(B0, 0, 0); PG8_SCHED; PG8_LDA(At, 0, 0); PG8_STAGE(PG8_SA(1, 1), a1 + hstepA, voffA);
            PG8_WAIT_L(8); PG8_BAR; PG8_WAIT_L(0); PG8_MMA(0, 0, At, B0); PG8_BAR; PG8_SCHED;
            PG8_LDB(B1, 0, 1); PG8_STAGE(PG8_SB(0, 0), b2, voffB);
            PG8_BAR; PG8_WAIT_L(0); PG8_MMA(0, 1, At, B1); PG8_BAR;
            PG8_LDA(At, 0, 1); PG8_STAGE(PG8_SA(0, 0), a2, voffA);
            PG8_BAR; PG8_WAIT_L(0); PG8_MMA(1, 0, At, B0); PG8_BAR; PG8_SCHED;
            PG8_STAGE(PG8_SB(0, 1), b2 + hstepB, voffB);
            PG8_WAIT_V(6); PG8_BAR; PG8_MMA(1, 1, At, B1); PG8_BAR;
            PG8_LDB(B0, 1, 0); PG8_SCHED; PG8_LDA(At, 1, 0); PG8_STAGE(PG8_SA(0, 1), a2 + hstepA, voffA);
            PG8_WAIT_L(8); PG8_BAR; PG8_WAIT_L(0); PG8_MMA(0, 0, At, B0); PG8_BAR; PG8_SCHED;
            PG8_LDB(B1, 1, 1); PG8_STAGE(PG8_SB(1, 0), b3, voffB);
            PG8_BAR; PG8_WAIT_L(0); PG8_MMA(0, 1, At, B1); PG8_BAR;
            PG8_LDA(At, 1, 1); PG8_STAGE(PG8_SA(1, 0), a3, voffA);
            PG8_BAR; PG8_WAIT_L(0); PG8_MMA(1, 0, At, B0); PG8_BAR; PG8_SCHED;
            PG8_STAGE(PG8_SB(1, 1), b3 + hstepB, voffB);
            PG8_WAIT_V(6); PG8_BAR; PG8_MMA(1, 1, At, B1); PG8_BAR;
            }
        }
        if constexpr (ALIGN_EPI) { if (wr == 0) PG8_BAR; }
        E(acc, cur, wr, wc, fr, fq);
        if (!has_next) break;
#pragma unroll
        for (int a = 0; a < 2; ++a)
#pragma unroll
            for (int b = 0; b < 2; ++b)
#pragma unroll
                for (int m = 0; m < 4; ++m)
#pragma unroll
                    for (int n = 0; n < 2; ++n) acc[a][b][m][n] = (f32x4){0.f, 0.f, 0.f, 0.f};
        cur = nxt; cA = nA; cB = nB; ++ui;
        if constexpr (ALIGN_EPI) { if (wr == 1) PG8_BAR; }
    }
    PG8_WAIT_V(0);
    if constexpr (!ALIGN_EPI) { if (wr == 0) PG8_BAR; }
    PG8_BAR;
#undef PG8_SA
#undef PG8_SB
#undef PG8_STAGE
#undef PG8_LDA
#undef PG8_LDB
#undef PG8_MMA
#undef PG8_WAIT_V
#undef PG8_WAIT_L
#undef PG8_BAR
#undef PG8_SCHED
}
}
#define GAS __attribute__((address_space(1)))
#define LAS __attribute__((address_space(3)))
typedef unsigned short bf16;
typedef unsigned v4u __attribute__((ext_vector_type(4)));
typedef unsigned v2u __attribute__((ext_vector_type(2)));
typedef float f32x4 __attribute__((ext_vector_type(4)));
typedef short bf16x8 __attribute__((ext_vector_type(8)));
typedef GAS unsigned gu32;
#define RLX_AGENT __ATOMIC_RELAXED, __HIP_MEMORY_SCOPE_AGENT
#define LDS_WAIT() asm volatile("s_waitcnt lgkmcnt(0)" ::: "memory")
#define VM_WAIT() asm volatile("s_waitcnt vmcnt(0)" ::: "memory")

constexpr int NWAVES = 8, NTHR = 512;
constexpr int T = 16896, TP = 16384, D = 1024, FF = 2816, NGU = 2 * FF, NIN = 9232, NINP = 9472;
constexpr int SEQ = 2048, NB = 8, DB = 128, DSEQ = 4;
constexpr float ALPHA = 1.189207115002721f, EPS = 1e-5f;
constexpr int C_Z = 0, C_XM = 1024, C_B = 2048, C_C = 2560, C_Q = 3072, C_F = 4096, C_I = 5120, C_OG = 6144, C_GM = 7168, C_GH = 8192, C_DT = 9216;
constexpr size_t O_Y = 0, O_CONVP = 17301504, O_SSMP = 17350656, O_HGP = 18399232, O_CONVS = 19447808, O_SSMS = 20234240, O_HGS = 37011456, O_END = 53788672;
constexpr size_t MiB = 1u << 20;
constexpr size_t OS_XB = O_SSMS * 4, OS_W1A = O_SSMS * 4 + 36 * MiB, OS_W1D = O_SSMS * 4 + 48 * MiB, OS_WIN = O_HGS * 4;
constexpr size_t WS_CTL = 0, CTL_ZERO_BYTES = 64 * 1024, WS_WMO = 1 * MiB, WS_WHO = 3 * MiB, WS_WO = 5 * MiB, WS_B = 8 * MiB;
constexpr size_t WS_PROJ = WS_B, WS_X2B = WS_B, WS_W2A = WS_B + 36 * MiB, WS_W2D = WS_B + 48 * MiB, WS_H = WS_B + 64 * MiB;
constexpr size_t WS_END = WS_B + (size_t)T * NIN * 2;
static_assert(WS_H + (size_t)T * FF * 2 <= WS_END, "H fits region B");
constexpr int CW_BAR = 1024;
constexpr int RING_BYTES = 131072, LDSCTL_OFF = RING_BYTES, MISC_OFF = LDSCTL_OFF + 320, LDS_BYTES = 147456;

__device__ __forceinline__ unsigned f2bf(float f) { unsigned u = __builtin_bit_cast(unsigned, f); return (u + 0x7fffu + ((u >> 16) & 1u)) >> 16; }
__device__ __forceinline__ unsigned pk2(float lo, float hi) { return f2bf(lo) | (f2bf(hi) << 16); }
__device__ __forceinline__ float bf2f(unsigned u16) { return __builtin_bit_cast(float, u16 << 16); }
__device__ __forceinline__ float bflo(unsigned w) { return __builtin_bit_cast(float, w << 16); }
__device__ __forceinline__ float bfhi(unsigned w) { return __builtin_bit_cast(float, w & 0xffff0000u); }
__device__ __forceinline__ float sigm(float x) { return __builtin_amdgcn_rcpf(1.f + __expf(-x)); }
__device__ __forceinline__ float siluf(float x) { return x * sigm(x); }
__device__ __forceinline__ float wave_sum(float v) {
#pragma unroll
    for (int o = 1; o < 64; o <<= 1) v += __shfl_xor(v, o);
    return v;
}

#define XB_TMO      128
#define XB_XCNT(j)  (256  + 64 * (j))
#define XB_XSUB(j)  (1280 + 64 * (j))
#define XB_XGEN(j)  (2304 + 64 * (j))
#define XB_TOP      3328
#define XB_TOPGEN   3392
#define XCD_BAR_WORDS 3456
#define XB_SPIN_CAP (1u << 20)
__device__ __forceinline__ unsigned xb_ld(unsigned* p)              { return __hip_atomic_load(p, __ATOMIC_RELAXED, __HIP_MEMORY_SCOPE_AGENT); }
__device__ __forceinline__ unsigned xb_add(unsigned* p, unsigned v) { return __hip_atomic_fetch_add(p, v, __ATOMIC_RELAXED, __HIP_MEMORY_SCOPE_AGENT); }
__device__ __forceinline__ unsigned xb_xcc_id() { return (unsigned)__builtin_amdgcn_s_getreg((3 << 11) | 20) & 0xFu; }
#define XB_SPIN(cond, bar) do { unsigned _sp = 0; while (cond) { __builtin_amdgcn_s_sleep(1); \
    if ((++_sp & 255u) == 0u) { if (xb_ld(&(bar)[XB_TMO])) break; if (_sp > XB_SPIN_CAP) { atomicAdd(&(bar)[XB_TMO], 1u); break; } } } } while (0)
struct XcdBarrier { unsigned* bar; unsigned x; volatile LAS unsigned* st; };
__device__ __forceinline__ XcdBarrier xcd_barrier_post(unsigned* bar, volatile LAS unsigned* st) {
    XcdBarrier b; b.bar = bar; b.x = xb_xcc_id(); b.st = st;
    if (threadIdx.x == 0) (void)xb_add(&bar[XB_XCNT(b.x)], 1u);
    return b;
}
__device__ __forceinline__ void xcd_barrier_complete(unsigned* bar, unsigned x, unsigned& nloc, unsigned& nx) {
    const unsigned G = gridDim.x * gridDim.y * gridDim.z;
    unsigned sum, cnt, mine, sp = 0u;
    for (;;) {
        sum = 0u; cnt = 0u; mine = 0u;
#pragma unroll
        for (unsigned j = 0; j < 16; ++j) { const unsigned c = xb_ld(&bar[XB_XCNT(j)]); sum += c; cnt += (c > 0u) ? 1u : 0u; mine = (j == x) ? c : mine; }
        if (sum == G) break;
        __builtin_amdgcn_s_sleep(1);
        if ((++sp & 255u) == 0u) { if (xb_ld(&bar[XB_TMO])) break; if (sp > XB_SPIN_CAP) { atomicAdd(&bar[XB_TMO], 1u); break; } }
    }
    nloc = mine > 0u ? mine : 1u; nx = cnt > 0u ? cnt : 1u;
}
__device__ __forceinline__ void xcd_barrier(const XcdBarrier& b) {
    asm volatile("s_waitcnt vmcnt(0)" ::: "memory");
    __syncthreads();
    if (threadIdx.x == 0) {
        unsigned* bar = b.bar;
        __builtin_amdgcn_s_waitcnt(0);
        unsigned nloc = b.st[0], nx = b.st[1];
        if (nloc == 0u) { xcd_barrier_complete(bar, b.x, nloc, nx); b.st[0] = nloc; b.st[1] = nx; }
        const unsigned old = xb_add(&bar[XB_XSUB(b.x)], 1u);
        const unsigned gen = old / nloc;
        if (old + 1u == (gen + 1u) * nloc) {
            __builtin_amdgcn_fence(__ATOMIC_RELEASE, "agent");
            asm volatile("s_waitcnt vmcnt(0)" ::: "memory");
            const unsigned og = xb_add(&bar[XB_TOP], 1u);
            const unsigned tg = og / nx;
            if (og + 1u == (tg + 1u) * nx) xb_add(&bar[XB_TOPGEN], 1u);
            else XB_SPIN(xb_ld(&bar[XB_TOPGEN]) == tg, bar);
            __builtin_amdgcn_fence(__ATOMIC_ACQUIRE, "agent");
            xb_add(&bar[XB_XGEN(b.x)], 1u);
            asm volatile("s_waitcnt vmcnt(0)" ::: "memory");
        } else {
            XB_SPIN(xb_ld(&bar[XB_XGEN(b.x)]) == gen, bar);
            __builtin_amdgcn_fence(__ATOMIC_ACQUIRE, "agent");
            asm volatile("s_waitcnt vmcnt(0)" ::: "memory");
        }
    }
    __syncthreads();
}

using pg8::Unit;
struct EpiSwiGLU {
    static constexpr bool PERM = true;
    bf16* H;
    __device__ __forceinline__ void operator()(const f32x4 (&acc)[2][2][4][2], const Unit& u, int wr, int wc, int fr, int fq) const {
        const int row0 = u.pm * 256 + wr * 64 + fr, col0 = u.pn * 128 + wc * 32 + 8 * fq;
#pragma unroll
        for (int ai = 0; ai < 2; ++ai)
#pragma unroll
            for (int m = 0; m < 4; ++m) {
                const f32x4 g0 = acc[ai][0][m][0], g1 = acc[ai][0][m][1], u0 = acc[ai][1][m][0], u1 = acc[ai][1][m][1];
                v4u w;
                w.x = pg8::cvt_pk_bf16(siluf(g0[0]) * u0[0], siluf(g0[1]) * u0[1]); w.y = pg8::cvt_pk_bf16(siluf(g0[2]) * u0[2], siluf(g0[3]) * u0[3]);
                w.z = pg8::cvt_pk_bf16(siluf(g1[0]) * u1[0], siluf(g1[1]) * u1[1]); w.w = pg8::cvt_pk_bf16(siluf(g1[2]) * u1[2], siluf(g1[3]) * u1[3]);
                *(v4u*)(H + (size_t)(row0 + ai * 128 + m * 16) * FF + col0) = w;
            }
    }
};
struct EpiBf16N {
    static constexpr bool PERM = true;
    bf16* O; int ldc, ncols;
    __device__ __forceinline__ void operator()(const f32x4 (&acc)[2][2][4][2], const Unit& u, int wr, int wc, int fr, int fq) const {
        const int row0 = u.pm * 256 + wr * 64 + fr, col0 = u.pn * 256 + wc * 32 + 8 * fq;
#pragma unroll
        for (int ai = 0; ai < 2; ++ai)
#pragma unroll
            for (int m = 0; m < 4; ++m) { bf16* rowp = O + (size_t)(row0 + ai * 128 + m * 16) * ldc + col0;
#pragma unroll
                for (int bj = 0; bj < 2; ++bj) { const f32x4 v0 = acc[ai][bj][m][0], v1 = acc[ai][bj][m][1];
                    v4u w; w.x = pg8::cvt_pk_bf16(v0[0], v0[1]); w.y = pg8::cvt_pk_bf16(v0[2], v0[3]); w.z = pg8::cvt_pk_bf16(v1[0], v1[1]); w.w = pg8::cvt_pk_bf16(v1[2], v1[3]);
                    if (col0 + bj * 128 < ncols) *(v4u*)(rowp + bj * 128) = w; } }
    }
};
struct EpiResid {
    static constexpr bool PERM = false;
    const float* res; const float* res2; float* out; float s; bool dry;
    __device__ __forceinline__ void operator()(const f32x4 (&acc)[2][2][4][2], const Unit& u, int wr, int wc, int fr, int fq) const {
        const int row0 = u.pm * 256 + wr * 64 + fr, col0 = u.pn * 256 + wc * 32 + 4 * fq;
        const float* rb = (res2 != nullptr && u.pm >= TP / 256) ? res2 - (size_t)TP * D : res;
#pragma unroll
        for (int ai = 0; ai < 2; ++ai)
#pragma unroll
            for (int m = 0; m < 4; ++m) { const size_t off = (size_t)(row0 + ai * 128 + m * 16) * D + col0;
#pragma unroll
                for (int bj = 0; bj < 2; ++bj)
#pragma unroll
                    for (int n = 0; n < 2; ++n) { const f32x4 r = *(const f32x4*)(rb + off + bj * 128 + n * 16);
                        if (!dry) *(f32x4*)(out + off + bj * 128 + n * 16) = r * ALPHA + acc[ai][bj][m][n] * s; } }
    }
    __device__ __forceinline__ void small(int row, int col, const f32x4 v) const {
        const float* rb = (res2 != nullptr && row >= TP) ? res2 - (size_t)TP * D : res; const size_t off = (size_t)row * D + col;
        const f32x4 r = *(const f32x4*)(rb + off); if (!dry) *(f32x4*)(out + off) = r * ALPHA + v * s;
    }
};
template <bool ADD> struct EpiGate {
    static constexpr bool PERM = true;
    const bf16* gate; bf16* dst; bool dry;
    __device__ __forceinline__ void operator()(const f32x4 (&acc)[2][2][4][2], const Unit& u, int wr, int wc, int fr, int fq) const {
        const int row0 = u.pm * 256 + wr * 64 + fr, col0 = u.pn * 256 + wc * 32 + 8 * fq;
#pragma unroll
        for (int ai = 0; ai < 2; ++ai)
#pragma unroll
            for (int m = 0; m < 4; ++m) { const size_t off = (size_t)(row0 + ai * 128 + m * 16) * NIN + col0;
#pragma unroll
                for (int bj = 0; bj < 2; ++bj) { const f32x4 v0 = acc[ai][bj][m][0], v1 = acc[ai][bj][m][1];
                    const v4u gw = *(const v4u*)(gate + off + bj * 128);
                    float r[8] = { sigm(bflo(gw.x)) * v0[0], sigm(bfhi(gw.x)) * v0[1], sigm(bflo(gw.y)) * v0[2], sigm(bfhi(gw.y)) * v0[3],
                                   sigm(bflo(gw.z)) * v1[0], sigm(bfhi(gw.z)) * v1[1], sigm(bflo(gw.w)) * v1[2], sigm(bfhi(gw.w)) * v1[3] };
                    if (ADD) { const v4u dw = *(const v4u*)(dst + off + bj * 128);
                        r[0] += bflo(dw.x); r[1] += bfhi(dw.x); r[2] += bflo(dw.y); r[3] += bfhi(dw.y); r[4] += bflo(dw.z); r[5] += bfhi(dw.z); r[6] += bflo(dw.w); r[7] += bfhi(dw.w); }
                    v4u w; w.x = pg8::cvt_pk_bf16(r[0], r[1]); w.y = pg8::cvt_pk_bf16(r[2], r[3]); w.z = pg8::cvt_pk_bf16(r[4], r[5]); w.w = pg8::cvt_pk_bf16(r[6], r[7]);
                    if (!dry) *(v4u*)(dst + off + bj * 128) = w; } }
    }
    __device__ __forceinline__ void small(int row, int col, const f32x4 v) const {
        const size_t off = (size_t)row * NIN + col; const v2u gw = *(const v2u*)(gate + off);
        float r[4] = { sigm(bflo(gw.x)) * v[0], sigm(bfhi(gw.x)) * v[1], sigm(bflo(gw.y)) * v[2], sigm(bfhi(gw.y)) * v[3] };
        if (ADD) { const v2u dw = *(const v2u*)(dst + off); r[0] += bflo(dw.x); r[1] += bfhi(dw.x); r[2] += bflo(dw.y); r[3] += bfhi(dw.y); }
        if (!dry) *(v2u*)(dst + off) = (v2u){pg8::cvt_pk_bf16(r[0], r[1]), pg8::cvt_pk_bf16(r[2], r[3])};
    }
};

template <int KS  , class Epi>
__device__ __forceinline__ void small_gemm(const bf16* A, int lda, const bf16* Bt, int K, const Epi& E, LAS unsigned char* lds, int bx, int G, int tid, int wave, int lane) {
    const int fr = lane & 15, fq = lane >> 4;
    LAS float* red = (LAS float*)lds;
    for (int u = bx; u < 256; u += G) {
        const int r0 = TP + 32 * (u >> 4), c0 = 64 * (u & 15);
        f32x4 acc[2][4];
#pragma unroll
        for (int m = 0; m < 2; ++m)
#pragma unroll
            for (int n = 0; n < 4; ++n) acc[m][n] = (f32x4){0.f, 0.f, 0.f, 0.f};
        const bf16* pa = A + (size_t)(r0 + fr) * lda + wave * (KS * 32) + 8 * fq; const bf16* pb = Bt + (size_t)(c0 + fr) * K + wave * (KS * 32) + 8 * fq;
#pragma unroll 4
        for (int ks = 0; ks < KS; ++ks) {
            bf16x8 a[2], b[4];
#pragma unroll
            for (int m = 0; m < 2; ++m) a[m] = *(const bf16x8*)(pa + (size_t)(16 * m) * lda + 32 * ks);
#pragma unroll
            for (int n = 0; n < 4; ++n) b[n] = *(const bf16x8*)(pb + (size_t)(16 * n) * K + 32 * ks);
#pragma unroll
            for (int m = 0; m < 2; ++m)
#pragma unroll
                for (int n = 0; n < 4; ++n) acc[m][n] = __builtin_amdgcn_mfma_f32_16x16x32_bf16(b[n], a[m], acc[m][n], 0, 0, 0);
        }
#pragma unroll
        for (int m = 0; m < 2; ++m)
#pragma unroll
            for (int n = 0; n < 4; ++n) *(LAS f32x4*)(red + (wave * 32 + 16 * m + fr) * 64 + 16 * n + 4 * fq) = acc[m][n];
        __syncthreads();
        { const int row = tid >> 4, col = (tid & 15) * 4; f32x4 v = (f32x4){0.f, 0.f, 0.f, 0.f};
#pragma unroll
            for (int w = 0; w < 8; ++w) v += *(const LAS f32x4*)(red + (w * 32 + row) * 64 + col);
            E.small(r0 + row, c0 + col, v); }
        __syncthreads();
    }
}
__device__ __forceinline__ void transpose_item(const float* W, int ldw, int srccol0, int ncopy, bf16* WT, int dstrow0, int K, int k0, LAS float* scr, int lane) {
#pragma unroll 8
    for (int i = 0; i < 32; ++i) { const int kk = 2 * i + (lane >> 5), n = lane & 31; scr[kk * 33 + n] = (n < ncopy) ? W[(size_t)(k0 + kk) * ldw + srccol0 + n] : 0.f; }
    LDS_WAIT(); asm volatile("" ::: "memory");
    const int c = lane & 7;
#pragma unroll
    for (int j = 0; j < 4; ++j) { const int n = (lane >> 3) + 8 * j; const LAS float* s = scr + (8 * c) * 33 + n;
        v4u o; o.x = pk2(s[0 * 33], s[1 * 33]); o.y = pk2(s[2 * 33], s[3 * 33]); o.z = pk2(s[4 * 33], s[5 * 33]); o.w = pk2(s[6 * 33], s[7 * 33]);
        *(v4u*)(WT + (size_t)(dstrow0 + n) * K + k0 + 8 * c) = o; }
    LDS_WAIT(); asm volatile("" ::: "memory");
}
__device__ __forceinline__ void ffn_weight_items(const float* Wg, const float* Wu, const float* Wd, bf16* WA, bf16* WD, LAS float* scr, int gw, int NGW, int lane) {
    constexpr int I_A = (NGU / 32) * (D / 64), I_D = (D / 32) * (FF / 64);
    for (int it = gw; it < I_A + I_D; it += NGW) {
        if (it < I_A) { const int gi = it / (D / 64), kb = it % (D / 64), n0 = 32 * gi, pn = n0 >> 8, bj = (n0 >> 7) & 1, i0 = n0 & 127;
            transpose_item(bj ? Wu : Wg, FF, 128 * pn + i0, 32, WA, n0, D, 64 * kb, scr, lane); }
        else { const int r = it - I_A, gi = r / (FF / 64), kb = r % (FF / 64);
            transpose_item(Wd, D, 32 * gi, 32, WD, 32 * gi, FF, 64 * kb, scr, lane); }
    }
}
__device__ __forceinline__ void p0_prologue(const float* const* in, unsigned char* outb, unsigned char* ws, LAS unsigned char* lds, int vcu, int G, int wave, int lane) {
    LAS float* scr = (LAS float*)(lds + wave * 16384);
    const int gw = vcu * NWAVES + wave, NGW = G * NWAVES;
    ffn_weight_items(in[5], in[6], in[7], (bf16*)(outb + OS_W1A), (bf16*)(outb + OS_W1D), scr, gw, NGW, lane);
    constexpr int I_IN = (NINP / 32) * (D / 64), I_SQ = (D / 32) * (D / 64);
    for (int it = gw; it < I_IN + 3 * I_SQ; it += NGW) {
        if (it < I_IN) { const int gi = it / (D / 64), kb = it % (D / 64), n0 = 32 * gi;
            int src, ncopy;
            if (n0 < 3072) { src = n0; ncopy = 32; } else if (n0 < C_DT) { src = n0 + 16; ncopy = 32; } else if (n0 == C_DT) { src = 3072; ncopy = 16; } else { src = 0; ncopy = 0; }
            transpose_item(in[10], NIN, src, ncopy, (bf16*)(outb + OS_WIN), n0, D, 64 * kb, scr, lane); }
        else { const int r = it - I_IN, w = r / I_SQ, r2 = r % I_SQ, gi = r2 / (D / 64), kb = r2 % (D / 64);
            const float* W = in[w == 0 ? 17 : (w == 1 ? 20 : 21)]; bf16* WT = (bf16*)(ws + (w == 0 ? WS_WMO : (w == 1 ? WS_WHO : WS_WO)));
            transpose_item(W, D, 32 * gi, 32, WT, 32 * gi, D, 64 * kb, scr, lane); }
    }
    bf16* XB = (bf16*)(outb + OS_XB);
    const size_t n8 = (size_t)T * D / 8, nthr = (size_t)G * NTHR;
    for (size_t i = (size_t)vcu * NTHR + threadIdx.x; i < n8; i += nthr) {
        const size_t e = i * 8; const float* src = (e < (size_t)TP * D) ? in[0] + e : in[1] + (e - (size_t)TP * D);
        const f32x4 a = *(const f32x4*)src, b = *(const f32x4*)(src + 4);
        v4u w; w.x = pk2(a[0], a[1]); w.y = pk2(a[2], a[3]); w.z = pk2(b[0], b[1]); w.w = pk2(b[2], b[3]);
        *(v4u*)(XB + e) = w;
    }
}
__device__ __forceinline__ void ln_phase(float* X, bf16* XBo, const float* gam, const float* bet, int vcu, int G, int wave, int lane, bool dry) {
    const int gw = vcu * NWAVES + wave, NGW = G * NWAVES;
    f32x4 gv[4], bv[4];
#pragma unroll
    for (int j = 0; j < 4; ++j) { gv[j] = *(const f32x4*)(gam + 4 * lane + 256 * j); bv[j] = *(const f32x4*)(bet + 4 * lane + 256 * j); }
    for (int m = gw; m < T; m += NGW) {
        f32x4* xr = (f32x4*)(X + (size_t)m * D) + lane;
        f32x4 v[4]; float s = 0.f;
#pragma unroll
        for (int j = 0; j < 4; ++j) { v[j] = xr[64 * j]; s += (v[j][0] + v[j][1]) + (v[j][2] + v[j][3]); }
        const float mean = wave_sum(s) * (1.f / D); float s2 = 0.f;
#pragma unroll
        for (int j = 0; j < 4; ++j) { v[j] = v[j] - mean; s2 += (v[j][0] * v[j][0] + v[j][1] * v[j][1]) + (v[j][2] * v[j][2] + v[j][3] * v[j][3]); }
        const float rstd = 1.f / sqrtf(wave_sum(s2) * (1.f / D) + EPS);
#pragma unroll
        for (int j = 0; j < 4; ++j) { const f32x4 o = v[j] * rstd * gv[j] + bv[j]; if (dry) continue; xr[64 * j] = o;
            if (XBo) { v2u w; w.x = pk2(o[0], o[1]); w.y = pk2(o[2], o[3]); *((v2u*)(XBo + (size_t)m * D) + lane + 64 * j) = w; } }
    }
}
__device__ __forceinline__ void norm_phase(bf16* PROJ, const float* mw, const float* hw, int vcu, int G, int wave, int lane, bool dry) {
    const int gw = vcu * NWAVES + wave, NGW = G * NWAVES;
    float mwv[16], hwv[16];
#pragma unroll
    for (int j = 0; j < 16; ++j) { mwv[j] = mw[16 * lane + j]; hwv[j] = hw[16 * lane + j]; }
    for (int m = gw; m < T; m += NGW) {
        bf16* row = PROJ + (size_t)m * NIN;
        const v4u y0 = *(const v4u*)(row + C_XM + 16 * lane), y1 = *(const v4u*)(row + C_XM + 16 * lane + 8);
        const v4u z0 = *(const v4u*)(row + C_Z + 16 * lane), z1 = *(const v4u*)(row + C_Z + 16 * lane + 8);
        const v4u o0 = *(const v4u*)(row + C_I + 16 * lane), o1 = *(const v4u*)(row + C_I + 16 * lane + 8);
        const v4u g0 = *(const v4u*)(row + C_OG + 16 * lane), g1 = *(const v4u*)(row + C_OG + 16 * lane + 8);
        float a[16], b[16];
        const unsigned yw[8] = {y0.x, y0.y, y0.z, y0.w, y1.x, y1.y, y1.z, y1.w}, zw[8] = {z0.x, z0.y, z0.z, z0.w, z1.x, z1.y, z1.z, z1.w};
        const unsigned ow[8] = {o0.x, o0.y, o0.z, o0.w, o1.x, o1.y, o1.z, o1.w}, gww[8] = {g0.x, g0.y, g0.z, g0.w, g1.x, g1.y, g1.z, g1.w};
        float sa = 0.f, sb = 0.f;
#pragma unroll
        for (int j = 0; j < 8; ++j) {
            a[2 * j] = bflo(yw[j]) * siluf(bflo(zw[j])); a[2 * j + 1] = bfhi(yw[j]) * siluf(bfhi(zw[j]));
            b[2 * j] = bflo(ow[j]); b[2 * j + 1] = bfhi(ow[j]);
            sa += a[2 * j] * a[2 * j] + a[2 * j + 1] * a[2 * j + 1]; sb += b[2 * j] * b[2 * j] + b[2 * j + 1] * b[2 * j + 1];
        }
        sb += __shfl_xor(sb, 1); sb += __shfl_xor(sb, 2); sb += __shfl_xor(sb, 4);
        sa += __shfl_xor(sa, 1); sa += __shfl_xor(sa, 2); sa += __shfl_xor(sa, 4); sa += __shfl_xor(sa, 8);
        const float ra = 1.f / sqrtf(sa * (1.f / 256.f) + EPS), rb = 1.f / sqrtf(sb * (1.f / 128.f) + EPS);
        unsigned wa[8], wb[8];
#pragma unroll
        for (int j = 0; j < 8; ++j) {
            wa[j] = pk2(a[2 * j] * ra * mwv[2 * j], a[2 * j + 1] * ra * mwv[2 * j + 1]);
            wb[j] = pk2(b[2 * j] * rb * hwv[2 * j] * siluf(bflo(gww[j])), b[2 * j + 1] * rb * hwv[2 * j + 1] * siluf(bfhi(gww[j])));
        }
        if (dry) continue;
        *(v4u*)(row + C_XM + 16 * lane) = (v4u){wa[0], wa[1], wa[2], wa[3]}; *(v4u*)(row + C_XM + 16 * lane + 8) = (v4u){wa[4], wa[5], wa[6], wa[7]};
        *(v4u*)(row + C_I + 16 * lane) = (v4u){wb[0], wb[1], wb[2], wb[3]}; *(v4u*)(row + C_I + 16 * lane + 8) = (v4u){wb[4], wb[5], wb[6], wb[7]};
    }
}
typedef short v4s __attribute__((ext_vector_type(4)));
constexpr size_t WS_DECH = 7 * MiB, WS_DTF = WS_END, WS_ACF = WS_DTF + (size_t)T * 16 * 4, WS_TAIL = WS_ACF + (size_t)T * 16 * 4, WS_END2 = WS_TAIL + (size_t)256 * 3 * 2048 * 2;

__device__ __forceinline__ void unpack4(const v2u w, float (&f)[4]) { f[0] = bflo(w.x); f[1] = bfhi(w.x); f[2] = bflo(w.y); f[3] = bfhi(w.y); }

__device__ __forceinline__ void prep_chunk(int ci, bf16* PROJ, const float* const* in, float* out, unsigned char* ws, int tid, int wave, int lane) {
    const int b = ci >> 5, c = ci & 31; const size_t r0 = (size_t)b * SEQ + (size_t)c * 64;
    float* DTF = (float*)(ws + WS_DTF); float* ACF = (float*)(ws + WS_ACF); float* DECH = (float*)(ws + WS_DECH); bf16* TAIL = (bf16*)(ws + WS_TAIL);
#pragma unroll
    for (int q = 0; q < 2; ++q) { const int h = 2 * wave + q;
        const float xr = bf2f(PROJ[(r0 + lane) * NIN + C_DT + h]) + in[13][h]; const float dt = xr > 20.f ? xr : log1pf(__expf(xr));
        float v = -__expf(in[14][h]) * dt;
#pragma unroll
        for (int o = 1; o < 64; o <<= 1) { const float tt = __shfl_up(v, o); if (lane >= o) v += tt; }
        DTF[(r0 + lane) * 16 + h] = dt; ACF[(r0 + lane) * 16 + h] = v; }
    { const int ch4 = 4 * tid; bf16* colp = PROJ + r0 * NIN + C_XM + ch4;
        const f32x4 cw0 = *(const f32x4*)(in[11] + ch4), cw1 = *(const f32x4*)(in[11] + 2048 + ch4), cw2 = *(const f32x4*)(in[11] + 4096 + ch4), cw3 = *(const f32x4*)(in[11] + 6144 + ch4), cbv = *(const f32x4*)(in[12] + ch4);
        float w0[4] = {0.f, 0.f, 0.f, 0.f}, w1[4] = {0.f, 0.f, 0.f, 0.f}, w2[4] = {0.f, 0.f, 0.f, 0.f};
        if (c > 0) { unpack4(*(const v2u*)(colp - 3 * (size_t)NIN), w0); unpack4(*(const v2u*)(colp - 2 * (size_t)NIN), w1); unpack4(*(const v2u*)(colp - (size_t)NIN), w2); }
#pragma unroll 1
        for (int tb = 0; tb < 64; tb += 16) {
            v2u raw[16];
#pragma unroll
            for (int i = 0; i < 16; ++i) raw[i] = *(const v2u*)(colp + (size_t)(tb + i) * NIN);
#pragma unroll
            for (int i = 0; i < 16; ++i) { float x[4]; unpack4(raw[i], x); float o[4];
#pragma unroll
                for (int j = 0; j < 4; ++j) { o[j] = siluf(cbv[j] + cw0[j] * w0[j] + cw1[j] * w1[j] + cw2[j] * w2[j] + cw3[j] * x[j]); w0[j] = w1[j]; w1[j] = w2[j]; w2[j] = x[j]; }
                const v2u ow = (v2u){pk2(o[0], o[1]), pk2(o[2], o[3])}; const int t = tb + i;
                if (t < 61) *(v2u*)(colp + (size_t)t * NIN) = ow; else *(v2u*)(TAIL + ((size_t)ci * 3 + (t - 61)) * 2048 + ch4) = ow;
                if (c == 31 && t >= 61) *(f32x4*)(out + O_CONVP + ((size_t)b * 3 + (t - 61)) * 2048 + ch4) = (f32x4){x[0], x[1], x[2], x[3]}; }
        } }
    { const int k2 = 2 * tid; bf16* qp = PROJ + r0 * NIN + C_Q + k2; bf16* fp = PROJ + r0 * NIN + C_F + k2;
        const float lb0 = sigm(in[18][k2] - in[18][1024 + k2]), lb1 = sigm(in[18][k2 + 1] - in[18][1024 + k2 + 1]);
        float run0 = 0.f, run1 = 0.f;
#pragma unroll 1
        for (int tb = 0; tb < 64; tb += 16) {
            unsigned qr[16], fr_[16];
#pragma unroll
            for (int i = 0; i < 16; ++i) { qr[i] = *(const unsigned*)(qp + (size_t)(tb + i) * NIN); fr_[i] = *(const unsigned*)(fp + (size_t)(tb + i) * NIN); }
#pragma unroll
            for (int i = 0; i < 16; ++i) {
                const float s0 = sigm(bflo(fr_[i])), s1 = sigm(bfhi(fr_[i]));
                run0 += __logf(lb0 + (1.f - lb0) * s0); run1 += __logf(lb1 + (1.f - lb1) * s1);
                const float e0 = __expf(run0), e1 = __expf(run1);
                *(unsigned*)(qp + (size_t)(tb + i) * NIN) = pk2(bflo(qr[i]) * e0, bfhi(qr[i]) * e1);
                *(unsigned*)(fp + (size_t)(tb + i) * NIN) = pk2((1.f - lb0) * (1.f - s0) * __builtin_amdgcn_rcpf(e0), (1.f - lb1) * (1.f - s1) * __builtin_amdgcn_rcpf(e1)); }
        }
        DECH[(size_t)ci * 1024 + k2] = __expf(run0); DECH[(size_t)ci * 1024 + k2 + 1] = __expf(run1); }
}

constexpr int S_QC = 136, S_X = 40, S_WT = 72;
constexpr int G_QC = 0, G_KB = 17408, G_X = 34816, G_XS = 39936, G_WT = 45056, G_ST = 54272, G_FA = 62976, GRP_BYTES = 64000;
static_assert(2 * GRP_BYTES <= RING_BYTES, "scan LDS map");
__device__ __forceinline__ bf16x8 row_frag(const LAS bf16* img, int stride, int row, int k) { return *(const LAS bf16x8*)(img + row * stride + k); }
__device__ __forceinline__ bf16x8 tr_frag(const LAS bf16* img, int stride, int k0, int c0, int fr) {
    const LAS bf16* p = img + (k0 + (fr >> 2)) * stride + c0 + 4 * (fr & 3);
    const v4s lo = __builtin_amdgcn_ds_read_tr16_b64_v4i16((LAS v4s*)p), hi = __builtin_amdgcn_ds_read_tr16_b64_v4i16((LAS v4s*)(p + 4 * stride));
    return (bf16x8){lo[0], lo[1], lo[2], lo[3], hi[0], hi[1], hi[2], hi[3]};
}
constexpr unsigned pack2(const int (&a)[10]) { unsigned r = 0; for (int i = 0; i < 10; ++i) r |= (unsigned)a[i] << (2 * i); return r; }
constexpr int TB_LIST[10] = {3, 3, 2, 2, 3, 3, 2, 1, 0, 1}, SB_LIST[10] = {0, 2, 0, 2, 1, 3, 1, 1, 0, 0};
constexpr unsigned TB_PK = pack2(TB_LIST), SB_PK = pack2(SB_LIST);

__device__ __forceinline__ void scan_pair_job(int pj, bf16* PROJ, float* out, unsigned char* ws, const float* const* in, LAS unsigned char* lds, int tid0, int wave, bool dry) {
    const bool ssd = wave < 4; const int w4 = wave & 3;
    LAS unsigned char* gl = lds + (ssd ? 0 : GRP_BYTES);
    LAS bf16* QC = (LAS bf16*)(gl + G_QC); LAS bf16* KB = (LAS bf16*)(gl + G_KB); LAS bf16* XN = (LAS bf16*)(gl + G_X); LAS bf16* XS = (LAS bf16*)(gl + (ssd ? G_XS : G_X));
    LAS bf16* WT = (LAS bf16*)(gl + G_WT); LAS bf16* ST = (LAS bf16*)(gl + G_ST); LAS float* ACUM = (LAS float*)(gl + G_FA); LAS float* DT = ACUM + 64; LAS float* DEC = ACUM + 128;
    const float* DTF = (const float*)(ws + WS_DTF); const float* ACF = (const float*)(ws + WS_ACF); const float* DECH = (const float*)(ws + WS_DECH); const bf16* TAIL = (const bf16*)(ws + WS_TAIL);
    int b, colC, colB, colX, chC = 0, chB = 0, chX = 0, h = 0, half = 0, hd = 0, vq = 0;
    if (ssd) { b = pj >> 5; h = (pj >> 1) & 15; half = pj & 1; const int g = h >> 2; colX = C_XM + h * 64 + half * 32; colB = C_B + g * 128; colC = C_C + g * 128; chX = h * 64 + half * 32; chB = 1024 + g * 128; chC = 1536 + g * 128; }
    else { b = pj >> 5; hd = (pj >> 2) & 7; vq = pj & 3; colB = C_F + hd * 128; colC = C_Q + hd * 128; colX = C_I + hd * 128 + vq * 32; }
    const size_t rowbase = (size_t)b * SEQ;
    const float Dh = ssd ? in[15][h] : 0.f;
    f32x4 st[4];
#pragma unroll
    for (int i = 0; i < 4; ++i) st[i] = (f32x4){0.f, 0.f, 0.f, 0.f};
    { const int gt = tid0 & 255; for (int i = gt; i < (G_FA - G_WT) / 4; i += 256) ((LAS unsigned*)(gl + G_WT))[i] = 0u; }
    v4u pfC[4], pfB[4], pfX; float fa = 0.f, fb = 0.f;
#define LOAD_REGS(c_) do { const int ci_ = b * 32 + (c_); const bf16* base_ = PROJ + (rowbase + (size_t)(c_) * 64) * NIN; \
        _Pragma("unroll") for (int j = 0; j < 4; ++j) { const int i = gt + 256 * j, row = i >> 4, c16 = i & 15; const bool tl = ssd && row >= 61; \
            const bf16* tb_ = TAIL + ((size_t)ci_ * 3 + (row - 61)) * 2048 + c16 * 8; \
            pfC[j] = *(const v4u*)(tl ? tb_ + chC : base_ + (size_t)row * NIN + colC + c16 * 8); pfB[j] = *(const v4u*)(tl ? tb_ + chB : base_ + (size_t)row * NIN + colB + c16 * 8); } \
        { const int row = gt >> 2, c16 = gt & 3; const bool tl = ssd && row >= 61; \
            pfX = *(const v4u*)(tl ? TAIL + ((size_t)ci_ * 3 + (row - 61)) * 2048 + chX + c16 * 8 : base_ + (size_t)row * NIN + colX + c16 * 8); } \
        if (ssd) { if (gt < 64) { fa = ACF[(rowbase + (size_t)(c_) * 64 + gt) * 16 + h]; fb = DTF[(rowbase + (size_t)(c_) * 64 + gt) * 16 + h]; } } \
        else if (gt < 128) fa = DECH[(size_t)ci_ * 1024 + hd * 128 + gt]; } while (0)
#define STORE_REGS() do { \
        _Pragma("unroll") for (int j = 0; j < 4; ++j) { const int i = gt + 256 * j, row = i >> 4, c16 = i & 15; \
            *(LAS v4u*)(QC + row * S_QC + c16 * 8) = pfC[j]; *(LAS v4u*)(KB + row * S_QC + c16 * 8) = pfB[j]; } \
        *(LAS v4u*)(XN + (gt >> 2) * S_X + (gt & 3) * 8) = pfX; \
        if (ssd) { if (gt < 64) { ACUM[gt] = fa; DT[gt] = fb; } } else if (gt < 128) DEC[gt] = fa; } while (0)
    { const int gt = tid0 & 255; LOAD_REGS(0); }
    for (int c = 0; c < SEQ / 64; ++c) {
        int tid_v = tid0; asm volatile("" : "+v"(tid_v));
        const int gt = tid_v & 255, lane = tid_v & 63, fr = lane & 15, fq = lane >> 4;
        STORE_REGS();
        __syncthreads();
        if (c + 1 < SEQ / 64) LOAD_REGS(c + 1);
        const size_t t0 = rowbase + (size_t)c * 64;
        const float alast = ssd ? ACUM[63] : 0.f;
        if (ssd) {
            const int s = gt >> 2, p8 = (gt & 3) * 8; const float sc = __expf(alast - ACUM[s]) * DT[s];
            float x[8]; const v4u xw = *(const LAS v4u*)(XN + s * S_X + p8);
            x[0] = bflo(xw.x); x[1] = bfhi(xw.x); x[2] = bflo(xw.y); x[3] = bfhi(xw.y); x[4] = bflo(xw.z); x[5] = bfhi(xw.z); x[6] = bflo(xw.w); x[7] = bfhi(xw.w);
            *(LAS v4u*)(XS + s * S_X + p8) = (v4u){pk2(x[0] * sc, x[1] * sc), pk2(x[2] * sc, x[3] * sc), pk2(x[4] * sc, x[5] * sc), pk2(x[6] * sc, x[7] * sc)};
        }
        for (int idx = w4; idx < 10; idx += 4) { const int tb = (TB_PK >> (2 * idx)) & 3, sb = (SB_PK >> (2 * idx)) & 3; const int t = 16 * tb + fr, s0 = 16 * sb + 4 * fq;
            f32x4 g = (f32x4){0.f, 0.f, 0.f, 0.f};
#pragma unroll
            for (int k0 = 0; k0 < 128; k0 += 32) g = __builtin_amdgcn_mfma_f32_16x16x32_bf16(row_frag(KB, S_QC, 16 * sb + fr, k0 + 8 * fq), row_frag(QC, S_QC, t, k0 + 8 * fq), g, 0, 0, 0);
            float w[4];
            if (ssd) { const float at = ACUM[t]; const f32x4 as = *(const LAS f32x4*)(ACUM + s0), ds = *(const LAS f32x4*)(DT + s0);
#pragma unroll
                for (int j = 0; j < 4; ++j) w[j] = (s0 + j <= t) ? g[j] * __expf(fminf(at - as[j], 0.f)) * ds[j] : 0.f;
            } else {
#pragma unroll
                for (int j = 0; j < 4; ++j) w[j] = (s0 + j <= t) ? g[j] : 0.f;
            }
            *(LAS v2u*)(WT + t * S_WT + s0) = (v2u){pk2(w[0], w[1]), pk2(w[2], w[3])}; }
        __syncthreads();
        { const int t = 16 * w4 + fr; const float rs = ssd ? __expf(ACUM[t]) : 1.f;
            bf16x8 qa[4];
#pragma unroll
            for (int ks = 0; ks < 4; ++ks) qa[ks] = row_frag(QC, S_QC, t, 32 * ks + 8 * fq);
            const bf16x8 wa0 = row_frag(WT, S_WT, t, 8 * fq), wa1 = row_frag(WT, S_WT, t, 32 + 8 * fq);
#pragma unroll
            for (int pb = 0; pb < 2; ++pb) {
                f32x4 y = (f32x4){0.f, 0.f, 0.f, 0.f};
#pragma unroll
                for (int ks = 0; ks < 4; ++ks) y = __builtin_amdgcn_mfma_f32_16x16x32_bf16(row_frag(ST, S_QC, 16 * pb + fr, 32 * ks + 8 * fq), qa[ks], y, 0, 0, 0);
                y = y * rs;
                y = __builtin_amdgcn_mfma_f32_16x16x32_bf16(tr_frag(XN, S_X, 8 * fq, 16 * pb, fr), wa0, y, 0, 0, 0);
                if (w4 >= 2) y = __builtin_amdgcn_mfma_f32_16x16x32_bf16(tr_frag(XN, S_X, 32 + 8 * fq, 16 * pb, fr), wa1, y, 0, 0, 0);
                const int p0 = 16 * pb + 4 * fq;
                if (ssd) { const v2u xw = *(const LAS v2u*)(XN + t * S_X + p0); y[0] += Dh * bflo(xw.x); y[1] += Dh * bfhi(xw.x); y[2] += Dh * bflo(xw.y); y[3] += Dh * bfhi(xw.y); }
                if (!dry) *(v2u*)(PROJ + (t0 + t) * NIN + colX + p0) = (v2u){pk2(y[0], y[1]), pk2(y[2], y[3])};
            } }
        { const float dsc = ssd ? __expf(alast) : 1.f;
#pragma unroll
            for (int q = 0; q < 2; ++q) { const int n0 = 16 * (2 * w4 + q);
                const bf16x8 kb0 = tr_frag(KB, S_QC, 8 * fq, n0, fr), kb1 = tr_frag(KB, S_QC, 32 + 8 * fq, n0, fr);
                f32x4 dv = (f32x4){1.f, 1.f, 1.f, 1.f}; if (!ssd) dv = *(const LAS f32x4*)(DEC + n0 + 4 * fq);
#pragma unroll
                for (int pb = 0; pb < 2; ++pb) { f32x4 a = st[2 * q + pb] * dsc;
                    a = __builtin_amdgcn_mfma_f32_16x16x32_bf16(kb0, tr_frag(XS, S_X, 8 * fq, 16 * pb, fr), a, 0, 0, 0);
                    a = __builtin_amdgcn_mfma_f32_16x16x32_bf16(kb1, tr_frag(XS, S_X, 32 + 8 * fq, 16 * pb, fr), a, 0, 0, 0);
                    st[2 * q + pb] = a * dv; } } }
        __syncthreads();
#pragma unroll
        for (int q = 0; q < 2; ++q)
#pragma unroll
            for (int pb = 0; pb < 2; ++pb) *(LAS v2u*)(ST + (16 * pb + fr) * S_QC + 16 * (2 * w4 + q) + 4 * fq) = (v2u){pk2(st[2 * q + pb][0], st[2 * q + pb][1]), pk2(st[2 * q + pb][2], st[2 * q + pb][3])};
    }
#undef LOAD_REGS
#undef STORE_REGS
    if (!dry) { const int lane = tid0 & 63, fr = lane & 15, fq = lane >> 4;
#pragma unroll
        for (int q = 0; q < 2; ++q)
#pragma unroll
            for (int pb = 0; pb < 2; ++pb) { const int n0 = 16 * (2 * w4 + q) + 4 * fq, p = 16 * pb + fr; const f32x4 v = st[2 * q + pb];
                if (ssd) *(f32x4*)(out + O_SSMP + (((size_t)(b * 16 + h) * 64 + half * 32 + p) * 128 + n0)) = v;
                else {
#pragma unroll
                    for (int j = 0; j < 4; ++j) out[O_HGP + (((size_t)(b * 8 + hd) * 128 + n0 + j) * 128 + vq * 32 + p)] = v[j]; } } }
    __syncthreads();
}

__device__ __forceinline__ void ssd_sample_job(int job, bf16* PROJ, const float* const* in, float* out, LAS unsigned char* lds, int tid, bool dry) {
    const int sb = job >> 4, h = job & 15, g = h >> 2; const size_t row0 = (size_t)TP + 4 * sb;
    LAS float* SX = (LAS float*)lds; LAS float* SBm = SX + 4 * 64; LAS float* SCm = SBm + 4 * 128; LAS float* SDT = SCm + 4 * 128;
    if (tid < 320) {
        int col, cc; LAS float* dst; int dstride, di;
        if (tid < 64) { col = C_XM + h * 64 + tid; cc = h * 64 + tid; dst = SX; dstride = 64; di = tid; }
        else if (tid < 192) { col = C_B + g * 128 + (tid - 64); cc = 1024 + g * 128 + (tid - 64); dst = SBm; dstride = 128; di = tid - 64; }
        else { col = C_C + g * 128 + (tid - 192); cc = 1536 + g * 128 + (tid - 192); dst = SCm; dstride = 128; di = tid - 192; }
        float u[7];
#pragma unroll
        for (int j = 0; j < 3; ++j) u[j] = in[2][((size_t)sb * 3 + j) * 2048 + cc];
#pragma unroll
        for (int j = 0; j < 4; ++j) u[3 + j] = bf2f(PROJ[(row0 + j) * NIN + col]);
        const float w0 = in[11][cc], w1 = in[11][2048 + cc], w2 = in[11][4096 + cc], w3 = in[11][6144 + cc], bb = in[12][cc];
#pragma unroll
        for (int t = 0; t < 4; ++t) dst[t * dstride + di] = siluf(bb + w0 * u[t] + w1 * u[t + 1] + w2 * u[t + 2] + w3 * u[t + 3]);
        if (!dry && (tid < 64 || (h & 3) == 0)) {
#pragma unroll
            for (int j = 0; j < 3; ++j) out[O_CONVS + ((size_t)sb * 3 + j) * 2048 + cc] = u[4 + j];
        }
    } else if (tid < 324) { const int t = tid - 320; const float xr = bf2f(PROJ[(row0 + t) * NIN + C_DT + h]) + in[13][h]; SDT[t] = xr > 20.f ? xr : log1pf(__expf(xr)); }
    __syncthreads();
    const int p = tid >> 3, nq = tid & 7;
    const float a_neg = -__expf(in[14][h]), Dh = in[15][h];
    const size_t sbase = (((size_t)sb * 16 + h) * 64 + p) * 128 + 16 * nq;
    float hs[16];
#pragma unroll
    for (int i = 0; i < 4; ++i) { const f32x4 v = *(const f32x4*)(in[3] + sbase + 4 * i); hs[4 * i] = v[0]; hs[4 * i + 1] = v[1]; hs[4 * i + 2] = v[2]; hs[4 * i + 3] = v[3]; }
#pragma unroll
    for (int t = 0; t < 4; ++t) {
        const float dt = SDT[t], dec = __expf(dt * a_neg), xv = SX[t * 64 + p], xb = dt * xv; float part = 0.f;
#pragma unroll
        for (int i = 0; i < 16; ++i) { hs[i] = dec * hs[i] + xb * SBm[t * 128 + 16 * nq + i]; part += hs[i] * SCm[t * 128 + 16 * nq + i]; }
        part += __shfl_xor(part, 1); part += __shfl_xor(part, 2); part += __shfl_xor(part, 4);
        if (nq == 0 && !dry) PROJ[(row0 + t) * NIN + C_XM + h * 64 + p] = (bf16)f2bf(part + Dh * xv);
    }
    if (!dry)
#pragma unroll
    for (int i = 0; i < 4; ++i) *(f32x4*)(out + O_SSMS + sbase + 4 * i) = (f32x4){hs[4 * i], hs[4 * i + 1], hs[4 * i + 2], hs[4 * i + 3]};
    __syncthreads();
}
__device__ __forceinline__ void hgrn_sample_job(int job, bf16* PROJ, const float* const* in, float* out, LAS unsigned char* lds, int tid, bool dry) {
    const int sb = job >> 3, hd = job & 7; const size_t row0 = (size_t)TP + 4 * sb;
    LAS float* SQ = (LAS float*)lds; LAS float* SF = SQ + 512; LAS float* SK = SF + 512; LAS float* SV = SK + 512; LAS float* PP = SV + 512;
    if (tid < 128) { const int k = tid; const float lb = sigm(in[18][hd * 128 + k] - in[18][1024 + hd * 128 + k]);
#pragma unroll
        for (int t = 0; t < 4; ++t) { const float frw = bf2f(PROJ[(row0 + t) * NIN + C_F + hd * 128 + k]), q = bf2f(PROJ[(row0 + t) * NIN + C_Q + hd * 128 + k]);
            const float sg = sigm(frw); SF[t * 128 + k] = lb + (1.f - lb) * sg; SK[t * 128 + k] = (1.f - lb) * (1.f - sg); SQ[t * 128 + k] = q; } }
    else if (tid < 256) { const int v = tid - 128;
#pragma unroll
        for (int t = 0; t < 4; ++t) SV[t * 128 + v] = bf2f(PROJ[(row0 + t) * NIN + C_I + hd * 128 + v]); }
    __syncthreads();
    const int v4 = tid & 31, kq = tid >> 5;
    const size_t sbase = (((size_t)sb * 8 + hd) * 128 + 8 * kq) * 128 + 4 * v4;
    f32x4 s[8];
#pragma unroll
    for (int i = 0; i < 8; ++i) s[i] = *(const f32x4*)(in[4] + sbase + (size_t)i * 128);
#pragma unroll
    for (int t = 0; t < 4; ++t) { const f32x4 vv = *(const LAS f32x4*)(SV + t * 128 + 4 * v4); f32x4 part = (f32x4){0.f, 0.f, 0.f, 0.f};
#pragma unroll
        for (int i = 0; i < 8; ++i) { const float f = SF[t * 128 + 8 * kq + i], kk = SK[t * 128 + 8 * kq + i], q = SQ[t * 128 + 8 * kq + i];
            s[i] = s[i] * f + vv * kk; part += s[i] * q; }
        *(LAS f32x4*)(PP + (t * 16 + kq) * 128 + 4 * v4) = part; }
    if (!dry)
#pragma unroll
    for (int i = 0; i < 8; ++i) *(f32x4*)(out + O_HGS + sbase + (size_t)i * 128) = s[i];
    __syncthreads();
    { const int t = tid >> 7, v = tid & 127; float o = 0.f;
#pragma unroll
        for (int q = 0; q < 16; ++q) o += PP[(t * 16 + q) * 128 + v];
        if (!dry) PROJ[(row0 + t) * NIN + C_I + hd * 128 + v] = (bf16)f2bf(o); }
    __syncthreads();
}
#ifndef MK_N_LAUNCHES
#define MK_N_LAUNCHES 1
#endif
constexpr int NPH = 15;
struct Args { const float* in[29]; float* out; unsigned char* ws; int ph_lo, ph_hi; };
static_assert(sizeof(Args) == 29 * 8 + 8 + 8 + 8, "Args has no padding");

__global__ void __launch_bounds__(NTHR, 2) mk_fwd(Args args) {
    extern __shared__ __attribute__((aligned(16))) unsigned char lds_raw[];
    LAS unsigned char* lds = (LAS unsigned char*)lds_raw;
    volatile LAS unsigned* MISC = (volatile LAS unsigned*)(lds + MISC_OFF);
    const int tid = threadIdx.x, lane = tid & 63, wave = __builtin_amdgcn_readfirstlane(tid >> 6);
    const int G = gridDim.x; const int bx = blockIdx.x; const int vcu = (G % 8 == 0) ? (bx % 8) * (G / 8) + bx / 8 : bx;
    const float* const* in = args.in; float* out = args.out; unsigned char* outb = (unsigned char*)args.out; unsigned char* ws = args.ws;
    for (int u = tid; u < (LDS_BYTES - LDSCTL_OFF) / 4; u += NTHR) ((LAS unsigned*)(lds + LDSCTL_OFF))[u] = 0u;
    __syncthreads();
    const int lo = args.ph_lo, hi = args.ph_hi;
    XcdBarrier bar; bar.bar = (unsigned*)(ws + WS_CTL) + CW_BAR; bar.x = 0; bar.st = nullptr;
    if (hi - lo > 1) bar = xcd_barrier_post((unsigned*)(ws + WS_CTL) + CW_BAR, MISC + 8);
#ifndef PH_MASK
#define PH_MASK 0x7fff
#endif
#define IN(k) ((((PH_MASK) >> (k)) & 1) && lo <= (k) && (k) < hi)
#ifndef DUP_MASK
#define DUP_MASK 0
#endif
#define DUPN(k) ((((DUP_MASK) >> (k)) & 1) ? 2 : 1)
#define SEAM(k) do { if (IN(k) && IN((k) + 1)) xcd_barrier(bar); } while (0)
    bf16* PROJ = (bf16*)(ws + WS_PROJ);
    float* Y = out + O_Y;

#define REPS(k) _Pragma("unroll 1") for (int rep_ = DUPN(k) - 1; rep_ >= 0; --rep_)
#define DRY ((rep_ > 0) && (args.ph_hi != 12345))
    if (IN(0)) REPS(0) { p0_prologue(in, outb, ws, lds, vcu, G, wave, lane); } SEAM(0);
    if (IN(1)) REPS(1) { pg8::Gemm g{(const bf16*)(outb + OS_XB), (const bf16*)(outb + OS_W1A), T, NGU, D, D}; pg8::StaticOrder S; S.init(T, NGU, G, bx);
        EpiSwiGLU E{(bf16*)(ws + WS_H)}; pg8::gemm_phase<EpiSwiGLU, pg8::StaticOrder, true, true>(lds, g, S, E); } SEAM(1);
    if (IN(2)) REPS(2) { pg8::Gemm g{(const bf16*)(ws + WS_H), (const bf16*)(outb + OS_W1D), TP, D, FF, FF}; pg8::StaticOrder S; S.init(TP, D, G, bx);
        EpiResid E{in[0], in[1], Y, 0.5f, false}; pg8::gemm_phase<EpiResid, pg8::StaticOrder, true, true>(lds, g, S, E);
        small_gemm<11>((const bf16*)(ws + WS_H), FF, (const bf16*)(outb + OS_W1D), FF, E, lds, bx, G, tid, wave, lane); } SEAM(2);
    if (IN(3)) REPS(3) { ln_phase(Y, (bf16*)(outb + OS_XB), in[8], in[9], vcu, G, wave, lane, DRY); } SEAM(3);
    if (IN(4)) REPS(4) { pg8::Gemm g{(const bf16*)(outb + OS_XB), (const bf16*)(outb + OS_WIN), T, NINP, D, D}; pg8::StaticOrder S; S.init(T, NINP, G, bx);
        EpiBf16N E{PROJ, NIN, NIN}; pg8::gemm_phase<EpiBf16N, pg8::StaticOrder, true, true>(lds, g, S, E); } SEAM(4);
    if (IN(5)) REPS(5) { for (int ci = bx; ci < 256; ci += G) prep_chunk(ci, PROJ, in, out, ws, tid, wave, lane); } SEAM(5);
    if (IN(6)) REPS(6) {
        const bool dry = DRY;
#ifndef DRY_SCAN_MASK
#define DRY_SCAN_MASK 7
#endif
        const int smask = (rep_ > 0) ? (DRY_SCAN_MASK) : 7;
        if (smask & 1) for (int pj = bx; pj < 256; pj += G) scan_pair_job(pj, PROJ, out, ws, in, lds, tid, wave, dry);
        if (smask & 2) for (int job = bx; job < DB * 16; job += G) ssd_sample_job(job, PROJ, in, out, lds, tid, dry);
        if (smask & 4) for (int job = bx; job < DB * 8; job += G) hgrn_sample_job(job, PROJ, in, out, lds, tid, dry);
    } SEAM(6);
    if (IN(7)) REPS(7) { norm_phase(PROJ, in[16], in[19], vcu, G, wave, lane, DRY); } SEAM(7);
    if (IN(8)) REPS(8) { pg8::Gemm g{PROJ + C_XM, (const bf16*)(ws + WS_WMO), TP, D, D, NIN}; pg8::StaticOrder S; S.init(TP, D, G, bx);
        EpiGate<false> E{PROJ + C_GM, PROJ + C_Z, false}; pg8::gemm_phase<EpiGate<false>, pg8::StaticOrder, true, true>(lds, g, S, E);
        small_gemm<4>(PROJ + C_XM, NIN, (const bf16*)(ws + WS_WMO), D, E, lds, bx, G, tid, wave, lane); } SEAM(8);
    if (IN(9)) REPS(9) { pg8::Gemm g{PROJ + C_I, (const bf16*)(ws + WS_WHO), TP, D, D, NIN}; pg8::StaticOrder S; S.init(TP, D, G, bx);
        EpiGate<true> E{PROJ + C_GH, PROJ + C_Z, DRY}; pg8::gemm_phase<EpiGate<true>, pg8::StaticOrder, true, true>(lds, g, S, E);
        small_gemm<4>(PROJ + C_I, NIN, (const bf16*)(ws + WS_WHO), D, E, lds, bx, G, tid, wave, lane); } SEAM(9);
    if (IN(10)) REPS(10) { pg8::Gemm g{PROJ + C_Z, (const bf16*)(ws + WS_WO), TP, D, D, NIN}; pg8::StaticOrder S; S.init(TP, D, G, bx);
        EpiResid E{Y, nullptr, Y, 1.0f, DRY}; pg8::gemm_phase<EpiResid, pg8::StaticOrder, true, true>(lds, g, S, E);
        small_gemm<4>(PROJ + C_Z, NIN, (const bf16*)(ws + WS_WO), D, E, lds, bx, G, tid, wave, lane); } SEAM(10);
    if (IN(11)) REPS(11) { ln_phase(Y, (bf16*)(ws + WS_X2B), in[22], in[23], vcu, G, wave, lane, DRY);
        ffn_weight_items(in[24], in[25], in[26], (bf16*)(ws + WS_W2A), (bf16*)(ws + WS_W2D), (LAS float*)(lds + wave * 16384), vcu * NWAVES + wave, G * NWAVES, lane); } SEAM(11);
    if (IN(12)) REPS(12) { pg8::Gemm g{(const bf16*)(ws + WS_X2B), (const bf16*)(ws + WS_W2A), T, NGU, D, D}; pg8::StaticOrder S; S.init(T, NGU, G, bx);
        EpiSwiGLU E{(bf16*)(ws + WS_H)}; pg8::gemm_phase<EpiSwiGLU, pg8::StaticOrder, true, true>(lds, g, S, E); } SEAM(12);
    if (IN(13)) REPS(13) { pg8::Gemm g{(const bf16*)(ws + WS_H), (const bf16*)(ws + WS_W2D), TP, D, FF, FF}; pg8::StaticOrder S; S.init(TP, D, G, bx);
        EpiResid E{Y, nullptr, Y, 0.5f, DRY}; pg8::gemm_phase<EpiResid, pg8::StaticOrder, true, true>(lds, g, S, E);
        small_gemm<11>((const bf16*)(ws + WS_H), FF, (const bf16*)(ws + WS_W2D), FF, E, lds, bx, G, tid, wave, lane); } SEAM(13);
    if (IN(14)) REPS(14) { ln_phase(Y, nullptr, in[27], in[28], vcu, G, wave, lane, DRY); }
#undef REPS
#undef DRY
#undef IN
#undef SEAM
}

extern "C" void kernel_launch(void* const* d_in, const int* in_sizes, int n_in, void* d_out, int out_size, void* d_ws, size_t ws_size, hipStream_t stream) {
    static int grid = 0;
    if (grid == 0) {
        if (n_in != 29 || out_size != (int)O_END || ws_size < WS_END2) { fprintf(stderr, "kernel_launch: unexpected shapes (n_in %d, out %d, ws %zu < %zu)\n", n_in, out_size, ws_size, (size_t)WS_END2); grid = -1; return; }
        int dev = 0, cus = 0, per_cu = 0;
        if (hipGetDevice(&dev) != hipSuccess || hipDeviceGetAttribute(&cus, hipDeviceAttributeMultiprocessorCount, dev) != hipSuccess) { grid = -1; return; }
        if (hipFuncSetAttribute((const void*)mk_fwd, hipFuncAttributeMaxDynamicSharedMemorySize, LDS_BYTES) != hipSuccess) { fprintf(stderr, "kernel_launch: hipFuncSetAttribute failed\n"); grid = -1; return; }
        if (hipOccupancyMaxActiveBlocksPerMultiprocessor(&per_cu, (const void*)mk_fwd, NTHR, LDS_BYTES) != hipSuccess || per_cu < 1) { fprintf(stderr, "kernel_launch: occupancy query says %d\n", per_cu); }
        (void)hipGetLastError();
        grid = cus;
    }
    if (grid < 0) return;
    (void)hipMemsetAsync((char*)d_ws + WS_CTL, 0, CTL_ZERO_BYTES, stream);
    Args a{};
    for (int i = 0; i < 29; ++i) a.in[i] = (const float*)d_in[i];
    a.out = (float*)d_out; a.ws = (unsigned char*)d_ws;
    if (MK_N_LAUNCHES == 1) { a.ph_lo = 0; a.ph_hi = NPH; hipLaunchKernelGGL(mk_fwd, dim3(grid), dim3(NTHR), LDS_BYTES, stream, a); }
    else { for (int p = 0; p < NPH; ++p) { a.ph_lo = p; a.ph_hi = p + 1; hipLaunchKernelGGL(mk_fwd, dim3(grid), dim3(NTHR), LDS_BYTES, stream, a); } }
}
```

```cpp
#include <hip/hip_runtime.h>
#include <cstdio>
#include <cstdint>
#define MK_N_LAUNCHES 1
#define DUP_MASK 0
#define DRY_SCAN_MASK 15
#define TIME_PHASE -1
namespace pg8 {
#define PG8_LAS __attribute__((address_space(3)))
typedef unsigned short bf16_t;
typedef short bf16x8 __attribute__((ext_vector_type(8)));
typedef float f32x4 __attribute__((ext_vector_type(4)));
typedef unsigned u32x4 __attribute__((ext_vector_type(4)));
typedef unsigned u32x2 __attribute__((ext_vector_type(2)));
constexpr int BM = 256, BK = 64, HALF = 128, HTB = HALF * BK * 2  , STAGE_BYTES = 8 * HTB, NXCD = 8, WGM = 8;

__host__ __device__ __forceinline__ int lds_byte(int r, int c) { const int st = (r >> 4) * 2 + (c >> 5), rr = r & 15, cc = c & 31, ob = rr * 64 + cc * 2; return st * 1024 + (ob ^ (((ob >> 9) & 1) << 5)); }
__host__ __device__ __forceinline__ void stage_rc(int b, int& R, int& C) { const int st = b / 1024, sb = b % 1024, swz = sb ^ (((sb >> 9) & 1) << 5); R = (st >> 1) * 16 + swz / 64; C = (st & 1) * 32 + (swz % 64) / 2; }
__host__ __device__ __forceinline__ int perm32(int rho) { const int n = rho >> 4, i = rho & 15; return 8 * (i >> 2) + 4 * n + (i & 3); }

struct Unit { int pm, pn; };
struct Gemm { const bf16_t* A; const bf16_t* Bt; int M, N, K, lda; };

struct StaticOrder {
    int nM, nN, nwg, G, c;
    __host__ __device__ void init(int M, int N, int G_, int c_) { nM = M / BM; nN = N / BM; nwg = nM * nN; G = G_; c = c_; }
    __host__ __device__ bool next(int i, Unit& u) const {
        const long L = (long)i * G + c; if (L >= nwg) return false;
        int wgid = (int)L; { const int q = nwg / NXCD, r = nwg % NXCD, xcd = wgid % NXCD, off = wgid / NXCD; wgid = (xcd < r ? xcd * (q + 1) : r * (q + 1) + (xcd - r) * q) + off; }
        const int nig = WGM * nN, gid = wgid / nig, fm = gid * WGM, gsz = (nM - fm) < WGM ? (nM - fm) : WGM;
        u.pm = fm + ((wgid % nig) % gsz); u.pn = (wgid % nig) / gsz; return true;
    }
};

__device__ __forceinline__ unsigned cvt_pk_bf16(float lo, float hi) { unsigned r; asm volatile("v_cvt_pk_bf16_f32 %0, %1, %2" : "=v"(r) : "v"(lo), "v"(hi)); return r; }

template <class Epi, class Sched, bool ALIGN_EPI = false, bool SP2 = false>
__device__ __forceinline__ void gemm_phase(PG8_LAS unsigned char* lds, const Gemm g, const Sched& S, const Epi& E) {
    const int tid = threadIdx.x, wid = __builtin_amdgcn_readfirstlane(tid >> 6), lane = tid & 63, wr = wid >> 2, wc = wid & 3, fr = lane & 15, fq = lane >> 4;
    const int K = g.K, nt = K / BK, lda = g.lda;
    unsigned voffA[2], voffB[2];
#pragma unroll
    for (int i = 0; i < 2; ++i) { int R, C; stage_rc(tid * 16 + i * 8192, R, C); const int Rb = Epi::PERM ? ((R & ~31) + perm32(R & 31)) : R;
        voffA[i] = (unsigned)(R * lda + C) * 2u; voffB[i] = (unsigned)(Rb * K + C) * 2u; }
    const size_t kstep = (size_t)(BK * 2);
    const size_t hstepA = (size_t)HALF * lda * 2, hstepB = (size_t)HALF * K * 2;
    const size_t tstepA = 2 * hstepA, tstepB = 2 * hstepB;
    const unsigned ldsw = (unsigned)wid * 1024u;
    const int aoff = lds_byte(wr * 64 + fr, fq * 8), boff = lds_byte(wc * 32 + fr, fq * 8);
#define PG8_SA(b, h) (((b) * 2 + (h)) * HTB)
#define PG8_SB(b, h) ((4 + (b) * 2 + (h)) * HTB)
#define PG8_STAGE(bufoff, gbase, voff) do { _Pragma("unroll") for (int _i = 0; _i < 2; ++_i) \
        __builtin_amdgcn_global_load_lds((const unsigned*)((const char*)(gbase) + (voff)[_i]), (PG8_LAS unsigned*)(lds + (bufoff) + ldsw + _i * 8192), 16, 0, 0); } while (0)
#define PG8_LDA(dst, b, h) do { _Pragma("unroll") for (int m = 0; m < 4; ++m) _Pragma("unroll") for (int k = 0; k < 2; ++k) dst[m][k] = *(const PG8_LAS bf16x8*)(lds + PG8_SA(b, h) + aoff + m * 2048 + k * 1024); } while (0)
#define PG8_LDB(dst, b, h) do { _Pragma("unroll") for (int n = 0; n < 2; ++n) _Pragma("unroll") for (int k = 0; k < 2; ++k) dst[n][k] = *(const PG8_LAS bf16x8*)(lds + PG8_SB(b, h) + boff + n * 2048 + k * 1024); } while (0)
#define PG8_MMA(ai, bj, At, Bt) do { __builtin_amdgcn_s_setprio(1); _Pragma("unroll") for (int m = 0; m < 4; ++m) _Pragma("unroll") for (int n = 0; n < 2; ++n) _Pragma("unroll") for (int k = 0; k < 2; ++k) \
        acc[ai][bj][m][n] = __builtin_amdgcn_mfma_f32_16x16x32_bf16(Bt[n][k], At[m][k], acc[ai][bj][m][n], 0, 0, 0); __builtin_amdgcn_s_setprio(0); } while (0)
#define PG8_WAIT_V(n) asm volatile("s_waitcnt vmcnt(" #n ")" ::: "memory")
#define PG8_WAIT_L(n) asm volatile("s_waitcnt lgkmcnt(" #n ")" ::: "memory")
#define PG8_BAR __builtin_amdgcn_s_barrier()
#define PG8_SCHED __builtin_amdgcn_sched_barrier(0)
    Unit cur, nxt; int ui = 0;
    if (!S.next(0, cur)) return;
    f32x4 acc[2][2][4][2];
#pragma unroll
    for (int a = 0; a < 2; ++a)
#pragma unroll
        for (int b = 0; b < 2; ++b)
#pragma unroll
            for (int m = 0; m < 4; ++m)
#pragma unroll
                for (int n = 0; n < 2; ++n) acc[a][b][m][n] = (f32x4){0.f, 0.f, 0.f, 0.f};
    bf16x8 At[4][2], B0[2][2], B1[2][2];
    const char* cA = (const char*)g.A + (size_t)cur.pm * tstepA; const char* cB = (const char*)g.Bt + (size_t)cur.pn * tstepB;
    if constexpr (SP2) {
        PG8_STAGE(PG8_SB(0, 0), cB, voffB); PG8_STAGE(PG8_SB(0, 1), cB + hstepB, voffB); PG8_STAGE(PG8_SA(0, 0), cA, voffA); PG8_STAGE(PG8_SA(0, 1), cA + hstepA, voffA);
        if (wr == 1) PG8_BAR;
        PG8_WAIT_V(2); PG8_BAR;
        PG8_STAGE(PG8_SB(1, 0), cB + kstep, voffB); PG8_STAGE(PG8_SA(1, 0), cA + kstep, voffA); PG8_STAGE(PG8_SB(1, 1), cB + hstepB + kstep, voffB);
        PG8_WAIT_V(6); PG8_BAR;
    } else {
        PG8_STAGE(PG8_SB(0, 0), cB, voffB); PG8_STAGE(PG8_SA(0, 0), cA, voffA); PG8_STAGE(PG8_SB(0, 1), cB + hstepB, voffB); PG8_STAGE(PG8_SA(0, 1), cA + hstepA, voffA);
        if (wr == 1) PG8_BAR;
        PG8_WAIT_V(4); PG8_BAR;
        PG8_STAGE(PG8_SB(1, 0), cB + kstep, voffB); PG8_STAGE(PG8_SA(1, 0), cA + kstep, voffA); PG8_STAGE(PG8_SB(1, 1), cB + hstepB + kstep, voffB);
        PG8_WAIT_V(6); PG8_BAR;
    }
    for (;;) {
        const bool has_next = S.next(ui + 1, nxt);
        const char* nA = has_next ? (const char*)g.A + (size_t)nxt.pm * tstepA : cA; const char* nB = has_next ? (const char*)g.Bt + (size_t)nxt.pn * tstepB : cB;
        for (int t = 0; t < nt; t += 2) {
            const bool last = (t == nt - 2);
            const char* a1 = cA + (size_t)(t + 1) * kstep;
            const char* a2 = last ? nA : cA + (size_t)(t + 2) * kstep; const char* b2 = last ? nB : cB + (size_t)(t + 2) * kstep;
            const char* a3 = a2 + kstep; const char* b3 = b2 + kstep;
            if constexpr (SP2) {
            PG8_LDB(B0, 0, 0); PG8_LDB(B1, 0, 1); PG8_SCHED; PG8_LDA(At, 0, 0); PG8_STAGE(PG8_SA(1, 1), a1 + hstepA, voffA);
            PG8_WAIT_V(8); PG8_WAIT_L(0); PG8_BAR; PG8_MMA(0, 0, At, B0); PG8_MMA(0, 1, At, B1); PG8_BAR; PG8_SCHED;
            PG8_LDA(At, 0, 1); PG8_STAGE(PG8_SB(0, 0), b2, voffB); PG8_STAGE(PG8_SB(0, 1), b2 + hstepB, voffB); PG8_STAGE(PG8_SA(0, 0), a2, voffA);
            PG8_WAIT_V(8); PG8_WAIT_L(0); PG8_BAR; PG8_MMA(1, 0, At, B0); PG8_MMA(1, 1, At, B1); PG8_BAR; PG8_SCHED;
            PG8_LDB(B0, 1, 0); PG8_LDB(B1, 1, 1); PG8_SCHED; PG8_LDA(At, 1, 0); PG8_STAGE(PG8_SA(0, 1), a2 + hstepA, voffA);
            PG8_WAIT_V(8); PG8_WAIT_L(0); PG8_BAR; PG8_MMA(0, 0, At, B0); PG8_MMA(0, 1, At, B1); PG8_BAR; PG8_SCHED;
            PG8_LDA(At, 1, 1); PG8_STAGE(PG8_SB(1, 0), b3, voffB); PG8_STAGE(PG8_SB(1, 1), b3 + hstepB, voffB); PG8_STAGE(PG8_SA(1, 0), a3, voffA);
            PG8_WAIT_V(8); PG8_WAIT_L(0); PG8_BAR; PG8_MMA(1, 0, At, B0); PG8_MMA(1, 1, At, B1); PG8_BAR; PG8_SCHED;
            } else {
            PG8_LDB(B0, 0, 0); PG8_SCHED; PG8_LDA(At, 0, 0); PG8_STAGE(PG8_SA(1, 1), a1 + hstepA, voffA);
            PG8_WAIT_L(8); PG8_BAR; PG8_WAIT_L(0); PG8_MMA(0, 0, At, B0); PG8_BAR; PG8_SCHED;
            PG8_LDB(B1, 0, 1); PG8_STAGE(PG8_SB(0, 0), b2, voffB);
            PG8_BAR; PG8_WAIT_L(0); PG8_MMA(0, 1, At, B1); PG8_BAR;
            PG8_LDA(At, 0, 1); PG8_STAGE(PG8_SA(0, 0), a2, voffA);
            PG8_BAR; PG8_WAIT_L(0); PG8_MMA(1, 0, At, B0); PG8_BAR; PG8_SCHED;
            PG8_STAGE(PG8_SB(0, 1), b2 + hstepB, voffB);
            PG8_WAIT_V(6); PG8_BAR; PG8_MMA(1, 1, At, B1); PG8_BAR;
            PG8_LDB(B0, 1, 0); PG8_SCHED; PG8_LDA(At, 1, 0); PG8_STAGE(PG8_SA(0, 1), a2 + hstepA, voffA);
            PG8_WAIT_L(8); PG8_BAR; PG8_WAIT_L(0); PG8_MMA(0, 0, At, B0); PG8_BAR; PG8_SCHED;
            PG8_LDB(B1, 1, 1); PG8_STAGE(PG8_SB(1, 0), b3, voffB);
            PG8_BAR; PG8_WAIT_L(0); PG8_MMA(0, 1, At, B1); PG8_BAR;
            PG8_LDA(At, 1, 1); PG8_STAGE(PG8_SA(1, 0), a3, voffA);
            PG8_BAR; PG8_WAIT_L(0); PG8_MMA(1, 0, At, B0); PG8_BAR; PG8_SCHED;
            PG8_STAGE(PG8_SB(1, 1), b3 + hstepB, voffB);
            PG8_WAIT_V(6); PG8_BAR; PG8_MMA(1, 1, At, B1); PG8_BAR;
            }
        }
        if constexpr (ALIGN_EPI) { if (wr == 0) PG8_BAR; }
        E(acc, cur, wr, wc, fr, fq);
        if (!has_next) break;
#pragma unroll
        for (int a = 0; a < 2; ++a)
#pragma unroll
            for (int b = 0; b < 2; ++b)
#pragma unroll
                for (int m = 0; m < 4; ++m)
#pragma unroll
                    for (int n = 0; n < 2; ++n) acc[a][b][m][n] = (f32x4){0.f, 0.f, 0.f, 0.f};
        cur = nxt; cA = nA; cB = nB; ++ui;
        if constexpr (ALIGN_EPI) { if (wr == 1) PG8_BAR; }
    }
    PG8_WAIT_V(0);
    if constexpr (!ALIGN_EPI) { if (wr == 0) PG8_BAR; }
    PG8_BAR;
#undef PG8_SA
#undef PG8_SB
#undef PG8_STAGE
#undef PG8_LDA
#undef PG8_LDB
#undef PG8_MMA
#undef PG8_WAIT_V
#undef PG8_WAIT_L
#undef PG8_BAR
#undef PG8_SCHED
}
}
#define GAS __attribute__((address_space(1)))
#define LAS __attribute__((address_space(3)))
typedef unsigned short bf16;
typedef unsigned v4u __attribute__((ext_vector_type(4)));
typedef unsigned v2u __attribute__((ext_vector_type(2)));
typedef float f32x4 __attribute__((ext_vector_type(4)));
typedef short bf16x8 __attribute__((ext_vector_type(8)));
typedef GAS unsigned gu32;
#define RLX_AGENT __ATOMIC_RELAXED, __HIP_MEMORY_SCOPE_AGENT
#define LDS_WAIT() asm volatile("s_waitcnt lgkmcnt(0)" ::: "memory")
#define VM_WAIT() asm volatile("s_waitcnt vmcnt(0)" ::: "memory")

constexpr int NWAVES = 8, NTHR = 512;
constexpr int T = 16896, TP = 16384, D = 1024, FF = 2816, NGU = 2 * FF, NIN = 9232, NINP = 9472;
constexpr int SEQ = 2048, NB = 8, DB = 128, DSEQ = 4;
constexpr float ALPHA = 1.189207115002721f, EPS = 1e-5f;
constexpr int C_Z = 0, C_XM = 1024, C_B = 2048, C_C = 2560, C_Q = 3072, C_F = 4096, C_I = 5120, C_OG = 6144, C_GM = 7168, C_GH = 8192, C_DT = 9216;
constexpr size_t O_Y = 0, O_CONVP = 17301504, O_SSMP = 17350656, O_HGP = 18399232, O_CONVS = 19447808, O_SSMS = 20234240, O_HGS = 37011456, O_END = 53788672;
constexpr size_t MiB = 1u << 20;
constexpr size_t OS_XB = O_SSMS * 4, OS_W1A = O_SSMS * 4 + 36 * MiB, OS_W1D = O_SSMS * 4 + 48 * MiB, OS_WIN = O_HGS * 4;
constexpr size_t WS_CTL = 0, CTL_ZERO_BYTES = 64 * 1024, WS_WMO = 1 * MiB, WS_WHO = 3 * MiB, WS_WO = 5 * MiB, WS_B = 8 * MiB;
constexpr size_t WS_PROJ = WS_B, WS_X2B = WS_B, WS_W2A = WS_B + 36 * MiB, WS_W2D = WS_B + 48 * MiB, WS_H = WS_B + 64 * MiB;
constexpr size_t WS_END = WS_B + (size_t)T * NIN * 2;
static_assert(WS_H + (size_t)T * FF * 2 <= WS_END, "H fits region B");
constexpr int CW_BAR = 1024;
constexpr int RING_BYTES = 131072, LDSCTL_OFF = RING_BYTES, MISC_OFF = LDSCTL_OFF + 320, LDS_BYTES = 147456;

__device__ __forceinline__ unsigned f2bf(float f) { unsigned u = __builtin_bit_cast(unsigned, f); return (u + 0x7fffu + ((u >> 16) & 1u)) >> 16; }
__device__ __forceinline__ unsigned pk2(float lo, float hi) { return f2bf(lo) | (f2bf(hi) << 16); }
__device__ __forceinline__ float bf2f(unsigned u16) { return __builtin_bit_cast(float, u16 << 16); }
__device__ __forceinline__ float bflo(unsigned w) { return __builtin_bit_cast(float, w << 16); }
__device__ __forceinline__ float bfhi(unsigned w) { return __builtin_bit_cast(float, w & 0xffff0000u); }
__device__ __forceinline__ float sigm(float x) { return __builtin_amdgcn_rcpf(1.f + __expf(-x)); }
__device__ __forceinline__ float siluf(float x) { return x * sigm(x); }
__device__ __forceinline__ float wave_sum(float v) {
#pragma unroll
    for (int o = 1; o < 64; o <<= 1) v += __shfl_xor(v, o);
    return v;
}

#define XB_TMO      128
#define XB_XCNT(j)  (256  + 64 * (j))
#define XB_XSUB(j)  (1280 + 64 * (j))
#define XB_XGEN(j)  (2304 + 64 * (j))
#define XB_TOP      3328
#define XB_TOPGEN   3392
#define XCD_BAR_WORDS 3456
#define XB_SPIN_CAP (1u << 20)
__device__ __forceinline__ unsigned xb_ld(unsigned* p)              { return __hip_atomic_load(p, __ATOMIC_RELAXED, __HIP_MEMORY_SCOPE_AGENT); }
__device__ __forceinline__ unsigned xb_add(unsigned* p, unsigned v) { return __hip_atomic_fetch_add(p, v, __ATOMIC_RELAXED, __HIP_MEMORY_SCOPE_AGENT); }
__device__ __forceinline__ unsigned xb_xcc_id() { return (unsigned)__builtin_amdgcn_s_getreg((3 << 11) | 20) & 0xFu; }
#define XB_SPIN(cond, bar) do { unsigned _sp = 0; while (cond) { __builtin_amdgcn_s_sleep(1); \
    if ((++_sp & 255u) == 0u) { if (xb_ld(&(bar)[XB_TMO])) break; if (_sp > XB_SPIN_CAP) { atomicAdd(&(bar)[XB_TMO], 1u); break; } } } } while (0)
struct XcdBarrier { unsigned* bar; unsigned x; volatile LAS unsigned* st; };
__device__ __forceinline__ XcdBarrier xcd_barrier_post(unsigned* bar, volatile LAS unsigned* st) {
    XcdBarrier b; b.bar = bar; b.x = xb_xcc_id(); b.st = st;
    if (threadIdx.x == 0) (void)xb_add(&bar[XB_XCNT(b.x)], 1u);
    return b;
}
__device__ __forceinline__ void xcd_barrier_complete(unsigned* bar, unsigned x, unsigned& nloc, unsigned& nx) {
    const unsigned G = gridDim.x * gridDim.y * gridDim.z;
    unsigned sum, cnt, mine, sp = 0u;
    for (;;) {
        sum = 0u; cnt = 0u; mine = 0u;
#pragma unroll
        for (unsigned j = 0; j < 16; ++j) { const unsigned c = xb_ld(&bar[XB_XCNT(j)]); sum += c; cnt += (c > 0u) ? 1u : 0u; mine = (j == x) ? c : mine; }
        if (sum == G) break;
        __builtin_amdgcn_s_sleep(1);
        if ((++sp & 255u) == 0u) { if (xb_ld(&bar[XB_TMO])) break; if (sp > XB_SPIN_CAP) { atomicAdd(&bar[XB_TMO], 1u); break; } }
    }
    nloc = mine > 0u ? mine : 1u; nx = cnt > 0u ? cnt : 1u;
}
__device__ __forceinline__ void xcd_barrier(const XcdBarrier& b) {
    asm volatile("s_waitcnt vmcnt(0)" ::: "memory");
    __syncthreads();
    if (threadIdx.x == 0) {
        unsigned* bar = b.bar;
        __builtin_amdgcn_s_waitcnt(0);
        unsigned nloc = b.st[0], nx = b.st[1];
        if (nloc == 0u) { xcd_barrier_complete(bar, b.x, nloc, nx); b.st[0] = nloc; b.st[1] = nx; }
        const unsigned old = xb_add(&bar[XB_XSUB(b.x)], 1u);
        const unsigned gen = old / nloc;
        if (old + 1u == (gen + 1u) * nloc) {
            __builtin_amdgcn_fence(__ATOMIC_RELEASE, "agent");
            asm volatile("s_waitcnt vmcnt(0)" ::: "memory");
            const unsigned og = xb_add(&bar[XB_TOP], 1u);
            const unsigned tg = og / nx;
            if (og + 1u == (tg + 1u) * nx) xb_add(&bar[XB_TOPGEN], 1u);
            else XB_SPIN(xb_ld(&bar[XB_TOPGEN]) == tg, bar);
            __builtin_amdgcn_fence(__ATOMIC_ACQUIRE, "agent");
            xb_add(&bar[XB_XGEN(b.x)], 1u);
            asm volatile("s_waitcnt vmcnt(0)" ::: "memory");
        } else {
            XB_SPIN(xb_ld(&bar[XB_XGEN(b.x)]) == gen, bar);
            __builtin_amdgcn_fence(__ATOMIC_ACQUIRE, "agent");
            asm volatile("s_waitcnt vmcnt(0)" ::: "memory");
        }
    }
    __syncthreads();
}

using pg8::Unit;
struct EpiSwiGLU {
    static constexpr bool PERM = true;
    bf16* H;
    __device__ __forceinline__ void operator()(const f32x4 (&acc)[2][2][4][2], const Unit& u, int wr, int wc, int fr, int fq) const {
        const int row0 = u.pm * 256 + wr * 64 + fr, col0 = u.pn * 128 + wc * 32 + 8 * fq;
#pragma unroll
        for (int ai = 0; ai < 2; ++ai)
#pragma unroll
            for (int m = 0; m < 4; ++m) {
                const f32x4 g0 = acc[ai][0][m][0], g1 = acc[ai][0][m][1], u0 = acc[ai][1][m][0], u1 = acc[ai][1][m][1];
                v4u w;
                w.x = pg8::cvt_pk_bf16(siluf(g0[0]) * u0[0], siluf(g0[1]) * u0[1]); w.y = pg8::cvt_pk_bf16(siluf(g0[2]) * u0[2], siluf(g0[3]) * u0[3]);
                w.z = pg8::cvt_pk_bf16(siluf(g1[0]) * u1[0], siluf(g1[1]) * u1[1]); w.w = pg8::cvt_pk_bf16(siluf(g1[2]) * u1[2], siluf(g1[3]) * u1[3]);
                *(v4u*)(H + (size_t)(row0 + ai * 128 + m * 16) * FF + col0) = w;
            }
    }
};
struct EpiBf16N {
    static constexpr bool PERM = true;
    bf16* O; int ldc, ncols;
    __device__ __forceinline__ void operator()(const f32x4 (&acc)[2][2][4][2], const Unit& u, int wr, int wc, int fr, int fq) const {
        const int row0 = u.pm * 256 + wr * 64 + fr, col0 = u.pn * 256 + wc * 32 + 8 * fq;
#pragma unroll
        for (int ai = 0; ai < 2; ++ai)
#pragma unroll
            for (int m = 0; m < 4; ++m) { bf16* rowp = O + (size_t)(row0 + ai * 128 + m * 16) * ldc + col0;
#pragma unroll
                for (int bj = 0; bj < 2; ++bj) { const f32x4 v0 = acc[ai][bj][m][0], v1 = acc[ai][bj][m][1];
                    v4u w; w.x = pg8::cvt_pk_bf16(v0[0], v0[1]); w.y = pg8::cvt_pk_bf16(v0[2], v0[3]); w.z = pg8::cvt_pk_bf16(v1[0], v1[1]); w.w = pg8::cvt_pk_bf16(v1[2], v1[3]);
                    if (col0 + bj * 128 < ncols) *(v4u*)(rowp + bj * 128) = w; } }
    }
};
struct EpiResid {
    static constexpr bool PERM = false;
    const float* res; const float* res2; float* out; float s; bool dry;
    __device__ __forceinline__ void operator()(const f32x4 (&acc)[2][2][4][2], const Unit& u, int wr, int wc, int fr, int fq) const {
        const int row0 = u.pm * 256 + wr * 64 + fr, col0 = u.pn * 256 + wc * 32 + 4 * fq;
        const float* rb = (res2 != nullptr && u.pm >= TP / 256) ? res2 - (size_t)TP * D : res;
#pragma unroll
        for (int ai = 0; ai < 2; ++ai)
#pragma unroll
            for (int m = 0; m < 4; ++m) { const size_t off = (size_t)(row0 + ai * 128 + m * 16) * D + col0;
#pragma unroll
                for (int bj = 0; bj < 2; ++bj)
#pragma unroll
                    for (int n = 0; n < 2; ++n) { const f32x4 r = *(const f32x4*)(rb + off + bj * 128 + n * 16);
                        if (!dry) *(f32x4*)(out + off + bj * 128 + n * 16) = r * ALPHA + acc[ai][bj][m][n] * s; } }
    }
    __device__ __forceinline__ void small(int row, int col, const f32x4 v) const {
        const float* rb = (res2 != nullptr && row >= TP) ? res2 - (size_t)TP * D : res; const size_t off = (size_t)row * D + col;
        const f32x4 r = *(const f32x4*)(rb + off); if (!dry) *(f32x4*)(out + off) = r * ALPHA + v * s;
    }
};
template <bool ADD> struct EpiGate {
    static constexpr bool PERM = true;
    const bf16* gate; bf16* dst; bool dry;
    __device__ __forceinline__ void operator()(const f32x4 (&acc)[2][2][4][2], const Unit& u, int wr, int wc, int fr, int fq) const {
        const int row0 = u.pm * 256 + wr * 64 + fr, col0 = u.pn * 256 + wc * 32 + 8 * fq;
#pragma unroll
        for (int ai = 0; ai < 2; ++ai)
#pragma unroll
            for (int m = 0; m < 4; ++m) { const size_t off = (size_t)(row0 + ai * 128 + m * 16) * NIN + col0;
#pragma unroll
                for (int bj = 0; bj < 2; ++bj) { const f32x4 v0 = acc[ai][bj][m][0], v1 = acc[ai][bj][m][1];
                    const v4u gw = *(const v4u*)(gate + off + bj * 128);
                    float r[8] = { sigm(bflo(gw.x)) * v0[0], sigm(bfhi(gw.x)) * v0[1], sigm(bflo(gw.y)) * v0[2], sigm(bfhi(gw.y)) * v0[3],
                                   sigm(bflo(gw.z)) * v1[0], sigm(bfhi(gw.z)) * v1[1], sigm(bflo(gw.w)) * v1[2], sigm(bfhi(gw.w)) * v1[3] };
                    if (ADD) { const v4u dw = *(const v4u*)(dst + off + bj * 128);
                        r[0] += bflo(dw.x); r[1] += bfhi(dw.x); r[2] += bflo(dw.y); r[3] += bfhi(dw.y); r[4] += bflo(dw.z); r[5] += bfhi(dw.z); r[6] += bflo(dw.w); r[7] += bfhi(dw.w); }
                    v4u w; w.x = pg8::cvt_pk_bf16(r[0], r[1]); w.y = pg8::cvt_pk_bf16(r[2], r[3]); w.z = pg8::cvt_pk_bf16(r[4], r[5]); w.w = pg8::cvt_pk_bf16(r[6], r[7]);
                    if (!dry) *(v4u*)(dst + off + bj * 128) = w; } }
    }
    __device__ __forceinline__ void small(int row, int col, const f32x4 v) const {
        const size_t off = (size_t)row * NIN + col; const v2u gw = *(const v2u*)(gate + off);
        float r[4] = { sigm(bflo(gw.x)) * v[0], sigm(bfhi(gw.x)) * v[1], sigm(bflo(gw.y)) * v[2], sigm(bfhi(gw.y)) * v[3] };
        if (ADD) { const v2u dw = *(const v2u*)(dst + off); r[0] += bflo(dw.x); r[1] += bfhi(dw.x); r[2] += bflo(dw.y); r[3] += bfhi(dw.y); }
        if (!dry) *(v2u*)(dst + off) = (v2u){pg8::cvt_pk_bf16(r[0], r[1]), pg8::cvt_pk_bf16(r[2], r[3])};
    }
};

template <int KS  , class Epi>
__device__ __forceinline__ void small_gemm(const bf16* A, int lda, const bf16* Bt, int K, const Epi& E, LAS unsigned char* lds, int bx, int G, int tid, int wave, int lane) {
    const int fr = lane & 15, fq = lane >> 4;
    LAS float* red = (LAS float*)lds;
    for (int u = bx; u < 256; u += G) {
        const int r0 = TP + 32 * (u >> 4), c0 = 64 * (u & 15);
        f32x4 acc[2][4];
#pragma unroll
        for (int m = 0; m < 2; ++m)
#pragma unroll
            for (int n = 0; n < 4; ++n) acc[m][n] = (f32x4){0.f, 0.f, 0.f, 0.f};
        const bf16* pa = A + (size_t)(r0 + fr) * lda + wave * (KS * 32) + 8 * fq; const bf16* pb = Bt + (size_t)(c0 + fr) * K + wave * (KS * 32) + 8 * fq;
#pragma unroll 4
        for (int ks = 0; ks < KS; ++ks) {
            bf16x8 a[2], b[4];
#pragma unroll
            for (int m = 0; m < 2; ++m) a[m] = *(const bf16x8*)(pa + (size_t)(16 * m) * lda + 32 * ks);
#pragma unroll
            for (int n = 0; n < 4; ++n) b[n] = *(const bf16x8*)(pb + (size_t)(16 * n) * K + 32 * ks);
#pragma unroll
            for (int m = 0; m < 2; ++m)
#pragma unroll
                for (int n = 0; n < 4; ++n) acc[m][n] = __builtin_amdgcn_mfma_f32_16x16x32_bf16(b[n], a[m], acc[m][n], 0, 0, 0);
        }
#pragma unroll
        for (int m = 0; m < 2; ++m)
#pragma unroll
            for (int n = 0; n < 4; ++n) *(LAS f32x4*)(red + (wave * 32 + 16 * m + fr) * 64 + 16 * n + 4 * fq) = acc[m][n];
        __syncthreads();
        { const int row = tid >> 4, col = (tid & 15) * 4; f32x4 v = (f32x4){0.f, 0.f, 0.f, 0.f};
#pragma unroll
            for (int w = 0; w < 8; ++w) v += *(const LAS f32x4*)(red + (w * 32 + row) * 64 + col);
            E.small(r0 + row, c0 + col, v); }
        __syncthreads();
    }
}
__device__ __forceinline__ void transpose_item(const float* W, int ldw, int srccol0, int ncopy, bf16* WT, int dstrow0, int K, int k0, LAS float* scr, int lane) {
    { const int n4 = (lane & 7) * 4, kr = lane >> 3; f32x4 v[8];
#pragma unroll
        for (int i = 0; i < 8; ++i) v[i] = (n4 < ncopy) ? *(const f32x4*)(W + (size_t)(k0 + 8 * i + kr) * ldw + srccol0 + n4) : (f32x4){0.f, 0.f, 0.f, 0.f};
#pragma unroll
        for (int i = 0; i < 8; ++i) { LAS float* d = scr + (8 * i + kr) * 33 + n4; d[0] = v[i][0]; d[1] = v[i][1]; d[2] = v[i][2]; d[3] = v[i][3]; } }
    LDS_WAIT(); asm volatile("" ::: "memory");
    const int c = lane & 7;
#pragma unroll
    for (int j = 0; j < 4; ++j) { const int n = (lane >> 3) + 8 * j; const LAS float* s = scr + (8 * c) * 33 + n;
        v4u o; o.x = pk2(s[0 * 33], s[1 * 33]); o.y = pk2(s[2 * 33], s[3 * 33]); o.z = pk2(s[4 * 33], s[5 * 33]); o.w = pk2(s[6 * 33], s[7 * 33]);
        *(v4u*)(WT + (size_t)(dstrow0 + n) * K + k0 + 8 * c) = o; }
    LDS_WAIT(); asm volatile("" ::: "memory");
}
__device__ __forceinline__ void ffn_weight_items(const float* Wg, const float* Wu, const float* Wd, bf16* WA, bf16* WD, LAS float* scr, int gw, int NGW, int lane) {
    constexpr int I_A = (NGU / 32) * (D / 64), I_D = (D / 32) * (FF / 64);
    for (int it = gw; it < I_A + I_D; it += NGW) {
        if (it < I_A) { const int gi = it / (D / 64), kb = it % (D / 64), n0 = 32 * gi, pn = n0 >> 8, bj = (n0 >> 7) & 1, i0 = n0 & 127;
            transpose_item(bj ? Wu : Wg, FF, 128 * pn + i0, 32, WA, n0, D, 64 * kb, scr, lane); }
        else { const int r = it - I_A, gi = r / (FF / 64), kb = r % (FF / 64);
            transpose_item(Wd, D, 32 * gi, 32, WD, 32 * gi, FF, 64 * kb, scr, lane); }
    }
}
__device__ __forceinline__ void p0_prologue(const float* const* in, unsigned char* outb, unsigned char* ws, LAS unsigned char* lds, int vcu, int G, int wave, int lane) {
    LAS float* scr = (LAS float*)(lds + wave * 16384);
    const int gw = vcu * NWAVES + wave, NGW = G * NWAVES;
    ffn_weight_items(in[5], in[6], in[7], (bf16*)(outb + OS_W1A), (bf16*)(outb + OS_W1D), scr, gw, NGW, lane);
    constexpr int I_IN = (NINP / 32) * (D / 64), I_SQ = (D / 32) * (D / 64);
    for (int it = gw; it < I_IN + 3 * I_SQ; it += NGW) {
        if (it < I_IN) { const int gi = it / (D / 64), kb = it % (D / 64), n0 = 32 * gi;
            int src, ncopy;
            if (n0 < 3072) { src = n0; ncopy = 32; } else if (n0 < C_DT) { src = n0 + 16; ncopy = 32; } else if (n0 == C_DT) { src = 3072; ncopy = 16; } else { src = 0; ncopy = 0; }
            transpose_item(in[10], NIN, src, ncopy, (bf16*)(outb + OS_WIN), n0, D, 64 * kb, scr, lane); }
        else { const int r = it - I_IN, w = r / I_SQ, r2 = r % I_SQ, gi = r2 / (D / 64), kb = r2 % (D / 64);
            const float* W = in[w == 0 ? 17 : (w == 1 ? 20 : 21)]; bf16* WT = (bf16*)(ws + (w == 0 ? WS_WMO : (w == 1 ? WS_WHO : WS_WO)));
            transpose_item(W, D, 32 * gi, 32, WT, 32 * gi, D, 64 * kb, scr, lane); }
    }
    bf16* XB = (bf16*)(outb + OS_XB);
    const size_t n8 = (size_t)T * D / 8, nthr = (size_t)G * NTHR;
    for (size_t i0 = (size_t)vcu * NTHR + threadIdx.x; i0 < n8; i0 += 4 * nthr) {
        f32x4 a[4], b[4];
#pragma unroll
        for (int u = 0; u < 4; ++u) { const size_t i = i0 + u * nthr; if (i < n8) { const size_t e = i * 8; const float* src = (e < (size_t)TP * D) ? in[0] + e : in[1] + (e - (size_t)TP * D);
            a[u] = *(const f32x4*)src; b[u] = *(const f32x4*)(src + 4); } }
#pragma unroll
        for (int u = 0; u < 4; ++u) { const size_t i = i0 + u * nthr; if (i < n8) { v4u w; w.x = pk2(a[u][0], a[u][1]); w.y = pk2(a[u][2], a[u][3]); w.z = pk2(b[u][0], b[u][1]); w.w = pk2(b[u][2], b[u][3]);
            *(v4u*)(XB + i * 8) = w; } }
    }
}
__device__ __forceinline__ void ln_phase(float* X, bf16* XBo, const float* gam, const float* bet, int vcu, int G, int wave, int lane, bool dry) {
    const int gw = vcu * NWAVES + wave, NGW = G * NWAVES;
    f32x4 gv[4], bv[4];
#pragma unroll
    for (int j = 0; j < 4; ++j) { gv[j] = *(const f32x4*)(gam + 4 * lane + 256 * j); bv[j] = *(const f32x4*)(bet + 4 * lane + 256 * j); }
    f32x4 nx[4];
    if (gw < T) {
#pragma unroll
        for (int j = 0; j < 4; ++j) nx[j] = ((const f32x4*)(X + (size_t)gw * D) + lane)[64 * j]; }
    for (int m = gw; m < T; m += NGW) {
        f32x4* xr = (f32x4*)(X + (size_t)m * D) + lane;
        f32x4 v[4]; float s = 0.f;
#pragma unroll
        for (int j = 0; j < 4; ++j) v[j] = nx[j];
        if (m + NGW < T) {
#pragma unroll
            for (int j = 0; j < 4; ++j) nx[j] = ((const f32x4*)(X + (size_t)(m + NGW) * D) + lane)[64 * j]; }
#pragma unroll
        for (int j = 0; j < 4; ++j) s += (v[j][0] + v[j][1]) + (v[j][2] + v[j][3]);
        const float mean = wave_sum(s) * (1.f / D); float s2 = 0.f;
#pragma unroll
        for (int j = 0; j < 4; ++j) { v[j] = v[j] - mean; s2 += (v[j][0] * v[j][0] + v[j][1] * v[j][1]) + (v[j][2] * v[j][2] + v[j][3] * v[j][3]); }
        const float rstd = 1.f / sqrtf(wave_sum(s2) * (1.f / D) + EPS);
#pragma unroll
        for (int j = 0; j < 4; ++j) { const f32x4 o = v[j] * rstd * gv[j] + bv[j]; if (dry) continue; xr[64 * j] = o;
            if (XBo) { v2u w; w.x = pk2(o[0], o[1]); w.y = pk2(o[2], o[3]); *((v2u*)(XBo + (size_t)m * D) + lane + 64 * j) = w; } }
    }
}
__device__ __forceinline__ void norm_phase(bf16* PROJ, const float* mw, const float* hw, int vcu, int G, int wave, int lane, bool dry) {
    const int gw = vcu * NWAVES + wave, NGW = G * NWAVES;
    float mwv[16], hwv[16];
#pragma unroll
    for (int j = 0; j < 16; ++j) { mwv[j] = mw[16 * lane + j]; hwv[j] = hw[16 * lane + j]; }
    v4u nx[8];
#define NORM_LOAD(m_) do { const bf16* r_ = PROJ + (size_t)(m_) * NIN + 16 * lane; nx[0] = *(const v4u*)(r_ + C_XM); nx[1] = *(const v4u*)(r_ + C_XM + 8); nx[2] = *(const v4u*)(r_ + C_Z); nx[3] = *(const v4u*)(r_ + C_Z + 8); \
        nx[4] = *(const v4u*)(r_ + C_I); nx[5] = *(const v4u*)(r_ + C_I + 8); nx[6] = *(const v4u*)(r_ + C_OG); nx[7] = *(const v4u*)(r_ + C_OG + 8); } while (0)
    if (gw < T) NORM_LOAD(gw);
    for (int m = gw; m < T; m += NGW) {
        bf16* row = PROJ + (size_t)m * NIN;
        const v4u y0 = nx[0], y1 = nx[1], z0 = nx[2], z1 = nx[3], o0 = nx[4], o1 = nx[5], g0 = nx[6], g1 = nx[7];
        if (m + NGW < T) NORM_LOAD(m + NGW);
        float a[16], b[16];
        const unsigned yw[8] = {y0.x, y0.y, y0.z, y0.w, y1.x, y1.y, y1.z, y1.w}, zw[8] = {z0.x, z0.y, z0.z, z0.w, z1.x, z1.y, z1.z, z1.w};
        const unsigned ow[8] = {o0.x, o0.y, o0.z, o0.w, o1.x, o1.y, o1.z, o1.w}, gww[8] = {g0.x, g0.y, g0.z, g0.w, g1.x, g1.y, g1.z, g1.w};
        float sa = 0.f, sb = 0.f;
#pragma unroll
        for (int j = 0; j < 8; ++j) {
            a[2 * j] = bflo(yw[j]) * siluf(bflo(zw[j])); a[2 * j + 1] = bfhi(yw[j]) * siluf(bfhi(zw[j]));
            b[2 * j] = bflo(ow[j]); b[2 * j + 1] = bfhi(ow[j]);
            sa += a[2 * j] * a[2 * j] + a[2 * j + 1] * a[2 * j + 1]; sb += b[2 * j] * b[2 * j] + b[2 * j + 1] * b[2 * j + 1];
        }
        sb += __shfl_xor(sb, 1); sb += __shfl_xor(sb, 2); sb += __shfl_xor(sb, 4);
        sa += __shfl_xor(sa, 1); sa += __shfl_xor(sa, 2); sa += __shfl_xor(sa, 4); sa += __shfl_xor(sa, 8);
        const float ra = 1.f / sqrtf(sa * (1.f / 256.f) + EPS), rb = 1.f / sqrtf(sb * (1.f / 128.f) + EPS);
        unsigned wa[8], wb[8];
#pragma unroll
        for (int j = 0; j < 8; ++j) {
            wa[j] = pk2(a[2 * j] * ra * mwv[2 * j], a[2 * j + 1] * ra * mwv[2 * j + 1]);
            wb[j] = pk2(b[2 * j] * rb * hwv[2 * j] * siluf(bflo(gww[j])), b[2 * j + 1] * rb * hwv[2 * j + 1] * siluf(bfhi(gww[j])));
        }
        if (dry) continue;
        *(v4u*)(row + C_XM + 16 * lane) = (v4u){wa[0], wa[1], wa[2], wa[3]}; *(v4u*)(row + C_XM + 16 * lane + 8) = (v4u){wa[4], wa[5], wa[6], wa[7]};
        *(v4u*)(row + C_I + 16 * lane) = (v4u){wb[0], wb[1], wb[2], wb[3]}; *(v4u*)(row + C_I + 16 * lane + 8) = (v4u){wb[4], wb[5], wb[6], wb[7]};
    }
#undef NORM_LOAD
}
typedef short v4s __attribute__((ext_vector_type(4)));
constexpr size_t WS_DECH = 7 * MiB, WS_DTF = WS_END, WS_ACF = WS_DTF + (size_t)T * 16 * 4, WS_TAIL = WS_ACF + (size_t)T * 16 * 4, WS_END2 = WS_TAIL + (size_t)256 * 3 * 2048 * 2;

__device__ __forceinline__ void unpack4(const v2u w, float (&f)[4]) { f[0] = bflo(w.x); f[1] = bfhi(w.x); f[2] = bflo(w.y); f[3] = bfhi(w.y); }

__device__ __forceinline__ void prep_chunk(int ci, bf16* PROJ, const float* const* in, float* out, unsigned char* ws, int tid, int wave, int lane, bool dry) {
    const int b = ci >> 5, c = ci & 31; const size_t r0 = (size_t)b * SEQ + (size_t)c * 64;
    float* DTF = (float*)(ws + WS_DTF); float* ACF = (float*)(ws + WS_ACF); float* DECH = (float*)(ws + WS_DECH); bf16* TAIL = (bf16*)(ws + WS_TAIL);
#pragma unroll
    for (int q = 0; q < 2; ++q) { const int h = 2 * wave + q;
        const float xr = bf2f(PROJ[(r0 + lane) * NIN + C_DT + h]) + in[13][h]; const float dt = xr > 20.f ? xr : log1pf(__expf(xr));
        float v = -__expf(in[14][h]) * dt;
#pragma unroll
        for (int o = 1; o < 64; o <<= 1) { const float tt = __shfl_up(v, o); if (lane >= o) v += tt; }
        if (!dry) { DTF[(r0 + lane) * 16 + h] = dt; ACF[(r0 + lane) * 16 + h] = v; } }
    { const int ch4 = 4 * tid; bf16* colp = PROJ + r0 * NIN + C_XM + ch4;
        const f32x4 cw0 = *(const f32x4*)(in[11] + ch4), cw1 = *(const f32x4*)(in[11] + 2048 + ch4), cw2 = *(const f32x4*)(in[11] + 4096 + ch4), cw3 = *(const f32x4*)(in[11] + 6144 + ch4), cbv = *(const f32x4*)(in[12] + ch4);
        float w0[4] = {0.f, 0.f, 0.f, 0.f}, w1[4] = {0.f, 0.f, 0.f, 0.f}, w2[4] = {0.f, 0.f, 0.f, 0.f};
        if (c > 0) { unpack4(*(const v2u*)(colp - 3 * (size_t)NIN), w0); unpack4(*(const v2u*)(colp - 2 * (size_t)NIN), w1); unpack4(*(const v2u*)(colp - (size_t)NIN), w2); }
#pragma unroll 1
        for (int tb = 0; tb < 64; tb += 16) {
            v2u raw[16];
#pragma unroll
            for (int i = 0; i < 16; ++i) raw[i] = *(const v2u*)(colp + (size_t)(tb + i) * NIN);
#pragma unroll
            for (int i = 0; i < 16; ++i) { float x[4]; unpack4(raw[i], x); float o[4];
#pragma unroll
                for (int j = 0; j < 4; ++j) { o[j] = siluf(cbv[j] + cw0[j] * w0[j] + cw1[j] * w1[j] + cw2[j] * w2[j] + cw3[j] * x[j]); w0[j] = w1[j]; w1[j] = w2[j]; w2[j] = x[j]; }
                const v2u ow = (v2u){pk2(o[0], o[1]), pk2(o[2], o[3])}; const int t = tb + i;
                if (dry) continue;
                if (t < 61) *(v2u*)(colp + (size_t)t * NIN) = ow; else *(v2u*)(TAIL + ((size_t)ci * 3 + (t - 61)) * 2048 + ch4) = ow;
                if (c == 31 && t >= 61) *(f32x4*)(out + O_CONVP + ((size_t)b * 3 + (t - 61)) * 2048 + ch4) = (f32x4){x[0], x[1], x[2], x[3]}; }
        } }
    { const int k2 = 2 * tid; bf16* qp = PROJ + r0 * NIN + C_Q + k2; bf16* fp = PROJ + r0 * NIN + C_F + k2;
        const float lb0 = sigm(in[18][k2] - in[18][1024 + k2]), lb1 = sigm(in[18][k2 + 1] - in[18][1024 + k2 + 1]);
        float run0 = 0.f, run1 = 0.f;
#pragma unroll 1
        for (int tb = 0; tb < 64; tb += 16) {
            unsigned qr[16], fr_[16];
#pragma unroll
            for (int i = 0; i < 16; ++i) { qr[i] = *(const unsigned*)(qp + (size_t)(tb + i) * NIN); fr_[i] = *(const unsigned*)(fp + (size_t)(tb + i) * NIN); }
#pragma unroll
            for (int i = 0; i < 16; ++i) {
                const float s0 = sigm(bflo(fr_[i])), s1 = sigm(bfhi(fr_[i]));
                run0 += __logf(lb0 + (1.f - lb0) * s0); run1 += __logf(lb1 + (1.f - lb1) * s1);
                const float e0 = __expf(run0), e1 = __expf(run1);
                if (dry) continue;
                *(unsigned*)(qp + (size_t)(tb + i) * NIN) = pk2(bflo(qr[i]) * e0, bfhi(qr[i]) * e1);
                *(unsigned*)(fp + (size_t)(tb + i) * NIN) = pk2((1.f - lb0) * (1.f - s0) * __builtin_amdgcn_rcpf(e0), (1.f - lb1) * (1.f - s1) * __builtin_amdgcn_rcpf(e1)); }
        }
        if (!dry) { DECH[(size_t)ci * 1024 + k2] = __expf(run0); DECH[(size_t)ci * 1024 + k2 + 1] = __expf(run1); } }
}

constexpr int S_QC = 136, S_X = 40, S_WT = 72;
constexpr int G_QC = 0, G_KB = 17408, G_X = 34816, G_XS = 39936, G_WT = 45056, G_ST = 54272, G_FA = 62976, GRP_BYTES = 64000;
static_assert(2 * GRP_BYTES <= RING_BYTES, "scan LDS map");
__device__ __forceinline__ bf16x8 row_frag(const LAS bf16* img, int stride, int row, int k) { return *(const LAS bf16x8*)(img + row * stride + k); }
__device__ __forceinline__ bf16x8 tr_frag(const LAS bf16* img, int stride, int k0, int c0, int fr) {
    const LAS bf16* p = img + (k0 + (fr >> 2)) * stride + c0 + 4 * (fr & 3);
    const v4s lo = __builtin_amdgcn_ds_read_tr16_b64_v4i16((LAS v4s*)p), hi = __builtin_amdgcn_ds_read_tr16_b64_v4i16((LAS v4s*)(p + 4 * stride));
    return (bf16x8){lo[0], lo[1], lo[2], lo[3], hi[0], hi[1], hi[2], hi[3]};
}
constexpr unsigned pack2(const int (&a)[10]) { unsigned r = 0; for (int i = 0; i < 10; ++i) r |= (unsigned)a[i] << (2 * i); return r; }
constexpr int TB_LIST[10] = {3, 3, 2, 2, 3, 3, 2, 1, 0, 1}, SB_LIST[10] = {0, 2, 0, 2, 1, 3, 1, 1, 0, 0};
constexpr unsigned TB_PK = pack2(TB_LIST), SB_PK = pack2(SB_LIST);

__device__ __forceinline__ void scan_pair_job(int pj, bf16* PROJ, float* out, unsigned char* ws, const float* const* in, LAS unsigned char* lds, int tid0, int wave, bool dry) {
    const bool ssd = wave < 4; const int w4 = wave & 3;
    LAS unsigned char* gl = lds + (ssd ? 0 : GRP_BYTES);
    LAS bf16* QC = (LAS bf16*)(gl + G_QC); LAS bf16* KB = (LAS bf16*)(gl + G_KB); LAS bf16* XN = (LAS bf16*)(gl + G_X); LAS bf16* XS = (LAS bf16*)(gl + (ssd ? G_XS : G_X));
    LAS bf16* WT = (LAS bf16*)(gl + G_WT); LAS bf16* ST = (LAS bf16*)(gl + G_ST); LAS float* ACUM = (LAS float*)(gl + G_FA); LAS float* DT = ACUM + 64; LAS float* DEC = ACUM + 128;
    const float* DTF = (const float*)(ws + WS_DTF); const float* ACF = (const float*)(ws + WS_ACF); const float* DECH = (const float*)(ws + WS_DECH); const bf16* TAIL = (const bf16*)(ws + WS_TAIL);
    int b, colC, colB, colX, chC = 0, chB = 0, chX = 0, h = 0, half = 0, hd = 0, vq = 0;
    if (ssd) { b = pj >> 5; h = (pj >> 1) & 15; half = pj & 1; const int g = h >> 2; colX = C_XM + h * 64 + half * 32; colB = C_B + g * 128; colC = C_C + g * 128; chX = h * 64 + half * 32; chB = 1024 + g * 128; chC = 1536 + g * 128; }
    else { b = pj >> 5; hd = (pj >> 2) & 7; vq = pj & 3; colB = C_F + hd * 128; colC = C_Q + hd * 128; colX = C_I + hd * 128 + vq * 32; }
    const size_t rowbase = (size_t)b * SEQ;
    const float Dh = ssd ? in[15][h] : 0.f;
    f32x4 st[4];
#pragma unroll
    for (int i = 0; i < 4; ++i) st[i] = (f32x4){0.f, 0.f, 0.f, 0.f};
    { const int gt = tid0 & 255; for (int i = gt; i < (G_FA - G_WT) / 4; i += 256) ((LAS unsigned*)(gl + G_WT))[i] = 0u; }
    v4u pfC[4], pfB[4], pfX; float fa = 0.f, fb = 0.f;
#define LOAD_REGS(c_) do { const int ci_ = b * 32 + (c_); const bf16* base_ = PROJ + (rowbase + (size_t)(c_) * 64) * NIN; \
        _Pragma("unroll") for (int j = 0; j < 4; ++j) { const int i = gt + 256 * j, row = i >> 4, c16 = i & 15; const bool tl = ssd && row >= 61; \
            const bf16* tb_ = TAIL + ((size_t)ci_ * 3 + (row - 61)) * 2048 + c16 * 8; \
            pfC[j] = *(const v4u*)(tl ? tb_ + chC : base_ + (size_t)row * NIN + colC + c16 * 8); pfB[j] = *(const v4u*)(tl ? tb_ + chB : base_ + (size_t)row * NIN + colB + c16 * 8); } \
        { const int row = gt >> 2, c16 = gt & 3; const bool tl = ssd && row >= 61; \
            pfX = *(const v4u*)(tl ? TAIL + ((size_t)ci_ * 3 + (row - 61)) * 2048 + chX + c16 * 8 : base_ + (size_t)row * NIN + colX + c16 * 8); } \
        if (ssd) { if (gt < 64) { fa = ACF[(rowbase + (size_t)(c_) * 64 + gt) * 16 + h]; fb = DTF[(rowbase + (size_t)(c_) * 64 + gt) * 16 + h]; } } \
        else if (gt < 128) fa = DECH[(size_t)ci_ * 1024 + hd * 128 + gt]; } while (0)
#define STORE_REGS() do { \
        _Pragma("unroll") for (int j = 0; j < 4; ++j) { const int i = gt + 256 * j, row = i >> 4, c16 = i & 15; \
            *(LAS v4u*)(QC + row * S_QC + c16 * 8) = pfC[j]; *(LAS v4u*)(KB + row * S_QC + c16 * 8) = pfB[j]; } \
        *(LAS v4u*)(XN + (gt >> 2) * S_X + (gt & 3) * 8) = pfX; \
        if (ssd) { if (gt < 64) { ACUM[gt] = fa; DT[gt] = fb; } } else if (gt < 128) DEC[gt] = fa; } while (0)
    { const int gt = tid0 & 255; LOAD_REGS(0); }
    for (int c = 0; c < SEQ / 64; ++c) {
        int tid_v = tid0; asm volatile("" : "+v"(tid_v));
        const int gt = tid_v & 255, lane = tid_v & 63, fr = lane & 15, fq = lane >> 4;
        STORE_REGS();
        __syncthreads();
        if (c + 1 < SEQ / 64) LOAD_REGS(c + 1);
        const size_t t0 = rowbase + (size_t)c * 64;
        const float alast = ssd ? ACUM[63] : 0.f;
        if (ssd) {
            const int s = gt >> 2, p8 = (gt & 3) * 8; const float sc = __expf(alast - ACUM[s]) * DT[s];
            float x[8]; const v4u xw = *(const LAS v4u*)(XN + s * S_X + p8);
            x[0] = bflo(xw.x); x[1] = bfhi(xw.x); x[2] = bflo(xw.y); x[3] = bfhi(xw.y); x[4] = bflo(xw.z); x[5] = bfhi(xw.z); x[6] = bflo(xw.w); x[7] = bfhi(xw.w);
            *(LAS v4u*)(XS + s * S_X + p8) = (v4u){pk2(x[0] * sc, x[1] * sc), pk2(x[2] * sc, x[3] * sc), pk2(x[4] * sc, x[5] * sc), pk2(x[6] * sc, x[7] * sc)};
        }
        for (int idx = w4; idx < 10; idx += 4) { const int tb = (TB_PK >> (2 * idx)) & 3, sb = (SB_PK >> (2 * idx)) & 3; const int t = 16 * tb + fr, s0 = 16 * sb + 4 * fq;
            f32x4 g = (f32x4){0.f, 0.f, 0.f, 0.f};
#pragma unroll
            for (int k0 = 0; k0 < 128; k0 += 32) g = __builtin_amdgcn_mfma_f32_16x16x32_bf16(row_frag(KB, S_QC, 16 * sb + fr, k0 + 8 * fq), row_frag(QC, S_QC, t, k0 + 8 * fq), g, 0, 0, 0);
            float w[4];
            if (ssd) { const float at = ACUM[t]; const f32x4 as = *(const LAS f32x4*)(ACUM + s0), ds = *(const LAS f32x4*)(DT + s0);
#pragma unroll
                for (int j = 0; j < 4; ++j) w[j] = (s0 + j <= t) ? g[j] * __expf(fminf(at - as[j], 0.f)) * ds[j] : 0.f;
            } else {
#pragma unroll
                for (int j = 0; j < 4; ++j) w[j] = (s0 + j <= t) ? g[j] : 0.f;
            }
            *(LAS v2u*)(WT + t * S_WT + s0) = (v2u){pk2(w[0], w[1]), pk2(w[2], w[3])}; }
        __syncthreads();
        { const int t = 16 * w4 + fr; const float rs = ssd ? __expf(ACUM[t]) : 1.f;
            bf16x8 qa[4];
#pragma unroll
            for (int ks = 0; ks < 4; ++ks) qa[ks] = row_frag(QC, S_QC, t, 32 * ks + 8 * fq);
            const bf16x8 wa0 = row_frag(WT, S_WT, t, 8 * fq), wa1 = row_frag(WT, S_WT, t, 32 + 8 * fq);
#pragma unroll
            for (int pb = 0; pb < 2; ++pb) {
                f32x4 y = (f32x4){0.f, 0.f, 0.f, 0.f};
#pragma unroll
                for (int ks = 0; ks < 4; ++ks) y = __builtin_amdgcn_mfma_f32_16x16x32_bf16(row_frag(ST, S_QC, 16 * pb + fr, 32 * ks + 8 * fq), qa[ks], y, 0, 0, 0);
                y = y * rs;
                y = __builtin_amdgcn_mfma_f32_16x16x32_bf16(tr_frag(XN, S_X, 8 * fq, 16 * pb, fr), wa0, y, 0, 0, 0);
                if (w4 >= 2) y = __builtin_amdgcn_mfma_f32_16x16x32_bf16(tr_frag(XN, S_X, 32 + 8 * fq, 16 * pb, fr), wa1, y, 0, 0, 0);
                const int p0 = 16 * pb + 4 * fq;
                if (ssd) { const v2u xw = *(const LAS v2u*)(XN + t * S_X + p0); y[0] += Dh * bflo(xw.x); y[1] += Dh * bfhi(xw.x); y[2] += Dh * bflo(xw.y); y[3] += Dh * bfhi(xw.y); }
                if (!dry) *(v2u*)(PROJ + (t0 + t) * NIN + colX + p0) = (v2u){pk2(y[0], y[1]), pk2(y[2], y[3])};
            } }
        { const float dsc = ssd ? __expf(alast) : 1.f;
#pragma unroll
            for (int q = 0; q < 2; ++q) { const int n0 = 16 * (2 * w4 + q);
                const bf16x8 kb0 = tr_frag(KB, S_QC, 8 * fq, n0, fr), kb1 = tr_frag(KB, S_QC, 32 + 8 * fq, n0, fr);
                f32x4 dv = (f32x4){1.f, 1.f, 1.f, 1.f}; if (!ssd) dv = *(const LAS f32x4*)(DEC + n0 + 4 * fq);
#pragma unroll
                for (int pb = 0; pb < 2; ++pb) { f32x4 a = st[2 * q + pb] * dsc;
                    a = __builtin_amdgcn_mfma_f32_16x16x32_bf16(kb0, tr_frag(XS, S_X, 8 * fq, 16 * pb, fr), a, 0, 0, 0);
                    a = __builtin_amdgcn_mfma_f32_16x16x32_bf16(kb1, tr_frag(XS, S_X, 32 + 8 * fq, 16 * pb, fr), a, 0, 0, 0);
                    st[2 * q + pb] = a * dv; } } }
        __syncthreads();
#pragma unroll
        for (int q = 0; q < 2; ++q)
#pragma unroll
            for (int pb = 0; pb < 2; ++pb) *(LAS v2u*)(ST + (16 * pb + fr) * S_QC + 16 * (2 * w4 + q) + 4 * fq) = (v2u){pk2(st[2 * q + pb][0], st[2 * q + pb][1]), pk2(st[2 * q + pb][2], st[2 * q + pb][3])};
    }
#undef LOAD_REGS
#undef STORE_REGS
    if (!dry) { const int lane = tid0 & 63, fr = lane & 15, fq = lane >> 4;
#pragma unroll
        for (int q = 0; q < 2; ++q)
#pragma unroll
            for (int pb = 0; pb < 2; ++pb) { const int n0 = 16 * (2 * w4 + q) + 4 * fq, p = 16 * pb + fr; const f32x4 v = st[2 * q + pb];
                if (ssd) *(f32x4*)(out + O_SSMP + (((size_t)(b * 16 + h) * 64 + half * 32 + p) * 128 + n0)) = v;
                else {
#pragma unroll
                    for (int j = 0; j < 4; ++j) out[O_HGP + (((size_t)(b * 8 + hd) * 128 + n0 + j) * 128 + vq * 32 + p)] = v[j]; } } }
    __syncthreads();
}
__device__ __forceinline__ void ssd_sample_jobs(int bx, int G, bf16* PROJ, const float* const* in, float* out, LAS unsigned char* lds, int tid, bool dry) {
    const int p4 = tid >> 5, f4 = tid & 31;
    f32x4 nx[4];
    { const int job = bx; if (job < DB * 16) { const size_t sbase = ((size_t)job * 64 + p4) * 128 + 4 * f4;
#pragma unroll
        for (int i = 0; i < 4; ++i) nx[i] = *(const f32x4*)(in[3] + sbase + (size_t)i * 16 * 128); } }
    int it = 0;
    for (int job = bx; job < DB * 16; job += G, ++it) {
        const int sb = job >> 4, h = job & 15, g = h >> 2; const size_t row0 = (size_t)TP + 4 * sb;
        LAS float* SX = (LAS float*)(lds + (it & 1) * 8192); LAS float* SBm = SX + 4 * 64; LAS float* SCm = SBm + 4 * 128; LAS float* SDT = SCm + 4 * 128;
        f32x4 hv[4];
#pragma unroll
        for (int i = 0; i < 4; ++i) hv[i] = nx[i];
        const size_t sbase = ((size_t)job * 64 + p4) * 128 + 4 * f4;
        if (job + G < DB * 16) { const size_t nb = ((size_t)(job + G) * 64 + p4) * 128 + 4 * f4;
#pragma unroll
            for (int i = 0; i < 4; ++i) nx[i] = *(const f32x4*)(in[3] + nb + (size_t)i * 16 * 128); }
        if (tid < 320) {
            int col, cc; LAS float* dst; int dstride, di;
            if (tid < 64) { col = C_XM + h * 64 + tid; cc = h * 64 + tid; dst = SX; dstride = 64; di = tid; }
            else if (tid < 192) { col = C_B + g * 128 + (tid - 64); cc = 1024 + g * 128 + (tid - 64); dst = SBm; dstride = 128; di = tid - 64; }
            else { col = C_C + g * 128 + (tid - 192); cc = 1536 + g * 128 + (tid - 192); dst = SCm; dstride = 128; di = tid - 192; }
            float u[7];
#pragma unroll
            for (int j = 0; j < 3; ++j) u[j] = in[2][((size_t)sb * 3 + j) * 2048 + cc];
#pragma unroll
            for (int j = 0; j < 4; ++j) u[3 + j] = bf2f(PROJ[(row0 + j) * NIN + col]);
            const float w0 = in[11][cc], w1 = in[11][2048 + cc], w2 = in[11][4096 + cc], w3 = in[11][6144 + cc], bb = in[12][cc];
#pragma unroll
            for (int t = 0; t < 4; ++t) dst[t * dstride + di] = siluf(bb + w0 * u[t] + w1 * u[t + 1] + w2 * u[t + 2] + w3 * u[t + 3]);
            if (!dry && (tid < 64 || (h & 3) == 0)) {
#pragma unroll
                for (int j = 0; j < 3; ++j) out[O_CONVS + ((size_t)sb * 3 + j) * 2048 + cc] = u[4 + j];
            }
        } else if (tid < 324) { const int t = tid - 320; const float xr = bf2f(PROJ[(row0 + t) * NIN + C_DT + h]) + in[13][h]; SDT[t] = xr > 20.f ? xr : log1pf(__expf(xr)); }
        __syncthreads();
        const float a_neg = -__expf(in[14][h]), Dh = in[15][h];
#pragma unroll
        for (int t = 0; t < 4; ++t) {
            const float dt = SDT[t], dec = __expf(dt * a_neg);
            const f32x4 bv = *(const LAS f32x4*)(SBm + t * 128 + 4 * f4), cv = *(const LAS f32x4*)(SCm + t * 128 + 4 * f4);
#pragma unroll
            for (int i = 0; i < 4; ++i) { const int p = p4 + 16 * i; const float xv = SX[t * 64 + p], xb = dt * xv;
                hv[i] = hv[i] * dec + bv * xb;
                float part = (hv[i][0] * cv[0] + hv[i][1] * cv[1]) + (hv[i][2] * cv[2] + hv[i][3] * cv[3]);
                part += __shfl_xor(part, 1); part += __shfl_xor(part, 2); part += __shfl_xor(part, 4); part += __shfl_xor(part, 8); part += __shfl_xor(part, 16);
                if (f4 == 0 && !dry) PROJ[(row0 + t) * NIN + C_XM + h * 64 + p] = (bf16)f2bf(part + Dh * xv); }
        }
        if (!dry)
#pragma unroll
        for (int i = 0; i < 4; ++i) *(f32x4*)(out + O_SSMS + sbase + (size_t)i * 16 * 128) = hv[i];
    }
    __syncthreads();
}
__device__ __forceinline__ void hgrn_sample_jobs(int bx, int G, bf16* PROJ, const float* const* in, float* out, LAS unsigned char* lds, int tid, bool dry) {
    const int v4 = tid & 31, kq = tid >> 5;
    f32x4 nx[8];
    { const int job = bx; if (job < DB * 8) { const size_t sbase = ((size_t)job * 128 + 8 * kq) * 128 + 4 * v4;
#pragma unroll
        for (int i = 0; i < 8; ++i) nx[i] = *(const f32x4*)(in[4] + sbase + (size_t)i * 128); } }
    int it = 0;
    for (int job = bx; job < DB * 8; job += G, ++it) {
        const int sb = job >> 3, hd = job & 7; const size_t row0 = (size_t)TP + 4 * sb;
        LAS float* SQ = (LAS float*)(lds + (it & 1) * 8192); LAS float* SF = SQ + 512; LAS float* SK = SF + 512; LAS float* SV = SK + 512;
        LAS float* PP = (LAS float*)(lds + 16384 + (it & 1) * 32768);
        f32x4 s[8];
#pragma unroll
        for (int i = 0; i < 8; ++i) s[i] = nx[i];
        const size_t sbase = ((size_t)job * 128 + 8 * kq) * 128 + 4 * v4;
        if (job + G < DB * 8) { const size_t nb = ((size_t)(job + G) * 128 + 8 * kq) * 128 + 4 * v4;
#pragma unroll
            for (int i = 0; i < 8; ++i) nx[i] = *(const f32x4*)(in[4] + nb + (size_t)i * 128); }
        if (tid < 128) { const int k = tid; const float lb = sigm(in[18][hd * 128 + k] - in[18][1024 + hd * 128 + k]);
#pragma unroll
            for (int t = 0; t < 4; ++t) { const float frw = bf2f(PROJ[(row0 + t) * NIN + C_F + hd * 128 + k]), q = bf2f(PROJ[(row0 + t) * NIN + C_Q + hd * 128 + k]);
                const float sg = sigm(frw); SF[t * 128 + k] = lb + (1.f - lb) * sg; SK[t * 128 + k] = (1.f - lb) * (1.f - sg); SQ[t * 128 + k] = q; } }
        else if (tid < 256) { const int v = tid - 128;
#pragma unroll
            for (int t = 0; t < 4; ++t) SV[t * 128 + v] = bf2f(PROJ[(row0 + t) * NIN + C_I + hd * 128 + v]); }
        __syncthreads();
#pragma unroll
        for (int t = 0; t < 4; ++t) { const f32x4 vv = *(const LAS f32x4*)(SV + t * 128 + 4 * v4); f32x4 part = (f32x4){0.f, 0.f, 0.f, 0.f};
#pragma unroll
            for (int i = 0; i < 8; ++i) { const float f = SF[t * 128 + 8 * kq + i], kk = SK[t * 128 + 8 * kq + i], q = SQ[t * 128 + 8 * kq + i];
                s[i] = s[i] * f + vv * kk; part += s[i] * q; }
            *(LAS f32x4*)(PP + (t * 16 + kq) * 128 + 4 * v4) = part; }
        if (!dry)
#pragma unroll
        for (int i = 0; i < 8; ++i) *(f32x4*)(out + O_HGS + sbase + (size_t)i * 128) = s[i];
        __syncthreads();
        { const int t = tid >> 7, v = tid & 127; float o = 0.f;
#pragma unroll
            for (int q = 0; q < 16; ++q) o += PP[(t * 16 + q) * 128 + v];
            if (!dry) PROJ[(row0 + t) * NIN + C_I + hd * 128 + v] = (bf16)f2bf(o); }
    }
    __syncthreads();
}
#ifndef MK_N_LAUNCHES
#define MK_N_LAUNCHES 1
#endif
constexpr int NPH = 15;
struct Args { const float* in[29]; float* out; unsigned char* ws; int ph_lo, ph_hi; };
static_assert(sizeof(Args) == 29 * 8 + 8 + 8 + 8, "Args has no padding");

__global__ void __launch_bounds__(NTHR, 2) mk_fwd(Args args) {
    extern __shared__ __attribute__((aligned(16))) unsigned char lds_raw[];
    LAS unsigned char* lds = (LAS unsigned char*)lds_raw;
    volatile LAS unsigned* MISC = (volatile LAS unsigned*)(lds + MISC_OFF);
    const int tid = threadIdx.x, lane = tid & 63, wave = __builtin_amdgcn_readfirstlane(tid >> 6);
    const int G = gridDim.x; const int bx = blockIdx.x; const int vcu = (G % 8 == 0) ? (bx % 8) * (G / 8) + bx / 8 : bx;
    const float* const* in = args.in; float* out = args.out; unsigned char* outb = (unsigned char*)args.out; unsigned char* ws = args.ws;
    for (int u = tid; u < (LDS_BYTES - LDSCTL_OFF) / 4; u += NTHR) ((LAS unsigned*)(lds + LDSCTL_OFF))[u] = 0u;
    __syncthreads();
    const int lo = args.ph_lo, hi = args.ph_hi;
    XcdBarrier bar; bar.bar = (unsigned*)(ws + WS_CTL) + CW_BAR; bar.x = 0; bar.st = nullptr;
    if (hi - lo > 1) bar = xcd_barrier_post((unsigned*)(ws + WS_CTL) + CW_BAR, MISC + 8);
#ifndef PH_MASK
#define PH_MASK 0x7fff
#endif
#define IN(k) ((((PH_MASK) >> (k)) & 1) && lo <= (k) && (k) < hi)
#ifndef DUP_MASK
#define DUP_MASK 0
#endif
#define DUPN(k) ((((DUP_MASK) >> (k)) & 1) ? 2 : 1)
#ifndef TIME_PHASE
#define TIME_PHASE -1
#endif
#ifndef TIME_MULT
#define TIME_MULT 4
#endif
    unsigned long long tp_a = 0, tp_d = 0;
#define SEAM(k) do { if (IN(k) && IN((k) + 1)) xcd_barrier(bar); \
        if (TIME_PHASE >= 0) { if ((k) + 1 == TIME_PHASE) tp_a = __builtin_amdgcn_s_memrealtime(); if ((k) == TIME_PHASE) tp_d = __builtin_amdgcn_s_memrealtime() - tp_a; } } while (0)
    bf16* PROJ = (bf16*)(ws + WS_PROJ);
    float* Y = out + O_Y;

#define REPS(k) _Pragma("unroll 1") for (int rep_ = DUPN(k) - 1; rep_ >= 0; --rep_)
#define DRY ((rep_ > 0) && (args.ph_hi != 12345))
    if (IN(0)) REPS(0) { p0_prologue(in, outb, ws, lds, vcu, G, wave, lane); } SEAM(0);
    if (IN(1)) REPS(1) { pg8::Gemm g{(const bf16*)(outb + OS_XB), (const bf16*)(outb + OS_W1A), T, NGU, D, D}; pg8::StaticOrder S; S.init(T, NGU, G, bx);
        EpiSwiGLU E{(bf16*)(ws + WS_H)}; pg8::gemm_phase<EpiSwiGLU, pg8::StaticOrder, true, true>(lds, g, S, E); } SEAM(1);
    if (IN(2)) REPS(2) { pg8::Gemm g{(const bf16*)(ws + WS_H), (const bf16*)(outb + OS_W1D), TP, D, FF, FF}; pg8::StaticOrder S; S.init(TP, D, G, bx);
        EpiResid E{in[0], in[1], Y, 0.5f, false}; pg8::gemm_phase<EpiResid, pg8::StaticOrder, true, true>(lds, g, S, E);
        small_gemm<11>((const bf16*)(ws + WS_H), FF, (const bf16*)(outb + OS_W1D), FF, E, lds, bx, G, tid, wave, lane); } SEAM(2);
    if (IN(3)) REPS(3) { ln_phase(Y, (bf16*)(outb + OS_XB), in[8], in[9], vcu, G, wave, lane, DRY); } SEAM(3);
    if (IN(4)) REPS(4) { pg8::Gemm g{(const bf16*)(outb + OS_XB), (const bf16*)(outb + OS_WIN), T, NINP, D, D}; pg8::StaticOrder S; S.init(T, NINP, G, bx);
        EpiBf16N E{PROJ, NIN, NIN}; pg8::gemm_phase<EpiBf16N, pg8::StaticOrder, true, true>(lds, g, S, E); } SEAM(4);
    if (IN(5)) REPS(5) { for (int ci = bx; ci < 256; ci += G) prep_chunk(ci, PROJ, in, out, ws, tid, wave, lane, DRY); } SEAM(5);
    if (IN(6)) REPS(6) {
        const bool dry = DRY;
#ifndef DRY_SCAN_MASK
#define DRY_SCAN_MASK 7
#endif
        const int smask = (rep_ > 0) ? (DRY_SCAN_MASK) : 7;
        if (smask & 1) for (int pj = bx; pj < 256; pj += G) scan_pair_job(pj, PROJ, out, ws, in, lds, tid, wave, dry);
        if (smask & 2) ssd_sample_jobs(bx, G, PROJ, in, out, lds, tid, dry);
        if (smask & 4) hgrn_sample_jobs(bx, G, PROJ, in, out, lds, tid, dry);
    } SEAM(6);
    if (IN(7)) REPS(7) { norm_phase(PROJ, in[16], in[19], vcu, G, wave, lane, DRY); } SEAM(7);
    if (IN(8)) REPS(8) { pg8::Gemm g{PROJ + C_XM, (const bf16*)(ws + WS_WMO), TP, D, D, NIN}; pg8::StaticOrder S; S.init(TP, D, G, bx);
        EpiGate<false> E{PROJ + C_GM, PROJ + C_Z, false}; pg8::gemm_phase<EpiGate<false>, pg8::StaticOrder, true, true>(lds, g, S, E);
        small_gemm<4>(PROJ + C_XM, NIN, (const bf16*)(ws + WS_WMO), D, E, lds, bx, G, tid, wave, lane); } SEAM(8);
    if (IN(9)) REPS(9) { pg8::Gemm g{PROJ + C_I, (const bf16*)(ws + WS_WHO), TP, D, D, NIN}; pg8::StaticOrder S; S.init(TP, D, G, bx);
        EpiGate<true> E{PROJ + C_GH, PROJ + C_Z, DRY}; pg8::gemm_phase<EpiGate<true>, pg8::StaticOrder, true, true>(lds, g, S, E);
        small_gemm<4>(PROJ + C_I, NIN, (const bf16*)(ws + WS_WHO), D, E, lds, bx, G, tid, wave, lane); } SEAM(9);
    if (IN(10)) REPS(10) { pg8::Gemm g{PROJ + C_Z, (const bf16*)(ws + WS_WO), TP, D, D, NIN}; pg8::StaticOrder S; S.init(TP, D, G, bx);
        EpiResid E{Y, nullptr, Y, 1.0f, DRY}; pg8::gemm_phase<EpiResid, pg8::StaticOrder, true, true>(lds, g, S, E);
        small_gemm<4>(PROJ + C_Z, NIN, (const bf16*)(ws + WS_WO), D, E, lds, bx, G, tid, wave, lane); } SEAM(10);
    if (IN(11)) REPS(11) { ln_phase(Y, (bf16*)(ws + WS_X2B), in[22], in[23], vcu, G, wave, lane, DRY);
        ffn_weight_items(in[24], in[25], in[26], (bf16*)(ws + WS_W2A), (bf16*)(ws + WS_W2D), (LAS float*)(lds + wave * 16384), vcu * NWAVES + wave, G * NWAVES, lane); } SEAM(11);
    if (IN(12)) REPS(12) { pg8::Gemm g{(const bf16*)(ws + WS_X2B), (const bf16*)(ws + WS_W2A), T, NGU, D, D}; pg8::StaticOrder S; S.init(T, NGU, G, bx);
        EpiSwiGLU E{(bf16*)(ws + WS_H)}; pg8::gemm_phase<EpiSwiGLU, pg8::StaticOrder, true, true>(lds, g, S, E); } SEAM(12);
    if (IN(13)) REPS(13) { pg8::Gemm g{(const bf16*)(ws + WS_H), (const bf16*)(ws + WS_W2D), TP, D, FF, FF}; pg8::StaticOrder S; S.init(TP, D, G, bx);
        EpiResid E{Y, nullptr, Y, 0.5f, DRY}; pg8::gemm_phase<EpiResid, pg8::StaticOrder, true, true>(lds, g, S, E);
        small_gemm<11>((const bf16*)(ws + WS_H), FF, (const bf16*)(ws + WS_W2D), FF, E, lds, bx, G, tid, wave, lane); } SEAM(13);
    if (IN(14)) REPS(14) { ln_phase(Y, nullptr, in[27], in[28], vcu, G, wave, lane, DRY); }
    if (TIME_PHASE >= 0 && bx == 0 && tid == 0) { if (TIME_PHASE == 0) tp_d = 0; const unsigned long long te = __builtin_amdgcn_s_memrealtime();
        while (__builtin_amdgcn_s_memrealtime() - te < (unsigned long long)TIME_MULT * tp_d) __builtin_amdgcn_s_sleep(8); }
#undef REPS
#undef DRY
#undef IN
#undef SEAM
}

extern "C" void kernel_launch(void* const* d_in, const int* in_sizes, int n_in, void* d_out, int out_size, void* d_ws, size_t ws_size, hipStream_t stream) {
    static int grid = 0;
    if (grid == 0) {
        if (n_in != 29 || out_size != (int)O_END || ws_size < WS_END2) { fprintf(stderr, "kernel_launch: unexpected shapes (n_in %d, out %d, ws %zu < %zu)\n", n_in, out_size, ws_size, (size_t)WS_END2); grid = -1; return; }
        int dev = 0, cus = 0, per_cu = 0;
        if (hipGetDevice(&dev) != hipSuccess || hipDeviceGetAttribute(&cus, hipDeviceAttributeMultiprocessorCount, dev) != hipSuccess) { grid = -1; return; }
        if (hipFuncSetAttribute((const void*)mk_fwd, hipFuncAttributeMaxDynamicSharedMemorySize, LDS_BYTES) != hipSuccess) { fprintf(stderr, "kernel_launch: hipFuncSetAttribute failed\n"); grid = -1; return; }
        if (hipOccupancyMaxActiveBlocksPerMultiprocessor(&per_cu, (const void*)mk_fwd, NTHR, LDS_BYTES) != hipSuccess || per_cu < 1) { fprintf(stderr, "kernel_launch: occupancy query says %d\n", per_cu); }
        (void)hipGetLastError();
        grid = cus;
    }
    if (grid < 0) return;
    (void)hipMemsetAsync((char*)d_ws + WS_CTL, 0, CTL_ZERO_BYTES, stream);
    Args a{};
    for (int i = 0; i < 29; ++i) a.in[i] = (const float*)d_in[i];
    a.out = (float*)d_out; a.ws = (unsigned char*)d_ws;
    if (MK_N_LAUNCHES == 1) { a.ph_lo = 0; a.ph_hi = NPH; hipLaunchKernelGGL(mk_fwd, dim3(grid), dim3(NTHR), LDS_BYTES, stream, a); }
    else { for (int p = 0; p < NPH; ++p) { a.ph_lo = p; a.ph_hi = p + 1; hipLaunchKernelGGL(mk_fwd, dim3(grid), dim3(NTHR), LDS_BYTES, stream, a); } }
}
```

```cpp
#include <hip/hip_runtime.h>
#include <cstdio>
#include <cstdint>
#define MK_N_LAUNCHES 1
#define DUP_MASK 0
#define DRY_SCAN_MASK 15
#define TIME_PHASE -1
namespace pg8 {
#define PG8_LAS __attribute__((address_space(3)))
typedef unsigned short bf16_t;
typedef short bf16x8 __attribute__((ext_vector_type(8)));
typedef float f32x4 __attribute__((ext_vector_type(4)));
typedef unsigned u32x4 __attribute__((ext_vector_type(4)));
typedef unsigned u32x2 __attribute__((ext_vector_type(2)));
constexpr int BM = 256, BK = 64, HALF = 128, HTB = HALF * BK * 2  , STAGE_BYTES = 8 * HTB, NXCD = 8, WGM = 8;

__host__ __device__ __forceinline__ int lds_byte(int r, int c) { const int st = (r >> 4) * 2 + (c >> 5), rr = r & 15, cc = c & 31, ob = rr * 64 + cc * 2; return st * 1024 + (ob ^ (((ob >> 9) & 1) << 5)); }
__host__ __device__ __forceinline__ void stage_rc(int b, int& R, int& C) { const int st = b / 1024, sb = b % 1024, swz = sb ^ (((sb >> 9) & 1) << 5); R = (st >> 1) * 16 + swz / 64; C = (st & 1) * 32 + (swz % 64) / 2; }
__host__ __device__ __forceinline__ int perm32(int rho) { const int n = rho >> 4, i = rho & 15; return 8 * (i >> 2) + 4 * n + (i & 3); }

struct Unit { int pm, pn; };
struct Gemm { const bf16_t* A; const bf16_t* Bt; int M, N, K, lda; };

struct StaticOrder {
    int nM, nN, nwg, G, c;
    __host__ __device__ void init(int M, int N, int G_, int c_) { nM = M / BM; nN = N / BM; nwg = nM * nN; G = G_; c = c_; }
    __host__ __device__ bool next(int i, Unit& u) const {
        const long L = (long)i * G + c; if (L >= nwg) return false;
        int wgid = (int)L; { const int q = nwg / NXCD, r = nwg % NXCD, xcd = wgid % NXCD, off = wgid / NXCD; wgid = (xcd < r ? xcd * (q + 1) : r * (q + 1) + (xcd - r) * q) + off; }
        const int nig = WGM * nN, gid = wgid / nig, fm = gid * WGM, gsz = (nM - fm) < WGM ? (nM - fm) : WGM;
        u.pm = fm + ((wgid % nig) % gsz); u.pn = (wgid % nig) / gsz; return true;
    }
};

__device__ __forceinline__ unsigned cvt_pk_bf16(float lo, float hi) { unsigned r; asm volatile("v_cvt_pk_bf16_f32 %0, %1, %2" : "=v"(r) : "v"(lo), "v"(hi)); return r; }

template <class Epi, class Sched, bool ALIGN_EPI = false, bool SP2 = false>
__device__ __forceinline__ void gemm_phase(PG8_LAS unsigned char* lds, const Gemm g, const Sched& S, const Epi& E) {
    const int tid = threadIdx.x, wid = __builtin_amdgcn_readfirstlane(tid >> 6), lane = tid & 63, wr = wid >> 2, wc = wid & 3, fr = lane & 15, fq = lane >> 4;
    const int K = g.K, nt = K / BK, lda = g.lda;
    unsigned voffA[2], voffB[2];
#pragma unroll
    for (int i = 0; i < 2; ++i) { int R, C; stage_rc(tid * 16 + i * 8192, R, C); const int Rb = Epi::PERM ? ((R & ~31) + perm32(R & 31)) : R;
        voffA[i] = (unsigned)(R * lda + C) * 2u; voffB[i] = (unsigned)(Rb * K + C) * 2u; }
    const size_t kstep = (size_t)(BK * 2);
    const size_t hstepA = (size_t)HALF * lda * 2, hstepB = (size_t)HALF * K * 2;
    const size_t tstepA = 2 * hstepA, tstepB = 2 * hstepB;
    const unsigned ldsw = (unsigned)wid * 1024u;
    const int aoff = lds_byte(wr * 64 + fr, fq * 8), boff = lds_byte(wc * 32 + fr, fq * 8);
#define PG8_SA(b, h) (((b) * 2 + (h)) * HTB)
#define PG8_SB(b, h) ((4 + (b) * 2 + (h)) * HTB)
#define PG8_STAGE(bufoff, gbase, voff) do { _Pragma("unroll") for (int _i = 0; _i < 2; ++_i) \
        __builtin_amdgcn_global_load_lds((const unsigned*)((const char*)(gbase) + (voff)[_i]), (PG8_LAS unsigned*)(lds + (bufoff) + ldsw + _i * 8192), 16, 0, 0); } while (0)
#define PG8_LDA(dst, b, h) do { _Pragma("unroll") for (int m = 0; m < 4; ++m) _Pragma("unroll") for (int k = 0; k < 2; ++k) dst[m][k] = *(const PG8_LAS bf16x8*)(lds + PG8_SA(b, h) + aoff + m * 2048 + k * 1024); } while (0)
#define PG8_LDB(dst, b, h) do { _Pragma("unroll") for (int n = 0; n < 2; ++n) _Pragma("unroll") for (int k = 0; k < 2; ++k) dst[n][k] = *(const PG8_LAS bf16x8*)(lds + PG8_SB(b, h) + boff + n * 2048 + k * 1024); } while (0)
#define PG8_MMA(ai, bj, At, Bt) do { __builtin_amdgcn_s_setprio(1); _Pragma("unroll") for (int m = 0; m < 4; ++m) _Pragma("unroll") for (int n = 0; n < 2; ++n) _Pragma("unroll") for (int k = 0; k < 2; ++k) \
        acc[ai][bj][m][n] = __builtin_amdgcn_mfma_f32_16x16x32_bf16(Bt[n][k], At[m][k], acc[ai][bj][m][n], 0, 0, 0); __builtin_amdgcn_s_setprio(0); } while (0)
#define PG8_WAIT_V(n) asm volatile("s_waitcnt vmcnt(" #n ")" ::: "memory")
#define PG8_WAIT_L(n) asm volatile("s_waitcnt lgkmcnt(" #n ")" ::: "memory")
#define PG8_BAR __builtin_amdgcn_s_barrier()
#define PG8_SCHED __builtin_amdgcn_sched_barrier(0)
    Unit cur, nxt; int ui = 0;
    if (!S.next(0, cur)) return;
    f32x4 acc[2][2][4][2];
#pragma unroll
    for (int a = 0; a < 2; ++a)
#pragma unroll
        for (int b = 0; b < 2; ++b)
#pragma unroll
            for (int m = 0; m < 4; ++m)
#pragma unroll
                for (int n = 0; n < 2; ++n) acc[a][b][m][n] = (f32x4){0.f, 0.f, 0.f, 0.f};
    bf16x8 At[4][2], B0[2][2], B1[2][2];
    const char* cA = (const char*)g.A + (size_t)cur.pm * tstepA; const char* cB = (const char*)g.Bt + (size_t)cur.pn * tstepB;
    if constexpr (SP2) {
        PG8_STAGE(PG8_SB(0, 0), cB, voffB); PG8_STAGE(PG8_SB(0, 1), cB + hstepB, voffB); PG8_STAGE(PG8_SA(0, 0), cA, voffA); PG8_STAGE(PG8_SA(0, 1), cA + hstepA, voffA);
        if (wr == 1) PG8_BAR;
        PG8_WAIT_V(2); PG8_BAR;
        PG8_STAGE(PG8_SB(1, 0), cB + kstep, voffB); PG8_STAGE(PG8_SA(1, 0), cA + kstep, voffA); PG8_STAGE(PG8_SB(1, 1), cB + hstepB + kstep, voffB);
        PG8_WAIT_V(6); PG8_BAR;
    } else {
        PG8_STAGE(PG8_SB(0, 0), cB, voffB); PG8_STAGE(PG8_SA(0, 0), cA, voffA); PG8_STAGE(PG8_SB(0, 1), cB + hstepB, voffB); PG8_STAGE(PG8_SA(0, 1), cA + hstepA, voffA);
        if (wr == 1) PG8_BAR;
        PG8_WAIT_V(4); PG8_BAR;
        PG8_STAGE(PG8_SB(1, 0), cB + kstep, voffB); PG8_STAGE(PG8_SA(1, 0), cA + kstep, voffA); PG8_STAGE(PG8_SB(1, 1), cB + hstepB + kstep, voffB);
        PG8_WAIT_V(6); PG8_BAR;
    }
    for (;;) {
        const bool has_next = S.next(ui + 1, nxt);
        const char* nA = has_next ? (const char*)g.A + (size_t)nxt.pm * tstepA : cA; const char* nB = has_next ? (const char*)g.Bt + (size_t)nxt.pn * tstepB : cB;
        for (int t = 0; t < nt; t += 2) {
            const bool last = (t == nt - 2);
            const char* a1 = cA + (size_t)(t + 1) * kstep;
            const char* a2 = last ? nA : cA + (size_t)(t + 2) * kstep; const char* b2 = last ? nB : cB + (size_t)(t + 2) * kstep;
            const char* a3 = a2 + kstep; const char* b3 = b2 + kstep;
            if constexpr (SP2) {
            PG8_LDB(B0, 0, 0); PG8_LDB(B1, 0, 1); PG8_SCHED; PG8_LDA(At, 0, 0); PG8_STAGE(PG8_SA(1, 1), a1 + hstepA, voffA);
            PG8_WAIT_V(8); PG8_WAIT_L(0); PG8_BAR; PG8_MMA(0, 0, At, B0); PG8_MMA(0, 1, At, B1); PG8_BAR; PG8_SCHED;
            PG8_LDA(At, 0, 1); PG8_STAGE(PG8_SB(0, 0), b2, voffB); PG8_STAGE(PG8_SB(0, 1), b2 + hstepB, voffB); PG8_STAGE(PG8_SA(0, 0), a2, voffA);
            PG8_WAIT_V(8); PG8_WAIT_L(0); PG8_BAR; PG8_MMA(1, 0, At, B0); PG8_MMA(1, 1, At, B1); PG8_BAR; PG8_SCHED;
            PG8_LDB(B0, 1, 0); PG8_LDB(B1, 1, 1); PG8_SCHED; PG8_LDA(At, 1, 0); PG8_STAGE(PG8_SA(0, 1), a2 + hstepA, voffA);
            PG8_WAIT_V(8); PG8_WAIT_L(0); PG8_BAR; PG8_MMA(0, 0, At, B0); PG8_MMA(0, 1, At, B1); PG8_BAR; PG8_SCHED;
            PG8_LDA(At, 1, 1); PG8_STAGE(PG8_SB(1, 0), b3, voffB); PG8_STAGE(PG8_SB(1, 1), b3 + hstepB, voffB); PG8_STAGE(PG8_SA(1, 0), a3, voffA);
            PG8_WAIT_V(8); PG8_WAIT_L(0); PG8_BAR; PG8_MMA(1, 0, At, B0); PG8_MMA(1, 1, At, B1); PG8_BAR; PG8_SCHED;
            } else {
            PG8_LDB(B0, 0, 0); PG8_SCHED; PG8_LDA(At, 0, 0); PG8_STAGE(PG8_SA(1, 1), a1 + hstepA, voffA);
            PG8_WAIT_L(8); PG8_BAR; PG8_WAIT_L(0); PG8_MMA(0, 0, At, B0); PG8_BAR; PG8_SCHED;
            PG8_LDB(B1, 0, 1); PG8_STAGE(PG8_SB(0, 0), b2, voffB);
            PG8_BAR; PG8_WAIT_L(0); PG8_MMA(0, 1, At, B1); PG8_BAR;
            PG8_LDA(At, 0, 1); PG8_STAGE(PG8_SA(0, 0), a2, voffA);
            PG8_BAR; PG8_WAIT_L(0); PG8_MMA(1, 0, At, B0); PG8_BAR; PG8_SCHED;
            PG8_STAGE(PG8_SB(0, 1), b2 + hstepB, voffB);
            PG8_WAIT_V(6); PG8_BAR; PG8_MMA(1, 1, At, B1); PG8_BAR;
            PG8_LDB(B0, 1, 0); PG8_SCHED; PG8_LDA(At, 1, 0); PG8_STAGE(PG8_SA(0, 1), a2 + hstepA, voffA);
            PG8_WAIT_L(8); PG8_BAR; PG8_WAIT_L(0); PG8_MMA(0, 0, At, B0); PG8_BAR; PG8_SCHED;
            PG8_LDB(B1, 1, 1); PG8_STAGE(PG8_SB(1, 0), b3, voffB);
            PG8_BAR; PG8_WAIT_L(0); PG8_MMA(0, 1, At, B1); PG8_BAR;
            PG8_LDA(At, 1, 1); PG8_STAGE(PG8_SA(1, 0), a3, voffA);
            PG8_BAR; PG8_WAIT_L(0); PG8_MMA(1, 0, At, B0); PG8_BAR; PG8_SCHED;
            PG8_STAGE(PG8_SB(1, 1), b3 + hstepB, voffB);
            PG8_WAIT_V(6); PG8_BAR; PG8_MMA(1, 1, At, B1); PG8_BAR;
            }
        }
        if constexpr (ALIGN_EPI) { if (wr == 0) PG8_BAR; }
        E(acc, cur, wr, wc, fr, fq);
        if (!has_next) break;
#pragma unroll
        for (int a = 0; a < 2; ++a)
#pragma unroll
            for (int b = 0; b < 2; ++b)
#pragma unroll
                for (int m = 0; m < 4; ++m)
#pragma unroll
                    for (int n = 0; n < 2; ++n) acc[a][b][m][n] = (f32x4){0.f, 0.f, 0.f, 0.f};
        cur = nxt; cA = nA; cB = nB; ++ui;
        if constexpr (ALIGN_EPI) { if (wr == 1) PG8_BAR; }
    }
    PG8_WAIT_V(0);
    if constexpr (!ALIGN_EPI) { if (wr == 0) PG8_BAR; }
    PG8_BAR;
#undef PG8_SA
#undef PG8_SB
#undef PG8_STAGE
#undef PG8_LDA
#undef PG8_LDB
#undef PG8_MMA
#undef PG8_WAIT_V
#undef PG8_WAIT_L
#undef PG8_BAR
#undef PG8_SCHED
}
}
#define GAS __attribute__((address_space(1)))
#define LAS __attribute__((address_space(3)))
typedef unsigned short bf16;
typedef unsigned v4u __attribute__((ext_vector_type(4)));
typedef unsigned v2u __attribute__((ext_vector_type(2)));
typedef float f32x4 __attribute__((ext_vector_type(4)));
typedef short bf16x8 __attribute__((ext_vector_type(8)));
typedef GAS unsigned gu32;
#define RLX_AGENT __ATOMIC_RELAXED, __HIP_MEMORY_SCOPE_AGENT
#define LDS_WAIT() asm volatile("s_waitcnt lgkmcnt(0)" ::: "memory")
#define VM_WAIT() asm volatile("s_waitcnt vmcnt(0)" ::: "memory")

constexpr int NWAVES = 8, NTHR = 512;
constexpr int T = 16896, TP = 16384, D = 1024, FF = 2816, NGU = 2 * FF, NIN = 9232, NINP = 9472;
constexpr int SEQ = 2048, NB = 8, DB = 128, DSEQ = 4;
constexpr float ALPHA = 1.189207115002721f, EPS = 1e-5f;
constexpr int C_Z = 0, C_XM = 1024, C_B = 2048, C_C = 2560, C_Q = 3072, C_F = 4096, C_I = 5120, C_OG = 6144, C_GM = 7168, C_GH = 8192, C_DT = 9216;
constexpr size_t O_Y = 0, O_CONVP = 17301504, O_SSMP = 17350656, O_HGP = 18399232, O_CONVS = 19447808, O_SSMS = 20234240, O_HGS = 37011456, O_END = 53788672;
constexpr size_t MiB = 1u << 20;
constexpr size_t OS_XB = O_SSMS * 4, OS_W1A = O_SSMS * 4 + 36 * MiB, OS_W1D = O_SSMS * 4 + 48 * MiB, OS_WIN = O_HGS * 4;
constexpr size_t WS_CTL = 0, CTL_ZERO_BYTES = 64 * 1024, WS_WMO = 1 * MiB, WS_WHO = 3 * MiB, WS_WO = 5 * MiB, WS_B = 8 * MiB;
constexpr size_t WS_PROJ = WS_B, WS_X2B = WS_B, WS_W2A = WS_B + 36 * MiB, WS_W2D = WS_B + 48 * MiB, WS_H = WS_B + 64 * MiB;
constexpr size_t WS_END = WS_B + (size_t)T * NIN * 2;
static_assert(WS_H + (size_t)T * FF * 2 <= WS_END, "H fits region B");
constexpr int CW_BAR = 1024;
constexpr int RING_BYTES = 131072, LDSCTL_OFF = RING_BYTES, MISC_OFF = LDSCTL_OFF + 320, LDS_BYTES = 147456;

__device__ __forceinline__ unsigned f2bf(float f) { unsigned u = __builtin_bit_cast(unsigned, f); return (u + 0x7fffu + ((u >> 16) & 1u)) >> 16; }
__device__ __forceinline__ unsigned pk2(float lo, float hi) { return f2bf(lo) | (f2bf(hi) << 16); }
__device__ __forceinline__ float bf2f(unsigned u16) { return __builtin_bit_cast(float, u16 << 16); }
__device__ __forceinline__ float bflo(unsigned w) { return __builtin_bit_cast(float, w << 16); }
__device__ __forceinline__ float bfhi(unsigned w) { return __builtin_bit_cast(float, w & 0xffff0000u); }
__device__ __forceinline__ float sigm(float x) { return __builtin_amdgcn_rcpf(1.f + __expf(-x)); }
__device__ __forceinline__ float siluf(float x) { return x * sigm(x); }
__device__ __forceinline__ float wave_sum(float v) {
#pragma unroll
    for (int o = 1; o < 64; o <<= 1) v += __shfl_xor(v, o);
    return v;
}

#define XB_TMO      128
#define XB_XCNT(j)  (256  + 64 * (j))
#define XB_XSUB(j)  (1280 + 64 * (j))
#define XB_XGEN(j)  (2304 + 64 * (j))
#define XB_TOP      3328
#define XB_TOPGEN   3392
#define XCD_BAR_WORDS 3456
#define XB_SPIN_CAP (1u << 20)
__device__ __forceinline__ unsigned xb_ld(unsigned* p)              { return __hip_atomic_load(p, __ATOMIC_RELAXED, __HIP_MEMORY_SCOPE_AGENT); }
__device__ __forceinline__ unsigned xb_add(unsigned* p, unsigned v) { return __hip_atomic_fetch_add(p, v, __ATOMIC_RELAXED, __HIP_MEMORY_SCOPE_AGENT); }
__device__ __forceinline__ unsigned xb_xcc_id() { return (unsigned)__builtin_amdgcn_s_getreg((3 << 11) | 20) & 0xFu; }
#define XB_SPIN(cond, bar) do { unsigned _sp = 0; while (cond) { __builtin_amdgcn_s_sleep(1); \
    if ((++_sp & 255u) == 0u) { if (xb_ld(&(bar)[XB_TMO])) break; if (_sp > XB_SPIN_CAP) { atomicAdd(&(bar)[XB_TMO], 1u); break; } } } } while (0)
struct XcdBarrier { unsigned* bar; unsigned x; volatile LAS unsigned* st; };
__device__ __forceinline__ XcdBarrier xcd_barrier_post(unsigned* bar, volatile LAS unsigned* st) {
    XcdBarrier b; b.bar = bar; b.x = xb_xcc_id(); b.st = st;
    if (threadIdx.x == 0) (void)xb_add(&bar[XB_XCNT(b.x)], 1u);
    return b;
}
__device__ __forceinline__ void xcd_barrier_complete(unsigned* bar, unsigned x, unsigned& nloc, unsigned& nx) {
    const unsigned G = gridDim.x * gridDim.y * gridDim.z;
    unsigned sum, cnt, mine, sp = 0u;
    for (;;) {
        sum = 0u; cnt = 0u; mine = 0u;
#pragma unroll
        for (unsigned j = 0; j < 16; ++j) { const unsigned c = xb_ld(&bar[XB_XCNT(j)]); sum += c; cnt += (c > 0u) ? 1u : 0u; mine = (j == x) ? c : mine; }
        if (sum == G) break;
        __builtin_amdgcn_s_sleep(1);
        if ((++sp & 255u) == 0u) { if (xb_ld(&bar[XB_TMO])) break; if (sp > XB_SPIN_CAP) { atomicAdd(&bar[XB_TMO], 1u); break; } }
    }
    nloc = mine > 0u ? mine : 1u; nx = cnt > 0u ? cnt : 1u;
}
__device__ __forceinline__ void xcd_barrier(const XcdBarrier& b) {
    asm volatile("s_waitcnt vmcnt(0)" ::: "memory");
    __syncthreads();
    if (threadIdx.x == 0) {
        unsigned* bar = b.bar;
        __builtin_amdgcn_s_waitcnt(0);
        unsigned nloc = b.st[0], nx = b.st[1];
        if (nloc == 0u) { xcd_barrier_complete(bar, b.x, nloc, nx); b.st[0] = nloc; b.st[1] = nx; }
        const unsigned old = xb_add(&bar[XB_XSUB(b.x)], 1u);
        const unsigned gen = old / nloc;
        if (old + 1u == (gen + 1u) * nloc) {
            __builtin_amdgcn_fence(__ATOMIC_RELEASE, "agent");
            asm volatile("s_waitcnt vmcnt(0)" ::: "memory");
            const unsigned og = xb_add(&bar[XB_TOP], 1u);
            const unsigned tg = og / nx;
            if (og + 1u == (tg + 1u) * nx) xb_add(&bar[XB_TOPGEN], 1u);
            else XB_SPIN(xb_ld(&bar[XB_TOPGEN]) == tg, bar);
            __builtin_amdgcn_fence(__ATOMIC_ACQUIRE, "agent");
            xb_add(&bar[XB_XGEN(b.x)], 1u);
            asm volatile("s_waitcnt vmcnt(0)" ::: "memory");
        } else {
            XB_SPIN(xb_ld(&bar[XB_XGEN(b.x)]) == gen, bar);
            __builtin_amdgcn_fence(__ATOMIC_ACQUIRE, "agent");
            asm volatile("s_waitcnt vmcnt(0)" ::: "memory");
        }
    }
    __syncthreads();
}

using pg8::Unit;
struct EpiSwiGLU {
    static constexpr bool PERM = true;
    bf16* H;
    __device__ __forceinline__ void operator()(const f32x4 (&acc)[2][2][4][2], const Unit& u, int wr, int wc, int fr, int fq) const {
        const int row0 = u.pm * 256 + wr * 64 + fr, col0 = u.pn * 128 + wc * 32 + 8 * fq;
#pragma unroll
        for (int ai = 0; ai < 2; ++ai)
#pragma unroll
            for (int m = 0; m < 4; ++m) {
                const f32x4 g0 = acc[ai][0][m][0], g1 = acc[ai][0][m][1], u0 = acc[ai][1][m][0], u1 = acc[ai][1][m][1];
                v4u w;
                w.x = pg8::cvt_pk_bf16(siluf(g0[0]) * u0[0], siluf(g0[1]) * u0[1]); w.y = pg8::cvt_pk_bf16(siluf(g0[2]) * u0[2], siluf(g0[3]) * u0[3]);
                w.z = pg8::cvt_pk_bf16(siluf(g1[0]) * u1[0], siluf(g1[1]) * u1[1]); w.w = pg8::cvt_pk_bf16(siluf(g1[2]) * u1[2], siluf(g1[3]) * u1[3]);
                *(v4u*)(H + (size_t)(row0 + ai * 128 + m * 16) * FF + col0) = w;
            }
    }
};
struct EpiBf16N {
    static constexpr bool PERM = true;
    bf16* O; int ldc, ncols;
    __device__ __forceinline__ void operator()(const f32x4 (&acc)[2][2][4][2], const Unit& u, int wr, int wc, int fr, int fq) const {
        const int row0 = u.pm * 256 + wr * 64 + fr, col0 = u.pn * 256 + wc * 32 + 8 * fq;
#pragma unroll
        for (int ai = 0; ai < 2; ++ai)
#pragma unroll
            for (int m = 0; m < 4; ++m) { bf16* rowp = O + (size_t)(row0 + ai * 128 + m * 16) * ldc + col0;
#pragma unroll
                for (int bj = 0; bj < 2; ++bj) { const f32x4 v0 = acc[ai][bj][m][0], v1 = acc[ai][bj][m][1];
                    v4u w; w.x = pg8::cvt_pk_bf16(v0[0], v0[1]); w.y = pg8::cvt_pk_bf16(v0[2], v0[3]); w.z = pg8::cvt_pk_bf16(v1[0], v1[1]); w.w = pg8::cvt_pk_bf16(v1[2], v1[3]);
                    if (col0 + bj * 128 < ncols) *(v4u*)(rowp + bj * 128) = w; } }
    }
};
struct EpiResid {
    static constexpr bool PERM = false;
    const float* res; const float* res2; float* out; float s; bool dry;
    __device__ __forceinline__ void operator()(const f32x4 (&acc)[2][2][4][2], const Unit& u, int wr, int wc, int fr, int fq) const {
        const int row0 = u.pm * 256 + wr * 64 + fr, col0 = u.pn * 256 + wc * 32 + 4 * fq;
        const float* rb = (res2 != nullptr && u.pm >= TP / 256) ? res2 - (size_t)TP * D : res;
#pragma unroll
        for (int ai = 0; ai < 2; ++ai)
#pragma unroll
            for (int m = 0; m < 4; ++m) { const size_t off = (size_t)(row0 + ai * 128 + m * 16) * D + col0;
#pragma unroll
                for (int bj = 0; bj < 2; ++bj)
#pragma unroll
                    for (int n = 0; n < 2; ++n) { const f32x4 r = *(const f32x4*)(rb + off + bj * 128 + n * 16);
                        if (!dry) *(f32x4*)(out + off + bj * 128 + n * 16) = r * ALPHA + acc[ai][bj][m][n] * s; } }
    }
    __device__ __forceinline__ void small(int row, int col, const f32x4 v) const {
        const float* rb = (res2 != nullptr && row >= TP) ? res2 - (size_t)TP * D : res; const size_t off = (size_t)row * D + col;
        const f32x4 r = *(const f32x4*)(rb + off); if (!dry) *(f32x4*)(out + off) = r * ALPHA + v * s;
    }
};
template <bool ADD> struct EpiGate {
    static constexpr bool PERM = true;
    const bf16* gate; bf16* dst; bool dry;
    __device__ __forceinline__ void operator()(const f32x4 (&acc)[2][2][4][2], const Unit& u, int wr, int wc, int fr, int fq) const {
        const int row0 = u.pm * 256 + wr * 64 + fr, col0 = u.pn * 256 + wc * 32 + 8 * fq;
#pragma unroll
        for (int ai = 0; ai < 2; ++ai)
#pragma unroll
            for (int m = 0; m < 4; ++m) { const size_t off = (size_t)(row0 + ai * 128 + m * 16) * NIN + col0;
#pragma unroll
                for (int bj = 0; bj < 2; ++bj) { const f32x4 v0 = acc[ai][bj][m][0], v1 = acc[ai][bj][m][1];
                    const v4u gw = *(const v4u*)(gate + off + bj * 128);
                    float r[8] = { sigm(bflo(gw.x)) * v0[0], sigm(bfhi(gw.x)) * v0[1], sigm(bflo(gw.y)) * v0[2], sigm(bfhi(gw.y)) * v0[3],
                                   sigm(bflo(gw.z)) * v1[0], sigm(bfhi(gw.z)) * v1[1], sigm(bflo(gw.w)) * v1[2], sigm(bfhi(gw.w)) * v1[3] };
                    if (ADD) { const v4u dw = *(const v4u*)(dst + off + bj * 128);
                        r[0] += bflo(dw.x); r[1] += bfhi(dw.x); r[2] += bflo(dw.y); r[3] += bfhi(dw.y); r[4] += bflo(dw.z); r[5] += bfhi(dw.z); r[6] += bflo(dw.w); r[7] += bfhi(dw.w); }
                    v4u w; w.x = pg8::cvt_pk_bf16(r[0], r[1]); w.y = pg8::cvt_pk_bf16(r[2], r[3]); w.z = pg8::cvt_pk_bf16(r[4], r[5]); w.w = pg8::cvt_pk_bf16(r[6], r[7]);
                    if (!dry) *(v4u*)(dst + off + bj * 128) = w; } }
    }
    __device__ __forceinline__ void small(int row, int col, const f32x4 v) const {
        const size_t off = (size_t)row * NIN + col; const v2u gw = *(const v2u*)(gate + off);
        float r[4] = { sigm(bflo(gw.x)) * v[0], sigm(bfhi(gw.x)) * v[1], sigm(bflo(gw.y)) * v[2], sigm(bfhi(gw.y)) * v[3] };
        if (ADD) { const v2u dw = *(const v2u*)(dst + off); r[0] += bflo(dw.x); r[1] += bfhi(dw.x); r[2] += bflo(dw.y); r[3] += bfhi(dw.y); }
        if (!dry) *(v2u*)(dst + off) = (v2u){pg8::cvt_pk_bf16(r[0], r[1]), pg8::cvt_pk_bf16(r[2], r[3])};
    }
};

template <int KS  , class Epi>
__device__ __forceinline__ void small_gemm(const bf16* A, int lda, const bf16* Bt, int K, const Epi& E, LAS unsigned char* lds, int bx, int G, int tid, int wave, int lane) {
    const int fr = lane & 15, fq = lane >> 4;
    LAS float* red = (LAS float*)lds;
    for (int u = bx; u < 256; u += G) {
        const int r0 = TP + 32 * (u >> 4), c0 = 64 * (u & 15);
        f32x4 acc[2][4];
#pragma unroll
        for (int m = 0; m < 2; ++m)
#pragma unroll
            for (int n = 0; n < 4; ++n) acc[m][n] = (f32x4){0.f, 0.f, 0.f, 0.f};
        const bf16* pa = A + (size_t)(r0 + fr) * lda + wave * (KS * 32) + 8 * fq; const bf16* pb = Bt + (size_t)(c0 + fr) * K + wave * (KS * 32) + 8 * fq;
#pragma unroll 4
        for (int ks = 0; ks < KS; ++ks) {
            bf16x8 a[2], b[4];
#pragma unroll
            for (int m = 0; m < 2; ++m) a[m] = *(const bf16x8*)(pa + (size_t)(16 * m) * lda + 32 * ks);
#pragma unroll
            for (int n = 0; n < 4; ++n) b[n] = *(const bf16x8*)(pb + (size_t)(16 * n) * K + 32 * ks);
#pragma unroll
            for (int m = 0; m < 2; ++m)
#pragma unroll
                for (int n = 0; n < 4; ++n) acc[m][n] = __builtin_amdgcn_mfma_f32_16x16x32_bf16(b[n], a[m], acc[m][n], 0, 0, 0);
        }
#pragma unroll
        for (int m = 0; m < 2; ++m)
#pragma unroll
            for (int n = 0; n < 4; ++n) *(LAS f32x4*)(red + (wave * 32 + 16 * m + fr) * 64 + 16 * n + 4 * fq) = acc[m][n];
        __syncthreads();
        { const int row = tid >> 4, col = (tid & 15) * 4; f32x4 v = (f32x4){0.f, 0.f, 0.f, 0.f};
#pragma unroll
            for (int w = 0; w < 8; ++w) v += *(const LAS f32x4*)(red + (w * 32 + row) * 64 + col);
            E.small(r0 + row, c0 + col, v); }
        __syncthreads();
    }
}
__device__ __forceinline__ void transpose_item(const float* W, int ldw, int srccol0, int ncopy, bf16* WT, int dstrow0, int K, int k0, LAS float* scr, int lane) {
    { const int n4 = (lane & 7) * 4, kr = lane >> 3; f32x4 v[8];
#pragma unroll
        for (int i = 0; i < 8; ++i) v[i] = (n4 < ncopy) ? *(const f32x4*)(W + (size_t)(k0 + 8 * i + kr) * ldw + srccol0 + n4) : (f32x4){0.f, 0.f, 0.f, 0.f};
#pragma unroll
        for (int i = 0; i < 8; ++i) { LAS float* d = scr + (8 * i + kr) * 33 + n4; d[0] = v[i][0]; d[1] = v[i][1]; d[2] = v[i][2]; d[3] = v[i][3]; } }
    LDS_WAIT(); asm volatile("" ::: "memory");
    const int c = lane & 7;
#pragma unroll
    for (int j = 0; j < 4; ++j) { const int n = (lane >> 3) + 8 * j; const LAS float* s = scr + (8 * c) * 33 + n;
        v4u o; o.x = pk2(s[0 * 33], s[1 * 33]); o.y = pk2(s[2 * 33], s[3 * 33]); o.z = pk2(s[4 * 33], s[5 * 33]); o.w = pk2(s[6 * 33], s[7 * 33]);
        *(v4u*)(WT + (size_t)(dstrow0 + n) * K + k0 + 8 * c) = o; }
    LDS_WAIT(); asm volatile("" ::: "memory");
}
__device__ __forceinline__ void ffn_weight_items(const float* Wg, const float* Wu, const float* Wd, bf16* WA, bf16* WD, LAS float* scr, int gw, int NGW, int lane) {
    constexpr int I_A = (NGU / 32) * (D / 64), I_D = (D / 32) * (FF / 64);
    for (int it = gw; it < I_A + I_D; it += NGW) {
        if (it < I_A) { const int gi = it / (D / 64), kb = it % (D / 64), n0 = 32 * gi, pn = n0 >> 8, bj = (n0 >> 7) & 1, i0 = n0 & 127;
            transpose_item(bj ? Wu : Wg, FF, 128 * pn + i0, 32, WA, n0, D, 64 * kb, scr, lane); }
        else { const int r = it - I_A, gi = r / (FF / 64), kb = r % (FF / 64);
            transpose_item(Wd, D, 32 * gi, 32, WD, 32 * gi, FF, 64 * kb, scr, lane); }
    }
}
__device__ __forceinline__ void p0_prologue(const float* const* in, unsigned char* outb, unsigned char* ws, LAS unsigned char* lds, int vcu, int G, int wave, int lane) {
    LAS float* scr = (LAS float*)(lds + wave * 16384);
    const int gw = vcu * NWAVES + wave, NGW = G * NWAVES;
    ffn_weight_items(in[5], in[6], in[7], (bf16*)(outb + OS_W1A), (bf16*)(outb + OS_W1D), scr, gw, NGW, lane);
    constexpr int I_IN = (NINP / 32) * (D / 64), I_SQ = (D / 32) * (D / 64);
    for (int it = gw; it < I_IN + 3 * I_SQ; it += NGW) {
        if (it < I_IN) { const int gi = it / (D / 64), kb = it % (D / 64), n0 = 32 * gi;
            int src, ncopy;
            if (n0 < 3072) { src = n0; ncopy = 32; } else if (n0 < C_DT) { src = n0 + 16; ncopy = 32; } else if (n0 == C_DT) { src = 3072; ncopy = 16; } else { src = 0; ncopy = 0; }
            transpose_item(in[10], NIN, src, ncopy, (bf16*)(outb + OS_WIN), n0, D, 64 * kb, scr, lane); }
        else { const int r = it - I_IN, w = r / I_SQ, r2 = r % I_SQ, gi = r2 / (D / 64), kb = r2 % (D / 64);
            const float* W = in[w == 0 ? 17 : (w == 1 ? 20 : 21)]; bf16* WT = (bf16*)(ws + (w == 0 ? WS_WMO : (w == 1 ? WS_WHO : WS_WO)));
            transpose_item(W, D, 32 * gi, 32, WT, 32 * gi, D, 64 * kb, scr, lane); }
    }
    bf16* XB = (bf16*)(outb + OS_XB);
    const size_t n8 = (size_t)T * D / 8, nthr = (size_t)G * NTHR;
    for (size_t i0 = (size_t)vcu * NTHR + threadIdx.x; i0 < n8; i0 += 4 * nthr) {
        f32x4 a[4], b[4];
#pragma unroll
        for (int u = 0; u < 4; ++u) { const size_t i = i0 + u * nthr; if (i < n8) { const size_t e = i * 8; const float* src = (e < (size_t)TP * D) ? in[0] + e : in[1] + (e - (size_t)TP * D);
            a[u] = *(const f32x4*)src; b[u] = *(const f32x4*)(src + 4); } }
#pragma unroll
        for (int u = 0; u < 4; ++u) { const size_t i = i0 + u * nthr; if (i < n8) { v4u w; w.x = pk2(a[u][0], a[u][1]); w.y = pk2(a[u][2], a[u][3]); w.z = pk2(b[u][0], b[u][1]); w.w = pk2(b[u][2], b[u][3]);
            *(v4u*)(XB + i * 8) = w; } }
    }
}
__device__ __forceinline__ void ln_phase(float* X, bf16* XBo, const float* gam, const float* bet, int vcu, int G, int wave, int lane, bool dry) {
    const int gw = vcu * NWAVES + wave, NGW = G * NWAVES;
    f32x4 gv[4], bv[4];
#pragma unroll
    for (int j = 0; j < 4; ++j) { gv[j] = *(const f32x4*)(gam + 4 * lane + 256 * j); bv[j] = *(const f32x4*)(bet + 4 * lane + 256 * j); }
    f32x4 nx[4];
    { const int m0 = gw < T ? gw : 0;
#pragma unroll
        for (int j = 0; j < 4; ++j) nx[j] = ((const f32x4*)(X + (size_t)m0 * D) + lane)[64 * j]; }
    for (int m = gw; m < T; m += NGW) {
        f32x4* xr = (f32x4*)(X + (size_t)m * D) + lane;
        f32x4 v[4]; float s = 0.f;
#pragma unroll
        for (int j = 0; j < 4; ++j) v[j] = nx[j];
        { const int mn = (m + NGW < T) ? m + NGW : m;
#pragma unroll
            for (int j = 0; j < 4; ++j) nx[j] = ((const f32x4*)(X + (size_t)mn * D) + lane)[64 * j]; }
#pragma unroll
        for (int j = 0; j < 4; ++j) s += (v[j][0] + v[j][1]) + (v[j][2] + v[j][3]);
        const float mean = wave_sum(s) * (1.f / D); float s2 = 0.f;
#pragma unroll
        for (int j = 0; j < 4; ++j) { v[j] = v[j] - mean; s2 += (v[j][0] * v[j][0] + v[j][1] * v[j][1]) + (v[j][2] * v[j][2] + v[j][3] * v[j][3]); }
        const float rstd = 1.f / sqrtf(wave_sum(s2) * (1.f / D) + EPS);
#pragma unroll
        for (int j = 0; j < 4; ++j) { const f32x4 o = v[j] * rstd * gv[j] + bv[j]; if (dry) continue; xr[64 * j] = o;
            if (XBo) { v2u w; w.x = pk2(o[0], o[1]); w.y = pk2(o[2], o[3]); *((v2u*)(XBo + (size_t)m * D) + lane + 64 * j) = w; } }
    }
}
__device__ __forceinline__ void norm_phase(bf16* PROJ, const float* mw, const float* hw, int vcu, int G, int wave, int lane, bool dry) {
    const int gw = vcu * NWAVES + wave, NGW = G * NWAVES;
    float mwv[16], hwv[16];
#pragma unroll
    for (int j = 0; j < 16; ++j) { mwv[j] = mw[16 * lane + j]; hwv[j] = hw[16 * lane + j]; }
    v4u nx[8];
#define NORM_LOAD(m_) do { const bf16* r_ = PROJ + (size_t)(m_) * NIN + 16 * lane; nx[0] = *(const v4u*)(r_ + C_XM); nx[1] = *(const v4u*)(r_ + C_XM + 8); nx[2] = *(const v4u*)(r_ + C_Z); nx[3] = *(const v4u*)(r_ + C_Z + 8); \
        nx[4] = *(const v4u*)(r_ + C_I); nx[5] = *(const v4u*)(r_ + C_I + 8); nx[6] = *(const v4u*)(r_ + C_OG); nx[7] = *(const v4u*)(r_ + C_OG + 8); } while (0)
    { const int m0 = gw < T ? gw : 0; NORM_LOAD(m0); }
    for (int m = gw; m < T; m += NGW) {
        bf16* row = PROJ + (size_t)m * NIN;
        const v4u y0 = nx[0], y1 = nx[1], z0 = nx[2], z1 = nx[3], o0 = nx[4], o1 = nx[5], g0 = nx[6], g1 = nx[7];
        { const int mn = (m + NGW < T) ? m + NGW : m; NORM_LOAD(mn); }
        float a[16], b[16];
        const unsigned yw[8] = {y0.x, y0.y, y0.z, y0.w, y1.x, y1.y, y1.z, y1.w}, zw[8] = {z0.x, z0.y, z0.z, z0.w, z1.x, z1.y, z1.z, z1.w};
        const unsigned ow[8] = {o0.x, o0.y, o0.z, o0.w, o1.x, o1.y, o1.z, o1.w}, gww[8] = {g0.x, g0.y, g0.z, g0.w, g1.x, g1.y, g1.z, g1.w};
        float sa = 0.f, sb = 0.f;
#pragma unroll
        for (int j = 0; j < 8; ++j) {
            a[2 * j] = bflo(yw[j]) * siluf(bflo(zw[j])); a[2 * j + 1] = bfhi(yw[j]) * siluf(bfhi(zw[j]));
            b[2 * j] = bflo(ow[j]); b[2 * j + 1] = bfhi(ow[j]);
            sa += a[2 * j] * a[2 * j] + a[2 * j + 1] * a[2 * j + 1]; sb += b[2 * j] * b[2 * j] + b[2 * j + 1] * b[2 * j + 1];
        }
        sb += __shfl_xor(sb, 1); sb += __shfl_xor(sb, 2); sb += __shfl_xor(sb, 4);
        sa += __shfl_xor(sa, 1); sa += __shfl_xor(sa, 2); sa += __shfl_xor(sa, 4); sa += __shfl_xor(sa, 8);
        const float ra = 1.f / sqrtf(sa * (1.f / 256.f) + EPS), rb = 1.f / sqrtf(sb * (1.f / 128.f) + EPS);
        unsigned wa[8], wb[8];
#pragma unroll
        for (int j = 0; j < 8; ++j) {
            wa[j] = pk2(a[2 * j] * ra * mwv[2 * j], a[2 * j + 1] * ra * mwv[2 * j + 1]);
            wb[j] = pk2(b[2 * j] * rb * hwv[2 * j] * siluf(bflo(gww[j])), b[2 * j + 1] * rb * hwv[2 * j + 1] * siluf(bfhi(gww[j])));
        }
        if (dry) continue;
        *(v4u*)(row + C_XM + 16 * lane) = (v4u){wa[0], wa[1], wa[2], wa[3]}; *(v4u*)(row + C_XM + 16 * lane + 8) = (v4u){wa[4], wa[5], wa[6], wa[7]};
        *(v4u*)(row + C_I + 16 * lane) = (v4u){wb[0], wb[1], wb[2], wb[3]}; *(v4u*)(row + C_I + 16 * lane + 8) = (v4u){wb[4], wb[5], wb[6], wb[7]};
    }
#undef NORM_LOAD
}
typedef short v4s __attribute__((ext_vector_type(4)));
constexpr size_t WS_DECH = 7 * MiB, WS_DTF = WS_END, WS_ACF = WS_DTF + (size_t)T * 16 * 4, WS_TAIL = WS_ACF + (size_t)T * 16 * 4, WS_END2 = WS_TAIL + (size_t)256 * 3 * 2048 * 2;

__device__ __forceinline__ void unpack4(const v2u w, float (&f)[4]) { f[0] = bflo(w.x); f[1] = bfhi(w.x); f[2] = bflo(w.y); f[3] = bfhi(w.y); }

__device__ __forceinline__ void prep_chunk(int ci, bf16* PROJ, const float* const* in, float* out, unsigned char* ws, int tid, int wave, int lane, bool dry) {
    const int b = ci >> 5, c = ci & 31; const size_t r0 = (size_t)b * SEQ + (size_t)c * 64;
    float* DTF = (float*)(ws + WS_DTF); float* ACF = (float*)(ws + WS_ACF); float* DECH = (float*)(ws + WS_DECH); bf16* TAIL = (bf16*)(ws + WS_TAIL);
#pragma unroll
    for (int q = 0; q < 2; ++q) { const int h = 2 * wave + q;
        const float xr = bf2f(PROJ[(r0 + lane) * NIN + C_DT + h]) + in[13][h]; const float dt = xr > 20.f ? xr : log1pf(__expf(xr));
        float v = -__expf(in[14][h]) * dt;
#pragma unroll
        for (int o = 1; o < 64; o <<= 1) { const float tt = __shfl_up(v, o); if (lane >= o) v += tt; }
        if (!dry) { DTF[(r0 + lane) * 16 + h] = dt; ACF[(r0 + lane) * 16 + h] = v; } }
    { const int ch4 = 4 * tid; bf16* colp = PROJ + r0 * NIN + C_XM + ch4;
        const f32x4 cw0 = *(const f32x4*)(in[11] + ch4), cw1 = *(const f32x4*)(in[11] + 2048 + ch4), cw2 = *(const f32x4*)(in[11] + 4096 + ch4), cw3 = *(const f32x4*)(in[11] + 6144 + ch4), cbv = *(const f32x4*)(in[12] + ch4);
        float w0[4] = {0.f, 0.f, 0.f, 0.f}, w1[4] = {0.f, 0.f, 0.f, 0.f}, w2[4] = {0.f, 0.f, 0.f, 0.f};
        if (c > 0) { unpack4(*(const v2u*)(colp - 3 * (size_t)NIN), w0); unpack4(*(const v2u*)(colp - 2 * (size_t)NIN), w1); unpack4(*(const v2u*)(colp - (size_t)NIN), w2); }
#pragma unroll 1
        for (int tb = 0; tb < 64; tb += 16) {
            v2u raw[16];
#pragma unroll
            for (int i = 0; i < 16; ++i) raw[i] = *(const v2u*)(colp + (size_t)(tb + i) * NIN);
#pragma unroll
            for (int i = 0; i < 16; ++i) { float x[4]; unpack4(raw[i], x); float o[4];
#pragma unroll
                for (int j = 0; j < 4; ++j) { o[j] = siluf(cbv[j] + cw0[j] * w0[j] + cw1[j] * w1[j] + cw2[j] * w2[j] + cw3[j] * x[j]); w0[j] = w1[j]; w1[j] = w2[j]; w2[j] = x[j]; }
                const v2u ow = (v2u){pk2(o[0], o[1]), pk2(o[2], o[3])}; const int t = tb + i;
                if (dry) continue;
                if (t < 61) *(v2u*)(colp + (size_t)t * NIN) = ow; else *(v2u*)(TAIL + ((size_t)ci * 3 + (t - 61)) * 2048 + ch4) = ow;
                if (c == 31 && t >= 61) *(f32x4*)(out + O_CONVP + ((size_t)b * 3 + (t - 61)) * 2048 + ch4) = (f32x4){x[0], x[1], x[2], x[3]}; }
        } }
    { const int k2 = 2 * tid; bf16* qp = PROJ + r0 * NIN + C_Q + k2; bf16* fp = PROJ + r0 * NIN + C_F + k2;
        const float lb0 = sigm(in[18][k2] - in[18][1024 + k2]), lb1 = sigm(in[18][k2 + 1] - in[18][1024 + k2 + 1]);
        float run0 = 0.f, run1 = 0.f;
#pragma unroll 1
        for (int tb = 0; tb < 64; tb += 16) {
            unsigned qr[16], fr_[16];
#pragma unroll
            for (int i = 0; i < 16; ++i) { qr[i] = *(const unsigned*)(qp + (size_t)(tb + i) * NIN); fr_[i] = *(const unsigned*)(fp + (size_t)(tb + i) * NIN); }
#pragma unroll
            for (int i = 0; i < 16; ++i) {
                const float s0 = sigm(bflo(fr_[i])), s1 = sigm(bfhi(fr_[i]));
                run0 += __logf(lb0 + (1.f - lb0) * s0); run1 += __logf(lb1 + (1.f - lb1) * s1);
                const float e0 = __expf(run0), e1 = __expf(run1);
                if (dry) continue;
                *(unsigned*)(qp + (size_t)(tb + i) * NIN) = pk2(bflo(qr[i]) * e0, bfhi(qr[i]) * e1);
                *(unsigned*)(fp + (size_t)(tb + i) * NIN) = pk2((1.f - lb0) * (1.f - s0) * __builtin_amdgcn_rcpf(e0), (1.f - lb1) * (1.f - s1) * __builtin_amdgcn_rcpf(e1)); }
        }
        if (!dry) { DECH[(size_t)ci * 1024 + k2] = __expf(run0); DECH[(size_t)ci * 1024 + k2 + 1] = __expf(run1); } }
}

constexpr int S_QC = 136, S_X = 40, S_WT = 72;
constexpr int G_QC = 0, G_KB = 17408, G_X = 34816, G_XS = 39936, G_WT = 45056, G_ST = 54272, G_FA = 62976, GRP_BYTES = 64000;
static_assert(2 * GRP_BYTES <= RING_BYTES, "scan LDS map");
__device__ __forceinline__ bf16x8 row_frag(const LAS bf16* img, int stride, int row, int k) { return *(const LAS bf16x8*)(img + row * stride + k); }
__device__ __forceinline__ bf16x8 tr_frag(const LAS bf16* img, int stride, int k0, int c0, int fr) {
    const LAS bf16* p = img + (k0 + (fr >> 2)) * stride + c0 + 4 * (fr & 3);
    const v4s lo = __builtin_amdgcn_ds_read_tr16_b64_v4i16((LAS v4s*)p), hi = __builtin_amdgcn_ds_read_tr16_b64_v4i16((LAS v4s*)(p + 4 * stride));
    return (bf16x8){lo[0], lo[1], lo[2], lo[3], hi[0], hi[1], hi[2], hi[3]};
}
constexpr unsigned pack2(const int (&a)[10]) { unsigned r = 0; for (int i = 0; i < 10; ++i) r |= (unsigned)a[i] << (2 * i); return r; }
constexpr int TB_LIST[10] = {3, 3, 2, 2, 3, 3, 2, 1, 0, 1}, SB_LIST[10] = {0, 2, 0, 2, 1, 3, 1, 1, 0, 0};
constexpr unsigned TB_PK = pack2(TB_LIST), SB_PK = pack2(SB_LIST);

__device__ __forceinline__ void scan_pair_job(int pj, bf16* PROJ, float* out, unsigned char* ws, const float* const* in, LAS unsigned char* lds, int tid0, int wave, bool dry) {
    const bool ssd = wave < 4; const int w4 = wave & 3;
    LAS unsigned char* gl = lds + (ssd ? 0 : GRP_BYTES);
    LAS bf16* QC = (LAS bf16*)(gl + G_QC); LAS bf16* KB = (LAS bf16*)(gl + G_KB); LAS bf16* XN = (LAS bf16*)(gl + G_X); LAS bf16* XS = (LAS bf16*)(gl + (ssd ? G_XS : G_X));
    LAS bf16* WT = (LAS bf16*)(gl + G_WT); LAS bf16* ST = (LAS bf16*)(gl + G_ST); LAS float* ACUM = (LAS float*)(gl + G_FA); LAS float* DT = ACUM + 64; LAS float* DEC = ACUM + 128;
    const float* DTF = (const float*)(ws + WS_DTF); const float* ACF = (const float*)(ws + WS_ACF); const float* DECH = (const float*)(ws + WS_DECH); const bf16* TAIL = (const bf16*)(ws + WS_TAIL);
    int b, colC, colB, colX, chC = 0, chB = 0, chX = 0, h = 0, half = 0, hd = 0, vq = 0;
    if (ssd) { b = pj >> 5; h = (pj >> 1) & 15; half = pj & 1; const int g = h >> 2; colX = C_XM + h * 64 + half * 32; colB = C_B + g * 128; colC = C_C + g * 128; chX = h * 64 + half * 32; chB = 1024 + g * 128; chC = 1536 + g * 128; }
    else { b = pj >> 5; hd = (pj >> 2) & 7; vq = pj & 3; colB = C_F + hd * 128; colC = C_Q + hd * 128; colX = C_I + hd * 128 + vq * 32; }
    const size_t rowbase = (size_t)b * SEQ;
    const float Dh = ssd ? in[15][h] : 0.f;
    f32x4 st[4];
#pragma unroll
    for (int i = 0; i < 4; ++i) st[i] = (f32x4){0.f, 0.f, 0.f, 0.f};
    { const int gt = tid0 & 255; for (int i = gt; i < (G_FA - G_WT) / 4; i += 256) ((LAS unsigned*)(gl + G_WT))[i] = 0u; }
    v4u pfC[4], pfB[4], pfX; float fa = 0.f, fb = 0.f, fs_a = 0.f, fs_d = 0.f, fs_l = 0.f;
#define LOAD_REGS(c_) do { const int ci_ = b * 32 + (c_); const bf16* base_ = PROJ + (rowbase + (size_t)(c_) * 64) * NIN; \
        _Pragma("unroll") for (int j = 0; j < 4; ++j) { const int i = gt + 256 * j, row = i >> 4, c16 = i & 15; const bool tl = ssd && row >= 61; \
            const bf16* tb_ = TAIL + ((size_t)ci_ * 3 + (row - 61)) * 2048 + c16 * 8; \
            pfC[j] = *(const v4u*)(tl ? tb_ + chC : base_ + (size_t)row * NIN + colC + c16 * 8); pfB[j] = *(const v4u*)(tl ? tb_ + chB : base_ + (size_t)row * NIN + colB + c16 * 8); } \
        { const int row = gt >> 2, c16 = gt & 3; const bool tl = ssd && row >= 61; \
            pfX = *(const v4u*)(tl ? TAIL + ((size_t)ci_ * 3 + (row - 61)) * 2048 + chX + c16 * 8 : base_ + (size_t)row * NIN + colX + c16 * 8); } \
        { const size_t tb2_ = (rowbase + (size_t)(c_) * 64) * 16 + h; \
          const float* pa_ = ssd ? ACF + tb2_ + (size_t)(gt & 63) * 16 : DECH + (size_t)ci_ * 1024 + hd * 128 + (gt & 127); \
          const float* pb_ = ssd ? DTF + tb2_ + (size_t)(gt & 63) * 16 : pa_; \
          const float* pc_ = ssd ? ACF + tb2_ + (size_t)(gt >> 2) * 16 : pa_; const float* pd_ = ssd ? DTF + tb2_ + (size_t)(gt >> 2) * 16 : pa_; const float* pe_ = ssd ? ACF + tb2_ + 63 * 16 : pa_; \
          fa = *pa_; fb = *pb_; fs_a = *pc_; fs_d = *pd_; fs_l = *pe_; } } while (0)
#define STORE_REGS() do { \
        _Pragma("unroll") for (int j = 0; j < 4; ++j) { const int i = gt + 256 * j, row = i >> 4, c16 = i & 15; \
            *(LAS v4u*)(QC + row * S_QC + c16 * 8) = pfC[j]; *(LAS v4u*)(KB + row * S_QC + c16 * 8) = pfB[j]; } \
        *(LAS v4u*)(XN + (gt >> 2) * S_X + (gt & 3) * 8) = pfX; \
        if (ssd) { const float sc_ = __expf(fs_l - fs_a) * fs_d; \
            *(LAS v4u*)(XS + (gt >> 2) * S_X + (gt & 3) * 8) = (v4u){pk2(bflo(pfX.x) * sc_, bfhi(pfX.x) * sc_), pk2(bflo(pfX.y) * sc_, bfhi(pfX.y) * sc_), pk2(bflo(pfX.z) * sc_, bfhi(pfX.z) * sc_), pk2(bflo(pfX.w) * sc_, bfhi(pfX.w) * sc_)}; } \
        if (ssd) { if (gt < 64) { ACUM[gt] = fa; DT[gt] = fb; } } else if (gt < 128) DEC[gt] = fa; } while (0)
    { const int gt = tid0 & 255; LOAD_REGS(0); }
    for (int c = 0; c < SEQ / 64; ++c) {
        int tid_v = tid0; asm volatile("" : "+v"(tid_v));
        const int gt = tid_v & 255, lane = tid_v & 63, fr = lane & 15, fq = lane >> 4;
        STORE_REGS();
        __syncthreads();
        { const int cn = (c + 1 < SEQ / 64) ? c + 1 : c; LOAD_REGS(cn); }
        const size_t t0 = rowbase + (size_t)c * 64;
        const float alast = ssd ? ACUM[63] : 0.f;
        for (int idx = w4; idx < 10; idx += 4) { const int tb = (TB_PK >> (2 * idx)) & 3, sb = (SB_PK >> (2 * idx)) & 3; const int t = 16 * tb + fr, s0 = 16 * sb + 4 * fq;
            f32x4 g = (f32x4){0.f, 0.f, 0.f, 0.f};
#pragma unroll
            for (int k0 = 0; k0 < 128; k0 += 32) g = __builtin_amdgcn_mfma_f32_16x16x32_bf16(row_frag(KB, S_QC, 16 * sb + fr, k0 + 8 * fq), row_frag(QC, S_QC, t, k0 + 8 * fq), g, 0, 0, 0);
            float w[4];
            if (ssd) { const float at = ACUM[t]; const f32x4 as = *(const LAS f32x4*)(ACUM + s0), ds = *(const LAS f32x4*)(DT + s0);
#pragma unroll
                for (int j = 0; j < 4; ++j) w[j] = (s0 + j <= t) ? g[j] * __expf(fminf(at - as[j], 0.f)) * ds[j] : 0.f;
            } else {
#pragma unroll
                for (int j = 0; j < 4; ++j) w[j] = (s0 + j <= t) ? g[j] : 0.f;
            }
            *(LAS v2u*)(WT + t * S_WT + s0) = (v2u){pk2(w[0], w[1]), pk2(w[2], w[3])}; }
        __syncthreads();
        { const int t = 16 * w4 + fr; const float rs = ssd ? __expf(ACUM[t]) : 1.f;
            bf16x8 qa[4];
#pragma unroll
            for (int ks = 0; ks < 4; ++ks) qa[ks] = row_frag(QC, S_QC, t, 32 * ks + 8 * fq);
            const bf16x8 wa0 = row_frag(WT, S_WT, t, 8 * fq), wa1 = row_frag(WT, S_WT, t, 32 + 8 * fq);
#pragma unroll
            for (int pb = 0; pb < 2; ++pb) {
                f32x4 y = (f32x4){0.f, 0.f, 0.f, 0.f};
#pragma unroll
                for (int ks = 0; ks < 4; ++ks) y = __builtin_amdgcn_mfma_f32_16x16x32_bf16(row_frag(ST, S_QC, 16 * pb + fr, 32 * ks + 8 * fq), qa[ks], y, 0, 0, 0);
                y = y * rs;
                y = __builtin_amdgcn_mfma_f32_16x16x32_bf16(tr_frag(XN, S_X, 8 * fq, 16 * pb, fr), wa0, y, 0, 0, 0);
                if (w4 >= 2) y = __builtin_amdgcn_mfma_f32_16x16x32_bf16(tr_frag(XN, S_X, 32 + 8 * fq, 16 * pb, fr), wa1, y, 0, 0, 0);
                const int p0 = 16 * pb + 4 * fq;
                if (ssd) { const v2u xw = *(const LAS v2u*)(XN + t * S_X + p0); y[0] += Dh * bflo(xw.x); y[1] += Dh * bfhi(xw.x); y[2] += Dh * bflo(xw.y); y[3] += Dh * bfhi(xw.y); }
                if (!dry) *(v2u*)(PROJ + (t0 + t) * NIN + colX + p0) = (v2u){pk2(y[0], y[1]), pk2(y[2], y[3])};
            } }
        { const float dsc = ssd ? __expf(alast) : 1.f;
#pragma unroll
            for (int q = 0; q < 2; ++q) { const int n0 = 16 * (2 * w4 + q);
                const bf16x8 kb0 = tr_frag(KB, S_QC, 8 * fq, n0, fr), kb1 = tr_frag(KB, S_QC, 32 + 8 * fq, n0, fr);
                f32x4 dv = (f32x4){1.f, 1.f, 1.f, 1.f}; if (!ssd) dv = *(const LAS f32x4*)(DEC + n0 + 4 * fq);
#pragma unroll
                for (int pb = 0; pb < 2; ++pb) { f32x4 a = st[2 * q + pb] * dsc;
                    a = __builtin_amdgcn_mfma_f32_16x16x32_bf16(kb0, tr_frag(XS, S_X, 8 * fq, 16 * pb, fr), a, 0, 0, 0);
                    a = __builtin_amdgcn_mfma_f32_16x16x32_bf16(kb1, tr_frag(XS, S_X, 32 + 8 * fq, 16 * pb, fr), a, 0, 0, 0);
                    st[2 * q + pb] = a * dv; } } }
        __syncthreads();
#pragma unroll
        for (int q = 0; q < 2; ++q)
#pragma unroll
            for (int pb = 0; pb < 2; ++pb) *(LAS v2u*)(ST + (16 * pb + fr) * S_QC + 16 * (2 * w4 + q) + 4 * fq) = (v2u){pk2(st[2 * q + pb][0], st[2 * q + pb][1]), pk2(st[2 * q + pb][2], st[2 * q + pb][3])};
    }
#undef LOAD_REGS
#undef STORE_REGS
    if (!dry) { const int lane = tid0 & 63, fr = lane & 15, fq = lane >> 4;
#pragma unroll
        for (int q = 0; q < 2; ++q)
#pragma unroll
            for (int pb = 0; pb < 2; ++pb) { const int n0 = 16 * (2 * w4 + q) + 4 * fq, p = 16 * pb + fr; const f32x4 v = st[2 * q + pb];
                if (ssd) *(f32x4*)(out + O_SSMP + (((size_t)(b * 16 + h) * 64 + half * 32 + p) * 128 + n0)) = v;
                else {
#pragma unroll
                    for (int j = 0; j < 4; ++j) out[O_HGP + (((size_t)(b * 8 + hd) * 128 + n0 + j) * 128 + vq * 32 + p)] = v[j]; } } }
    __syncthreads();
}
__device__ __forceinline__ void ssd_sample_jobs(int bx, int G, bf16* PROJ, const float* const* in, float* out, LAS unsigned char* lds, int tid, bool dry) {
    const int p4 = tid >> 5, f4 = tid & 31;
    f32x4 nx[4];
    { const int job = bx < DB * 16 ? bx : 0; const size_t sbase = ((size_t)job * 64 + p4) * 128 + 4 * f4;
#pragma unroll
        for (int i = 0; i < 4; ++i) nx[i] = *(const f32x4*)(in[3] + sbase + (size_t)i * 16 * 128); }
    int it = 0;
    for (int job = bx; job < DB * 16; job += G, ++it) {
        const int sb = job >> 4, h = job & 15, g = h >> 2; const size_t row0 = (size_t)TP + 4 * sb;
        LAS float* SX = (LAS float*)(lds + (it & 1) * 8192); LAS float* SBm = SX + 4 * 64; LAS float* SCm = SBm + 4 * 128; LAS float* SDT = SCm + 4 * 128;
        f32x4 hv[4];
#pragma unroll
        for (int i = 0; i < 4; ++i) hv[i] = nx[i];
        const size_t sbase = ((size_t)job * 64 + p4) * 128 + 4 * f4;
        { const int jn = (job + G < DB * 16) ? job + G : job; const size_t nb = ((size_t)jn * 64 + p4) * 128 + 4 * f4;
#pragma unroll
            for (int i = 0; i < 4; ++i) nx[i] = *(const f32x4*)(in[3] + nb + (size_t)i * 16 * 128); }
        if (tid < 320) {
            int col, cc; LAS float* dst; int dstride, di;
            if (tid < 64) { col = C_XM + h * 64 + tid; cc = h * 64 + tid; dst = SX; dstride = 64; di = tid; }
            else if (tid < 192) { col = C_B + g * 128 + (tid - 64); cc = 1024 + g * 128 + (tid - 64); dst = SBm; dstride = 128; di = tid - 64; }
            else { col = C_C + g * 128 + (tid - 192); cc = 1536 + g * 128 + (tid - 192); dst = SCm; dstride = 128; di = tid - 192; }
            float u[7];
#pragma unroll
            for (int j = 0; j < 3; ++j) u[j] = in[2][((size_t)sb * 3 + j) * 2048 + cc];
#pragma unroll
            for (int j = 0; j < 4; ++j) u[3 + j] = bf2f(PROJ[(row0 + j) * NIN + col]);
            const float w0 = in[11][cc], w1 = in[11][2048 + cc], w2 = in[11][4096 + cc], w3 = in[11][6144 + cc], bb = in[12][cc];
#pragma unroll
            for (int t = 0; t < 4; ++t) dst[t * dstride + di] = siluf(bb + w0 * u[t] + w1 * u[t + 1] + w2 * u[t + 2] + w3 * u[t + 3]);
            if (!dry && (tid < 64 || (h & 3) == 0)) {
#pragma unroll
                for (int j = 0; j < 3; ++j) out[O_CONVS + ((size_t)sb * 3 + j) * 2048 + cc] = u[4 + j];
            }
        } else if (tid < 324) { const int t = tid - 320; const float xr = bf2f(PROJ[(row0 + t) * NIN + C_DT + h]) + in[13][h]; SDT[t] = xr > 20.f ? xr : log1pf(__expf(xr)); }
        __syncthreads();
        const float a_neg = -__expf(in[14][h]), Dh = in[15][h];
#pragma unroll
        for (int t = 0; t < 4; ++t) {
            const float dt = SDT[t], dec = __expf(dt * a_neg);
            const f32x4 bv = *(const LAS f32x4*)(SBm + t * 128 + 4 * f4), cv = *(const LAS f32x4*)(SCm + t * 128 + 4 * f4);
#pragma unroll
            for (int i = 0; i < 4; ++i) { const int p = p4 + 16 * i; const float xv = SX[t * 64 + p], xb = dt * xv;
                hv[i] = hv[i] * dec + bv * xb;
                float part = (hv[i][0] * cv[0] + hv[i][1] * cv[1]) + (hv[i][2] * cv[2] + hv[i][3] * cv[3]);
                part += __shfl_xor(part, 1); part += __shfl_xor(part, 2); part += __shfl_xor(part, 4); part += __shfl_xor(part, 8); part += __shfl_xor(part, 16);
                if (f4 == 0 && !dry) PROJ[(row0 + t) * NIN + C_XM + h * 64 + p] = (bf16)f2bf(part + Dh * xv); }
        }
        if (!dry)
#pragma unroll
        for (int i = 0; i < 4; ++i) *(f32x4*)(out + O_SSMS + sbase + (size_t)i * 16 * 128) = hv[i];
    }
    __syncthreads();
}
__device__ __forceinline__ void hgrn_sample_jobs(int bx, int G, bf16* PROJ, const float* const* in, float* out, LAS unsigned char* lds, int tid, bool dry) {
    const int v4 = tid & 31, kq = tid >> 5;
    f32x4 nx[8];
    { const int job = bx < DB * 8 ? bx : 0; const size_t sbase = ((size_t)job * 128 + 8 * kq) * 128 + 4 * v4;
#pragma unroll
        for (int i = 0; i < 8; ++i) nx[i] = *(const f32x4*)(in[4] + sbase + (size_t)i * 128); }
    int it = 0;
    for (int job = bx; job < DB * 8; job += G, ++it) {
        const int sb = job >> 3, hd = job & 7; const size_t row0 = (size_t)TP + 4 * sb;
        LAS float* SQ = (LAS float*)(lds + (it & 1) * 8192); LAS float* SF = SQ + 512; LAS float* SK = SF + 512; LAS float* SV = SK + 512;
        LAS float* PP = (LAS float*)(lds + 16384 + (it & 1) * 32768);
        f32x4 s[8];
#pragma unroll
        for (int i = 0; i < 8; ++i) s[i] = nx[i];
        const size_t sbase = ((size_t)job * 128 + 8 * kq) * 128 + 4 * v4;
        { const int jn = (job + G < DB * 8) ? job + G : job; const size_t nb = ((size_t)jn * 128 + 8 * kq) * 128 + 4 * v4;
#pragma unroll
            for (int i = 0; i < 8; ++i) nx[i] = *(const f32x4*)(in[4] + nb + (size_t)i * 128); }
        if (tid < 128) { const int k = tid; const float lb = sigm(in[18][hd * 128 + k] - in[18][1024 + hd * 128 + k]);
#pragma unroll
            for (int t = 0; t < 4; ++t) { const float frw = bf2f(PROJ[(row0 + t) * NIN + C_F + hd * 128 + k]), q = bf2f(PROJ[(row0 + t) * NIN + C_Q + hd * 128 + k]);
                const float sg = sigm(frw); SF[t * 128 + k] = lb + (1.f - lb) * sg; SK[t * 128 + k] = (1.f - lb) * (1.f - sg); SQ[t * 128 + k] = q; } }
        else if (tid < 256) { const int v = tid - 128;
#pragma unroll
            for (int t = 0; t < 4; ++t) SV[t * 128 + v] = bf2f(PROJ[(row0 + t) * NIN + C_I + hd * 128 + v]); }
        __syncthreads();
#pragma unroll
        for (int t = 0; t < 4; ++t) { const f32x4 vv = *(const LAS f32x4*)(SV + t * 128 + 4 * v4); f32x4 part = (f32x4){0.f, 0.f, 0.f, 0.f};
#pragma unroll
            for (int i = 0; i < 8; ++i) { const float f = SF[t * 128 + 8 * kq + i], kk = SK[t * 128 + 8 * kq + i], q = SQ[t * 128 + 8 * kq + i];
                s[i] = s[i] * f + vv * kk; part += s[i] * q; }
            *(LAS f32x4*)(PP + (t * 16 + kq) * 128 + 4 * v4) = part; }
        if (!dry)
#pragma unroll
        for (int i = 0; i < 8; ++i) *(f32x4*)(out + O_HGS + sbase + (size_t)i * 128) = s[i];
        __syncthreads();
        { const int t = tid >> 7, v = tid & 127; float o = 0.f;
#pragma unroll
            for (int q = 0; q < 16; ++q) o += PP[(t * 16 + q) * 128 + v];
            if (!dry) PROJ[(row0 + t) * NIN + C_I + hd * 128 + v] = (bf16)f2bf(o); }
    }
    __syncthreads();
}
#ifndef MK_N_LAUNCHES
#define MK_N_LAUNCHES 1
#endif
constexpr int NPH = 15;
struct Args { const float* in[29]; float* out; unsigned char* ws; int ph_lo, ph_hi; };
static_assert(sizeof(Args) == 29 * 8 + 8 + 8 + 8, "Args has no padding");

__global__ void __launch_bounds__(NTHR, 2) mk_fwd(Args args) {
    extern __shared__ __attribute__((aligned(16))) unsigned char lds_raw[];
    LAS unsigned char* lds = (LAS unsigned char*)lds_raw;
    volatile LAS unsigned* MISC = (volatile LAS unsigned*)(lds + MISC_OFF);
    const int tid = threadIdx.x, lane = tid & 63, wave = __builtin_amdgcn_readfirstlane(tid >> 6);
    const int G = gridDim.x; const int bx = blockIdx.x; const int vcu = (G % 8 == 0) ? (bx % 8) * (G / 8) + bx / 8 : bx;
    const float* const* in = args.in; float* out = args.out; unsigned char* outb = (unsigned char*)args.out; unsigned char* ws = args.ws;
    for (int u = tid; u < (LDS_BYTES - LDSCTL_OFF) / 4; u += NTHR) ((LAS unsigned*)(lds + LDSCTL_OFF))[u] = 0u;
    __syncthreads();
    const int lo = args.ph_lo, hi = args.ph_hi;
    XcdBarrier bar; bar.bar = (unsigned*)(ws + WS_CTL) + CW_BAR; bar.x = 0; bar.st = nullptr;
    if (hi - lo > 1) bar = xcd_barrier_post((unsigned*)(ws + WS_CTL) + CW_BAR, MISC + 8);
#ifndef PH_MASK
#define PH_MASK 0x7fff
#endif
#define IN(k) ((((PH_MASK) >> (k)) & 1) && lo <= (k) && (k) < hi)
#ifndef DUP_MASK
#define DUP_MASK 0
#endif
#define DUPN(k) ((((DUP_MASK) >> (k)) & 1) ? 2 : 1)
#ifndef TIME_PHASE
#define TIME_PHASE -1
#endif
#ifndef TIME_MULT
#define TIME_MULT 4
#endif
    unsigned long long tp_a = (TIME_PHASE == 0) ? __builtin_amdgcn_s_memrealtime() : 0ull, tp_d = 0;
#define SEAM(k) do { if (IN(k) && IN((k) + 1)) xcd_barrier(bar); \
        if (TIME_PHASE >= 0) { if ((k) + 1 == TIME_PHASE) tp_a = __builtin_amdgcn_s_memrealtime(); if ((k) == TIME_PHASE) tp_d = __builtin_amdgcn_s_memrealtime() - tp_a; } } while (0)
    bf16* PROJ = (bf16*)(ws + WS_PROJ);
    float* Y = out + O_Y;

#define REPS(k) _Pragma("unroll 1") for (int rep_ = DUPN(k) - 1; rep_ >= 0; --rep_)
#define DRY ((rep_ > 0) && (args.ph_hi != 12345))
    if (IN(0)) REPS(0) { p0_prologue(in, outb, ws, lds, vcu, G, wave, lane); } SEAM(0);
    if (IN(1)) REPS(1) { pg8::Gemm g{(const bf16*)(outb + OS_XB), (const bf16*)(outb + OS_W1A), T, NGU, D, D}; pg8::StaticOrder S; S.init(T, NGU, G, bx);
        EpiSwiGLU E{(bf16*)(ws + WS_H)}; pg8::gemm_phase<EpiSwiGLU, pg8::StaticOrder, true, true>(lds, g, S, E); } SEAM(1);
    if (IN(2)) REPS(2) { pg8::Gemm g{(const bf16*)(ws + WS_H), (const bf16*)(outb + OS_W1D), TP, D, FF, FF}; pg8::StaticOrder S; S.init(TP, D, G, bx);
        EpiResid E{in[0], in[1], Y, 0.5f, false}; pg8::gemm_phase<EpiResid, pg8::StaticOrder, true, true>(lds, g, S, E);
        small_gemm<11>((const bf16*)(ws + WS_H), FF, (const bf16*)(outb + OS_W1D), FF, E, lds, bx, G, tid, wave, lane); } SEAM(2);
    if (IN(3)) REPS(3) { ln_phase(Y, (bf16*)(outb + OS_XB), in[8], in[9], vcu, G, wave, lane, DRY); } SEAM(3);
    if (IN(4)) REPS(4) { pg8::Gemm g{(const bf16*)(outb + OS_XB), (const bf16*)(outb + OS_WIN), T, NINP, D, D}; pg8::StaticOrder S; S.init(T, NINP, G, bx);
        EpiBf16N E{PROJ, NIN, NIN}; pg8::gemm_phase<EpiBf16N, pg8::StaticOrder, true, true>(lds, g, S, E); } SEAM(4);
    if (IN(5)) REPS(5) { for (int ci = bx; ci < 256; ci += G) prep_chunk(ci, PROJ, in, out, ws, tid, wave, lane, DRY);
        ssd_sample_jobs(bx, G, PROJ, in, out, lds, tid, DRY); hgrn_sample_jobs(bx, G, PROJ, in, out, lds, tid, DRY); } SEAM(5);
    if (IN(6)) REPS(6) {
        const bool dry = DRY;
#ifndef DRY_SCAN_MASK
#define DRY_SCAN_MASK 7
#endif
        const int smask = (rep_ > 0) ? (DRY_SCAN_MASK) : 7;
        if (smask & 1) for (int pj = bx; pj < 256; pj += G) scan_pair_job(pj, PROJ, out, ws, in, lds, tid, wave, dry);
    } SEAM(6);
    if (IN(7)) REPS(7) { norm_phase(PROJ, in[16], in[19], vcu, G, wave, lane, DRY); } SEAM(7);
    if (IN(8)) REPS(8) { pg8::Gemm g{PROJ + C_XM, (const bf16*)(ws + WS_WMO), TP, D, D, NIN}; pg8::StaticOrder S; S.init(TP, D, G, bx);
        EpiGate<false> E{PROJ + C_GM, PROJ + C_Z, false}; pg8::gemm_phase<EpiGate<false>, pg8::StaticOrder, true, true>(lds, g, S, E);
        small_gemm<4>(PROJ + C_XM, NIN, (const bf16*)(ws + WS_WMO), D, E, lds, bx, G, tid, wave, lane); } SEAM(8);
    if (IN(9)) REPS(9) { pg8::Gemm g{PROJ + C_I, (const bf16*)(ws + WS_WHO), TP, D, D, NIN}; pg8::StaticOrder S; S.init(TP, D, G, bx);
        EpiGate<true> E{PROJ + C_GH, PROJ + C_Z, DRY}; pg8::gemm_phase<EpiGate<true>, pg8::StaticOrder, true, true>(lds, g, S, E);
        small_gemm<4>(PROJ + C_I, NIN, (const bf16*)(ws + WS_WHO), D, E, lds, bx, G, tid, wave, lane); } SEAM(9);
    if (IN(10)) REPS(10) { pg8::Gemm g{PROJ + C_Z, (const bf16*)(ws + WS_WO), TP, D, D, NIN}; pg8::StaticOrder S; S.init(TP, D, G, bx);
        EpiResid E{Y, nullptr, Y, 1.0f, DRY}; pg8::gemm_phase<EpiResid, pg8::StaticOrder, true, true>(lds, g, S, E);
        small_gemm<4>(PROJ + C_Z, NIN, (const bf16*)(ws + WS_WO), D, E, lds, bx, G, tid, wave, lane); } SEAM(10);
    if (IN(11)) REPS(11) { ln_phase(Y, (bf16*)(ws + WS_X2B), in[22], in[23], vcu, G, wave, lane, DRY);
        ffn_weight_items(in[24], in[25], in[26], (bf16*)(ws + WS_W2A), (bf16*)(ws + WS_W2D), (LAS float*)(lds + wave * 16384), vcu * NWAVES + wave, G * NWAVES, lane); } SEAM(11);
    if (IN(12)) REPS(12) { pg8::Gemm g{(const bf16*)(ws + WS_X2B), (const bf16*)(ws + WS_W2A), T, NGU, D, D}; pg8::StaticOrder S; S.init(T, NGU, G, bx);
        EpiSwiGLU E{(bf16*)(ws + WS_H)}; pg8::gemm_phase<EpiSwiGLU, pg8::StaticOrder, true, true>(lds, g, S, E); } SEAM(12);
    if (IN(13)) REPS(13) { pg8::Gemm g{(const bf16*)(ws + WS_H), (const bf16*)(ws + WS_W2D), TP, D, FF, FF}; pg8::StaticOrder S; S.init(TP, D, G, bx);
        EpiResid E{Y, nullptr, Y, 0.5f, DRY}; pg8::gemm_phase<EpiResid, pg8::StaticOrder, true, true>(lds, g, S, E);
        small_gemm<11>((const bf16*)(ws + WS_H), FF, (const bf16*)(ws + WS_W2D), FF, E, lds, bx, G, tid, wave, lane); } SEAM(13);
    if (IN(14)) REPS(14) { ln_phase(Y, nullptr, in[27], in[28], vcu, G, wave, lane, DRY); }
    if (TIME_PHASE >= 0 && bx == 0 && tid == 0) { const unsigned long long te = __builtin_amdgcn_s_memrealtime();
        while (__builtin_amdgcn_s_memrealtime() - te < (unsigned long long)TIME_MULT * tp_d) __builtin_amdgcn_s_sleep(8); }
#undef REPS
#undef DRY
#undef IN
#undef SEAM
}

extern "C" void kernel_launch(void* const* d_in, const int* in_sizes, int n_in, void* d_out, int out_size, void* d_ws, size_t ws_size, hipStream_t stream) {
    static int grid = 0;
    if (grid == 0) {
        if (n_in != 29 || out_size != (int)O_END || ws_size < WS_END2) { fprintf(stderr, "kernel_launch: unexpected shapes (n_in %d, out %d, ws %zu < %zu)\n", n_in, out_size, ws_size, (size_t)WS_END2); grid = -1; return; }
        int dev = 0, cus = 0, per_cu = 0;
        if (hipGetDevice(&dev) != hipSuccess || hipDeviceGetAttribute(&cus, hipDeviceAttributeMultiprocessorCount, dev) != hipSuccess) { grid = -1; return; }
        if (hipFuncSetAttribute((const void*)mk_fwd, hipFuncAttributeMaxDynamicSharedMemorySize, LDS_BYTES) != hipSuccess) { fprintf(stderr, "kernel_launch: hipFuncSetAttribute failed\n"); grid = -1; return; }
        if (hipOccupancyMaxActiveBlocksPerMultiprocessor(&per_cu, (const void*)mk_fwd, NTHR, LDS_BYTES) != hipSuccess || per_cu < 1) { fprintf(stderr, "kernel_launch: occupancy query says %d\n", per_cu); }
        (void)hipGetLastError();
        grid = cus;
    }
    if (grid < 0) return;
    (void)hipMemsetAsync((char*)d_ws + WS_CTL, 0, CTL_ZERO_BYTES, stream);
    Args a{};
    for (int i = 0; i < 29; ++i) a.in[i] = (const float*)d_in[i];
    a.out = (float*)d_out; a.ws = (unsigned char*)d_ws;
    if (MK_N_LAUNCHES == 1) { a.ph_lo = 0; a.ph_hi = NPH; hipLaunchKernelGGL(mk_fwd, dim3(grid), dim3(NTHR), LDS_BYTES, stream, a); }
    else { for (int p = 0; p < NPH; ++p) { a.ph_lo = p; a.ph_hi = p + 1; hipLaunchKernelGGL(mk_fwd, dim3(grid), dim3(NTHR), LDS_BYTES, stream, a); } }
}
```

```cpp
#include <hip/hip_runtime.h>
#include <cstdio>
#include <cstdint>
#define MK_N_LAUNCHES 1
#define DUP_MASK 0
#define DRY_SCAN_MASK 15
#define TIME_PHASE -1
namespace pg8 {
#define PG8_LAS __attribute__((address_space(3)))
typedef unsigned short bf16_t;
typedef short bf16x8 __attribute__((ext_vector_type(8)));
typedef float f32x4 __attribute__((ext_vector_type(4)));
typedef unsigned u32x4 __attribute__((ext_vector_type(4)));
typedef unsigned u32x2 __attribute__((ext_vector_type(2)));
constexpr int BM = 256, BK = 64, HALF = 128, HTB = HALF * BK * 2  , STAGE_BYTES = 8 * HTB, NXCD = 8, WGM = 8;

__host__ __device__ __forceinline__ int lds_byte(int r, int c) { const int st = (r >> 4) * 2 + (c >> 5), rr = r & 15, cc = c & 31, ob = rr * 64 + cc * 2; return st * 1024 + (ob ^ (((ob >> 9) & 1) << 5)); }
__host__ __device__ __forceinline__ void stage_rc(int b, int& R, int& C) { const int st = b / 1024, sb = b % 1024, swz = sb ^ (((sb >> 9) & 1) << 5); R = (st >> 1) * 16 + swz / 64; C = (st & 1) * 32 + (swz % 64) / 2; }
__host__ __device__ __forceinline__ int perm32(int rho) { const int n = rho >> 4, i = rho & 15; return 8 * (i >> 2) + 4 * n + (i & 3); }

struct Unit { int pm, pn; };
struct Gemm { const bf16_t* A; const bf16_t* Bt; int M, N, K, lda; };

struct StaticOrder {
    int nM, nN, nwg, G, c;
    __host__ __device__ void init(int M, int N, int G_, int c_) { nM = M / BM; nN = N / BM; nwg = nM * nN; G = G_; c = c_; }
    __host__ __device__ bool next(int i, Unit& u) const {
        const long L = (long)i * G + c; if (L >= nwg) return false;
        int wgid = (int)L; { const int q = nwg / NXCD, r = nwg % NXCD, xcd = wgid % NXCD, off = wgid / NXCD; wgid = (xcd < r ? xcd * (q + 1) : r * (q + 1) + (xcd - r) * q) + off; }
        const int nig = WGM * nN, gid = wgid / nig, fm = gid * WGM, gsz = (nM - fm) < WGM ? (nM - fm) : WGM;
        u.pm = fm + ((wgid % nig) % gsz); u.pn = (wgid % nig) / gsz; return true;
    }
};

__device__ __forceinline__ unsigned cvt_pk_bf16(float lo, float hi) { unsigned r; asm volatile("v_cvt_pk_bf16_f32 %0, %1, %2" : "=v"(r) : "v"(lo), "v"(hi)); return r; }

template <class Epi, class Sched, bool ALIGN_EPI = false, bool SP2 = false>
__device__ __forceinline__ void gemm_phase(PG8_LAS unsigned char* lds, const Gemm g, const Sched& S, const Epi& E) {
    const int tid = threadIdx.x, wid = __builtin_amdgcn_readfirstlane(tid >> 6), lane = tid & 63, wr = wid >> 2, wc = wid & 3, fr = lane & 15, fq = lane >> 4;
    const int K = g.K, nt = K / BK, lda = g.lda;
    unsigned voffA[2], voffB[2];
#pragma unroll
    for (int i = 0; i < 2; ++i) { int R, C; stage_rc(tid * 16 + i * 8192, R, C); const int Rb = Epi::PERM ? ((R & ~31) + perm32(R & 31)) : R;
        voffA[i] = (unsigned)(R * lda + C) * 2u; voffB[i] = (unsigned)(Rb * K + C) * 2u; }
    const size_t kstep = (size_t)(BK * 2);
    const size_t hstepA = (size_t)HALF * lda * 2, hstepB = (size_t)HALF * K * 2;
    const size_t tstepA = 2 * hstepA, tstepB = 2 * hstepB;
    const unsigned ldsw = (unsigned)wid * 1024u;
    const int aoff = lds_byte(wr * 64 + fr, fq * 8), boff = lds_byte(wc * 32 + fr, fq * 8);
#define PG8_SA(b, h) (((b) * 2 + (h)) * HTB)
#define PG8_SB(b, h) ((4 + (b) * 2 + (h)) * HTB)
#define PG8_STAGE(bufoff, gbase, voff) do { _Pragma("unroll") for (int _i = 0; _i < 2; ++_i) \
        __builtin_amdgcn_global_load_lds((const unsigned*)((const char*)(gbase) + (voff)[_i]), (PG8_LAS unsigned*)(lds + (bufoff) + ldsw + _i * 8192), 16, 0, 0); } while (0)
#define PG8_LDA(dst, b, h) do { _Pragma("unroll") for (int m = 0; m < 4; ++m) _Pragma("unroll") for (int k = 0; k < 2; ++k) dst[m][k] = *(const PG8_LAS bf16x8*)(lds + PG8_SA(b, h) + aoff + m * 2048 + k * 1024); } while (0)
#define PG8_LDB(dst, b, h) do { _Pragma("unroll") for (int n = 0; n < 2; ++n) _Pragma("unroll") for (int k = 0; k < 2; ++k) dst[n][k] = *(const PG8_LAS bf16x8*)(lds + PG8_SB(b, h) + boff + n * 2048 + k * 1024); } while (0)
#define PG8_MMA(ai, bj, At, Bt) do { __builtin_amdgcn_s_setprio(1); _Pragma("unroll") for (int m = 0; m < 4; ++m) _Pragma("unroll") for (int n = 0; n < 2; ++n) _Pragma("unroll") for (int k = 0; k < 2; ++k) \
        acc[ai][bj][m][n] = __builtin_amdgcn_mfma_f32_16x16x32_bf16(Bt[n][k], At[m][k], acc[ai][bj][m][n], 0, 0, 0); __builtin_amdgcn_s_setprio(0); } while (0)
#define PG8_WAIT_V(n) asm volatile("s_waitcnt vmcnt(" #n ")" ::: "memory")
#define PG8_WAIT_L(n) asm volatile("s_waitcnt lgkmcnt(" #n ")" ::: "memory")
#define PG8_BAR __builtin_amdgcn_s_barrier()
#define PG8_SCHED __builtin_amdgcn_sched_barrier(0)
    Unit cur, nxt; int ui = 0;
    if (!S.next(0, cur)) return;
    f32x4 acc[2][2][4][2];
#pragma unroll
    for (int a = 0; a < 2; ++a)
#pragma unroll
        for (int b = 0; b < 2; ++b)
#pragma unroll
            for (int m = 0; m < 4; ++m)
#pragma unroll
                for (int n = 0; n < 2; ++n) acc[a][b][m][n] = (f32x4){0.f, 0.f, 0.f, 0.f};
    bf16x8 At[4][2], B0[2][2], B1[2][2];
    const char* cA = (const char*)g.A + (size_t)cur.pm * tstepA; const char* cB = (const char*)g.Bt + (size_t)cur.pn * tstepB;
    if constexpr (SP2) {
        PG8_STAGE(PG8_SB(0, 0), cB, voffB); PG8_STAGE(PG8_SB(0, 1), cB + hstepB, voffB); PG8_STAGE(PG8_SA(0, 0), cA, voffA); PG8_STAGE(PG8_SA(0, 1), cA + hstepA, voffA);
        if (wr == 1) PG8_BAR;
        PG8_WAIT_V(2); PG8_BAR;
        PG8_STAGE(PG8_SB(1, 0), cB + kstep, voffB); PG8_STAGE(PG8_SA(1, 0), cA + kstep, voffA); PG8_STAGE(PG8_SB(1, 1), cB + hstepB + kstep, voffB);
        PG8_WAIT_V(6); PG8_BAR;
    } else {
        PG8_STAGE(PG8_SB(0, 0), cB, voffB); PG8_STAGE(PG8_SA(0, 0), cA, voffA); PG8_STAGE(PG8_SB(0, 1), cB + hstepB, voffB); PG8_STAGE(PG8_SA(0, 1), cA + hstepA, voffA);
        if (wr == 1) PG8_BAR;
        PG8_WAIT_V(4); PG8_BAR;
        PG8_STAGE(PG8_SB(1, 0), cB + kstep, voffB); PG8_STAGE(PG8_SA(1, 0), cA + kstep, voffA); PG8_STAGE(PG8_SB(1, 1), cB + hstepB + kstep, voffB);
        PG8_WAIT_V(6); PG8_BAR;
    }
    for (;;) {
        const bool has_next = S.next(ui + 1, nxt);
        const char* nA = has_next ? (const char*)g.A + (size_t)nxt.pm * tstepA : cA; const char* nB = has_next ? (const char*)g.Bt + (size_t)nxt.pn * tstepB : cB;
        for (int t = 0; t < nt; t += 2) {
            const bool last = (t == nt - 2);
            const char* a1 = cA + (size_t)(t + 1) * kstep;
            const char* a2 = last ? nA : cA + (size_t)(t + 2) * kstep; const char* b2 = last ? nB : cB + (size_t)(t + 2) * kstep;
            const char* a3 = a2 + kstep; const char* b3 = b2 + kstep;
            if constexpr (SP2) {
            PG8_LDB(B0, 0, 0); PG8_LDB(B1, 0, 1); PG8_SCHED; PG8_LDA(At, 0, 0); PG8_STAGE(PG8_SA(1, 1), a1 + hstepA, voffA);
            PG8_WAIT_V(8); PG8_WAIT_L(0); PG8_BAR; PG8_MMA(0, 0, At, B0); PG8_MMA(0, 1, At, B1); PG8_BAR; PG8_SCHED;
            PG8_LDA(At, 0, 1); PG8_STAGE(PG8_SB(0, 0), b2, voffB); PG8_STAGE(PG8_SB(0, 1), b2 + hstepB, voffB); PG8_STAGE(PG8_SA(0, 0), a2, voffA);
            PG8_WAIT_V(8); PG8_WAIT_L(0); PG8_BAR; PG8_MMA(1, 0, At, B0); PG8_MMA(1, 1, At, B1); PG8_BAR; PG8_SCHED;
            PG8_LDB(B0, 1, 0); PG8_LDB(B1, 1, 1); PG8_SCHED; PG8_LDA(At, 1, 0); PG8_STAGE(PG8_SA(0, 1), a2 + hstepA, voffA);
            PG8_WAIT_V(8); PG8_WAIT_L(0); PG8_BAR; PG8_MMA(0, 0, At, B0); PG8_MMA(0, 1, At, B1); PG8_BAR; PG8_SCHED;
            PG8_LDA(At, 1, 1); PG8_STAGE(PG8_SB(1, 0), b3, voffB); PG8_STAGE(PG8_SB(1, 1), b3 + hstepB, voffB); PG8_STAGE(PG8_SA(1, 0), a3, voffA);
            PG8_WAIT_V(8); PG8_WAIT_L(0); PG8_BAR; PG8_MMA(1, 0, At, B0); PG8_MMA(1, 1, At, B1); PG8_BAR; PG8_SCHED;
            } else {
            PG8_LDB(B0, 0, 0); PG8_SCHED; PG8_LDA(At, 0, 0); PG8_STAGE(PG8_SA(1, 1), a1 + hstepA, voffA);
            PG8_WAIT_L(8); PG8_BAR; PG8_WAIT_L(0); PG8_MMA(0, 0, At, B0); PG8_BAR; PG8_SCHED;
            PG8_LDB(B1, 0, 1); PG8_STAGE(PG8_SB(0, 0), b2, voffB);
            PG8_BAR; PG8_WAIT_L(0); PG8_MMA(0, 1, At, B1); PG8_BAR;
            PG8_LDA(At, 0, 1); PG8_STAGE(PG8_SA(0, 0), a2, voffA);
            PG8_BAR; PG8_WAIT_L(0); PG8_MMA(1, 0, At, B0); PG8_BAR; PG8_SCHED;
            PG8_STAGE(PG8_SB(0, 1), b2 + hstepB, voffB);
            PG8_WAIT_V(6); PG8_BAR; PG8_MMA(1, 1, At, B1); PG8_BAR;
            PG8_LDB(B0, 1, 0); PG8_SCHED; PG8_LDA(At, 1, 0); PG8_STAGE(PG8_SA(0, 1), a2 + hstepA, voffA);
            PG8_WAIT_L(8); PG8_BAR; PG8_WAIT_L(0); PG8_MMA(0, 0, At, B0); PG8_BAR; PG8_SCHED;
            PG8_LDB(B1, 1, 1); PG8_STAGE(PG8_SB(1, 0), b3, voffB);
            PG8_BAR; PG8_WAIT_L(0); PG8_MMA(0, 1, At, B1); PG8_BAR;
            PG8_LDA(At, 1, 1); PG8_STAGE(PG8_SA(1, 0), a3, voffA);
            PG8_BAR; PG8_WAIT_L(0); PG8_MMA(1, 0, At, B0); PG8_BAR; PG8_SCHED;
            PG8_STAGE(PG8_SB(1, 1), b3 + hstepB, voffB);
            PG8_WAIT_V(6); PG8_BAR; PG8_MMA(1, 1, At, B1); PG8_BAR;
            }
        }
        if constexpr (ALIGN_EPI) { if (wr == 0) PG8_BAR; }
        E(acc, cur, wr, wc, fr, fq);
        if (!has_next) break;
#pragma unroll
        for (int a = 0; a < 2; ++a)
#pragma unroll
            for (int b = 0; b < 2; ++b)
#pragma unroll
                for (int m = 0; m < 4; ++m)
#pragma unroll
                    for (int n = 0; n < 2; ++n) acc[a][b][m][n] = (f32x4){0.f, 0.f, 0.f, 0.f};
        cur = nxt; cA = nA; cB = nB; ++ui;
        if constexpr (ALIGN_EPI) { if (wr == 1) PG8_BAR; }
    }
    PG8_WAIT_V(0);
    if constexpr (!ALIGN_EPI) { if (wr == 0) PG8_BAR; }
    PG8_BAR;
#undef PG8_SA
#undef PG8_SB
#undef PG8_STAGE
#undef PG8_LDA
#undef PG8_LDB
#undef PG8_MMA
#undef PG8_WAIT_V
#undef PG8_WAIT_L
#undef PG8_BAR
#undef PG8_SCHED
}
}
#define GAS __attribute__((address_space(1)))
#define LAS __attribute__((address_space(3)))
typedef unsigned short bf16;
typedef unsigned v4u __attribute__((ext_vector_type(4)));
typedef unsigned v2u __attribute__((ext_vector_type(2)));
typedef float f32x4 __attribute__((ext_vector_type(4)));
typedef short bf16x8 __attribute__((ext_vector_type(8)));
typedef GAS unsigned gu32;
#define RLX_AGENT __ATOMIC_RELAXED, __HIP_MEMORY_SCOPE_AGENT
#define LDS_WAIT() asm volatile("s_waitcnt lgkmcnt(0)" ::: "memory")
#define VM_WAIT() asm volatile("s_waitcnt vmcnt(0)" ::: "memory")

constexpr int NWAVES = 8, NTHR = 512;
constexpr int T = 16896, TP = 16384, D = 1024, FF = 2816, NGU = 2 * FF, NIN = 9232, NINP = 9472;
constexpr int SEQ = 2048, NB = 8, DB = 128, DSEQ = 4;
constexpr float ALPHA = 1.189207115002721f, EPS = 1e-5f;
constexpr int C_Z = 0, C_XM = 1024, C_B = 2048, C_C = 2560, C_Q = 3072, C_F = 4096, C_I = 5120, C_OG = 6144, C_GM = 7168, C_GH = 8192, C_DT = 9216;
constexpr size_t O_Y = 0, O_CONVP = 17301504, O_SSMP = 17350656, O_HGP = 18399232, O_CONVS = 19447808, O_SSMS = 20234240, O_HGS = 37011456, O_END = 53788672;
constexpr size_t MiB = 1u << 20;
constexpr size_t OS_XB = O_SSMS * 4, OS_W1A = O_SSMS * 4 + 36 * MiB, OS_W1D = O_SSMS * 4 + 48 * MiB, OS_WIN = O_HGS * 4;
constexpr size_t WS_CTL = 0, CTL_ZERO_BYTES = 64 * 1024, WS_WMO = 1 * MiB, WS_WHO = 3 * MiB, WS_WO = 5 * MiB, WS_B = 8 * MiB;
constexpr size_t WS_PROJ = WS_B, WS_X2B = WS_B, WS_W2A = WS_B + 36 * MiB, WS_W2D = WS_B + 48 * MiB, WS_H = WS_B + 64 * MiB;
constexpr size_t WS_END = WS_B + (size_t)T * NIN * 2;
static_assert(WS_H + (size_t)T * FF * 2 <= WS_END, "H fits region B");
constexpr int CW_BAR = 1024;
constexpr int RING_BYTES = 131072, LDSCTL_OFF = RING_BYTES, MISC_OFF = LDSCTL_OFF + 320, LDS_BYTES = 147456;

__device__ __forceinline__ unsigned f2bf(float f) { unsigned u = __builtin_bit_cast(unsigned, f); return (u + 0x7fffu + ((u >> 16) & 1u)) >> 16; }
__device__ __forceinline__ unsigned pk2(float lo, float hi) { return f2bf(lo) | (f2bf(hi) << 16); }
__device__ __forceinline__ float bf2f(unsigned u16) { return __builtin_bit_cast(float, u16 << 16); }
__device__ __forceinline__ float bflo(unsigned w) { return __builtin_bit_cast(float, w << 16); }
__device__ __forceinline__ float bfhi(unsigned w) { return __builtin_bit_cast(float, w & 0xffff0000u); }
__device__ __forceinline__ float sigm(float x) { return __builtin_amdgcn_rcpf(1.f + __expf(-x)); }
__device__ __forceinline__ float siluf(float x) { return x * sigm(x); }
__device__ __forceinline__ float wave_sum(float v) {
#pragma unroll
    for (int o = 1; o < 64; o <<= 1) v += __shfl_xor(v, o);
    return v;
}

#define XB_TMO      128
#define XB_XCNT(j)  (256  + 64 * (j))
#define XB_XSUB(j)  (1280 + 64 * (j))
#define XB_XGEN(j)  (2304 + 64 * (j))
#define XB_TOP      3328
#define XB_TOPGEN   3392
#define XCD_BAR_WORDS 3456
#define XB_SPIN_CAP (1u << 20)
__device__ __forceinline__ unsigned xb_ld(unsigned* p)              { return __hip_atomic_load(p, __ATOMIC_RELAXED, __HIP_MEMORY_SCOPE_AGENT); }
__device__ __forceinline__ unsigned xb_add(unsigned* p, unsigned v) { return __hip_atomic_fetch_add(p, v, __ATOMIC_RELAXED, __HIP_MEMORY_SCOPE_AGENT); }
__device__ __forceinline__ unsigned xb_xcc_id() { return (unsigned)__builtin_amdgcn_s_getreg((3 << 11) | 20) & 0xFu; }
#define XB_SPIN(cond, bar) do { unsigned _sp = 0; while (cond) { __builtin_amdgcn_s_sleep(1); \
    if ((++_sp & 255u) == 0u) { if (xb_ld(&(bar)[XB_TMO])) break; if (_sp > XB_SPIN_CAP) { atomicAdd(&(bar)[XB_TMO], 1u); break; } } } } while (0)
struct XcdBarrier { unsigned* bar; unsigned x; volatile LAS unsigned* st; };
__device__ __forceinline__ XcdBarrier xcd_barrier_post(unsigned* bar, volatile LAS unsigned* st) {
    XcdBarrier b; b.bar = bar; b.x = xb_xcc_id(); b.st = st;
    if (threadIdx.x == 0) (void)xb_add(&bar[XB_XCNT(b.x)], 1u);
    return b;
}
__device__ __forceinline__ void xcd_barrier_complete(unsigned* bar, unsigned x, unsigned& nloc, unsigned& nx) {
    const unsigned G = gridDim.x * gridDim.y * gridDim.z;
    unsigned sum, cnt, mine, sp = 0u;
    for (;;) {
        sum = 0u; cnt = 0u; mine = 0u;
#pragma unroll
        for (unsigned j = 0; j < 16; ++j) { const unsigned c = xb_ld(&bar[XB_XCNT(j)]); sum += c; cnt += (c > 0u) ? 1u : 0u; mine = (j == x) ? c : mine; }
        if (sum == G) break;
        __builtin_amdgcn_s_sleep(1);
        if ((++sp & 255u) == 0u) { if (xb_ld(&bar[XB_TMO])) break; if (sp > XB_SPIN_CAP) { atomicAdd(&bar[XB_TMO], 1u); break; } }
    }
    nloc = mine > 0u ? mine : 1u; nx = cnt > 0u ? cnt : 1u;
}
__device__ __forceinline__ void xcd_barrier(const XcdBarrier& b) {
    asm volatile("s_waitcnt vmcnt(0)" ::: "memory");
    __syncthreads();
    if (threadIdx.x == 0) {
        unsigned* bar = b.bar;
        __builtin_amdgcn_s_waitcnt(0);
        unsigned nloc = b.st[0], nx = b.st[1];
        if (nloc == 0u) { xcd_barrier_complete(bar, b.x, nloc, nx); b.st[0] = nloc; b.st[1] = nx; }
        const unsigned old = xb_add(&bar[XB_XSUB(b.x)], 1u);
        const unsigned gen = old / nloc;
        if (old + 1u == (gen + 1u) * nloc) {
            __builtin_amdgcn_fence(__ATOMIC_RELEASE, "agent");
            asm volatile("s_waitcnt vmcnt(0)" ::: "memory");
            const unsigned og = xb_add(&bar[XB_TOP], 1u);
            const unsigned tg = og / nx;
            if (og + 1u == (tg + 1u) * nx) xb_add(&bar[XB_TOPGEN], 1u);
            else XB_SPIN(xb_ld(&bar[XB_TOPGEN]) == tg, bar);
            __builtin_amdgcn_fence(__ATOMIC_ACQUIRE, "agent");
            xb_add(&bar[XB_XGEN(b.x)], 1u);
            asm volatile("s_waitcnt vmcnt(0)" ::: "memory");
        } else {
            XB_SPIN(xb_ld(&bar[XB_XGEN(b.x)]) == gen, bar);
            __builtin_amdgcn_fence(__ATOMIC_ACQUIRE, "agent");
            asm volatile("s_waitcnt vmcnt(0)" ::: "memory");
        }
    }
    __syncthreads();
}

using pg8::Unit;
struct EpiSwiGLU {
    static constexpr bool PERM = true;
    bf16* H;
    __device__ __forceinline__ void operator()(const f32x4 (&acc)[2][2][4][2], const Unit& u, int wr, int wc, int fr, int fq) const {
        const int row0 = u.pm * 256 + wr * 64 + fr, col0 = u.pn * 128 + wc * 32 + 8 * fq;
#pragma unroll
        for (int ai = 0; ai < 2; ++ai)
#pragma unroll
            for (int m = 0; m < 4; ++m) {
                const f32x4 g0 = acc[ai][0][m][0], g1 = acc[ai][0][m][1], u0 = acc[ai][1][m][0], u1 = acc[ai][1][m][1];
                v4u w;
                w.x = pg8::cvt_pk_bf16(siluf(g0[0]) * u0[0], siluf(g0[1]) * u0[1]); w.y = pg8::cvt_pk_bf16(siluf(g0[2]) * u0[2], siluf(g0[3]) * u0[3]);
                w.z = pg8::cvt_pk_bf16(siluf(g1[0]) * u1[0], siluf(g1[1]) * u1[1]); w.w = pg8::cvt_pk_bf16(siluf(g1[2]) * u1[2], siluf(g1[3]) * u1[3]);
                *(v4u*)(H + (size_t)(row0 + ai * 128 + m * 16) * FF + col0) = w;
            }
    }
};
struct EpiBf16N {
    static constexpr bool PERM = true;
    bf16* O; int ldc, ncols;
    __device__ __forceinline__ void operator()(const f32x4 (&acc)[2][2][4][2], const Unit& u, int wr, int wc, int fr, int fq) const {
        const int row0 = u.pm * 256 + wr * 64 + fr, col0 = u.pn * 256 + wc * 32 + 8 * fq;
#pragma unroll
        for (int ai = 0; ai < 2; ++ai)
#pragma unroll
            for (int m = 0; m < 4; ++m) { bf16* rowp = O + (size_t)(row0 + ai * 128 + m * 16) * ldc + col0;
#pragma unroll
                for (int bj = 0; bj < 2; ++bj) { const f32x4 v0 = acc[ai][bj][m][0], v1 = acc[ai][bj][m][1];
                    v4u w; w.x = pg8::cvt_pk_bf16(v0[0], v0[1]); w.y = pg8::cvt_pk_bf16(v0[2], v0[3]); w.z = pg8::cvt_pk_bf16(v1[0], v1[1]); w.w = pg8::cvt_pk_bf16(v1[2], v1[3]);
                    if (col0 + bj * 128 < ncols) *(v4u*)(rowp + bj * 128) = w; } }
    }
};
struct EpiResid {
    static constexpr bool PERM = false;
    const float* res; const float* res2; float* out; float s; bool dry;
    __device__ __forceinline__ void operator()(const f32x4 (&acc)[2][2][4][2], const Unit& u, int wr, int wc, int fr, int fq) const {
        const int row0 = u.pm * 256 + wr * 64 + fr, col0 = u.pn * 256 + wc * 32 + 4 * fq;
        const float* rb = (res2 != nullptr && u.pm >= TP / 256) ? res2 - (size_t)TP * D : res;
#pragma unroll
        for (int ai = 0; ai < 2; ++ai)
#pragma unroll
            for (int m = 0; m < 4; ++m) { const size_t off = (size_t)(row0 + ai * 128 + m * 16) * D + col0;
#pragma unroll
                for (int bj = 0; bj < 2; ++bj)
#pragma unroll
                    for (int n = 0; n < 2; ++n) { const f32x4 r = *(const f32x4*)(rb + off + bj * 128 + n * 16);
                        if (!dry) *(f32x4*)(out + off + bj * 128 + n * 16) = r * ALPHA + acc[ai][bj][m][n] * s; } }
    }
    __device__ __forceinline__ void small(int row, int col, const f32x4 v) const {
        const float* rb = (res2 != nullptr && row >= TP) ? res2 - (size_t)TP * D : res; const size_t off = (size_t)row * D + col;
        const f32x4 r = *(const f32x4*)(rb + off); if (!dry) *(f32x4*)(out + off) = r * ALPHA + v * s;
    }
};
template <bool ADD> struct EpiGate {
    static constexpr bool PERM = true;
    const bf16* gate; bf16* dst; bool dry;
    __device__ __forceinline__ void operator()(const f32x4 (&acc)[2][2][4][2], const Unit& u, int wr, int wc, int fr, int fq) const {
        const int row0 = u.pm * 256 + wr * 64 + fr, col0 = u.pn * 256 + wc * 32 + 8 * fq;
#pragma unroll
        for (int ai = 0; ai < 2; ++ai)
#pragma unroll
            for (int m = 0; m < 4; ++m) { const size_t off = (size_t)(row0 + ai * 128 + m * 16) * NIN + col0;
#pragma unroll
                for (int bj = 0; bj < 2; ++bj) { const f32x4 v0 = acc[ai][bj][m][0], v1 = acc[ai][bj][m][1];
                    const v4u gw = *(const v4u*)(gate + off + bj * 128);
                    float r[8] = { sigm(bflo(gw.x)) * v0[0], sigm(bfhi(gw.x)) * v0[1], sigm(bflo(gw.y)) * v0[2], sigm(bfhi(gw.y)) * v0[3],
                                   sigm(bflo(gw.z)) * v1[0], sigm(bfhi(gw.z)) * v1[1], sigm(bflo(gw.w)) * v1[2], sigm(bfhi(gw.w)) * v1[3] };
                    if (ADD) { const v4u dw = *(const v4u*)(dst + off + bj * 128);
                        r[0] += bflo(dw.x); r[1] += bfhi(dw.x); r[2] += bflo(dw.y); r[3] += bfhi(dw.y); r[4] += bflo(dw.z); r[5] += bfhi(dw.z); r[6] += bflo(dw.w); r[7] += bfhi(dw.w); }
                    v4u w; w.x = pg8::cvt_pk_bf16(r[0], r[1]); w.y = pg8::cvt_pk_bf16(r[2], r[3]); w.z = pg8::cvt_pk_bf16(r[4], r[5]); w.w = pg8::cvt_pk_bf16(r[6], r[7]);
                    if (!dry) *(v4u*)(dst + off + bj * 128) = w; } }
    }
    __device__ __forceinline__ void small(int row, int col, const f32x4 v) const {
        const size_t off = (size_t)row * NIN + col; const v2u gw = *(const v2u*)(gate + off);
        float r[4] = { sigm(bflo(gw.x)) * v[0], sigm(bfhi(gw.x)) * v[1], sigm(bflo(gw.y)) * v[2], sigm(bfhi(gw.y)) * v[3] };
        if (ADD) { const v2u dw = *(const v2u*)(dst + off); r[0] += bflo(dw.x); r[1] += bfhi(dw.x); r[2] += bflo(dw.y); r[3] += bfhi(dw.y); }
        if (!dry) *(v2u*)(dst + off) = (v2u){pg8::cvt_pk_bf16(r[0], r[1]), pg8::cvt_pk_bf16(r[2], r[3])};
    }
};

template <int KS  , class Epi>
__device__ __forceinline__ void small_gemm(const bf16* A, int lda, const bf16* Bt, int K, const Epi& E, LAS unsigned char* lds, int bx, int G, int tid, int wave, int lane) {
    const int fr = lane & 15, fq = lane >> 4;
    LAS float* red = (LAS float*)lds;
    for (int u = bx; u < 256; u += G) {
        const int r0 = TP + 32 * (u >> 4), c0 = 64 * (u & 15);
        f32x4 acc[2][4];
#pragma unroll
        for (int m = 0; m < 2; ++m)
#pragma unroll
            for (int n = 0; n < 4; ++n) acc[m][n] = (f32x4){0.f, 0.f, 0.f, 0.f};
        const bf16* pa = A + (size_t)(r0 + fr) * lda + wave * (KS * 32) + 8 * fq; const bf16* pb = Bt + (size_t)(c0 + fr) * K + wave * (KS * 32) + 8 * fq;
#pragma unroll 4
        for (int ks = 0; ks < KS; ++ks) {
            bf16x8 a[2], b[4];
#pragma unroll
            for (int m = 0; m < 2; ++m) a[m] = *(const bf16x8*)(pa + (size_t)(16 * m) * lda + 32 * ks);
#pragma unroll
            for (int n = 0; n < 4; ++n) b[n] = *(const bf16x8*)(pb + (size_t)(16 * n) * K + 32 * ks);
#pragma unroll
            for (int m = 0; m < 2; ++m)
#pragma unroll
                for (int n = 0; n < 4; ++n) acc[m][n] = __builtin_amdgcn_mfma_f32_16x16x32_bf16(b[n], a[m], acc[m][n], 0, 0, 0);
        }
#pragma unroll
        for (int m = 0; m < 2; ++m)
#pragma unroll
            for (int n = 0; n < 4; ++n) *(LAS f32x4*)(red + (wave * 32 + 16 * m + fr) * 64 + 16 * n + 4 * fq) = acc[m][n];
        __syncthreads();
        { const int row = tid >> 4, col = (tid & 15) * 4; f32x4 v = (f32x4){0.f, 0.f, 0.f, 0.f};
#pragma unroll
            for (int w = 0; w < 8; ++w) v += *(const LAS f32x4*)(red + (w * 32 + row) * 64 + col);
            E.small(r0 + row, c0 + col, v); }
        __syncthreads();
    }
}
__device__ __forceinline__ void transpose_item(const float* W, int ldw, int srccol0, int ncopy, bf16* WT, int dstrow0, int K, int k0, LAS float* scr, int lane) {
    { const int n4 = (lane & 7) * 4, kr = lane >> 3; f32x4 v[8];
#pragma unroll
        for (int i = 0; i < 8; ++i) v[i] = (n4 < ncopy) ? *(const f32x4*)(W + (size_t)(k0 + 8 * i + kr) * ldw + srccol0 + n4) : (f32x4){0.f, 0.f, 0.f, 0.f};
#pragma unroll
        for (int i = 0; i < 8; ++i) { LAS float* d = scr + (8 * i + kr) * 33 + n4; d[0] = v[i][0]; d[1] = v[i][1]; d[2] = v[i][2]; d[3] = v[i][3]; } }
    LDS_WAIT(); asm volatile("" ::: "memory");
    const int c = lane & 7;
#pragma unroll
    for (int j = 0; j < 4; ++j) { const int n = (lane >> 3) + 8 * j; const LAS float* s = scr + (8 * c) * 33 + n;
        v4u o; o.x = pk2(s[0 * 33], s[1 * 33]); o.y = pk2(s[2 * 33], s[3 * 33]); o.z = pk2(s[4 * 33], s[5 * 33]); o.w = pk2(s[6 * 33], s[7 * 33]);
        *(v4u*)(WT + (size_t)(dstrow0 + n) * K + k0 + 8 * c) = o; }
    LDS_WAIT(); asm volatile("" ::: "memory");
}
__device__ __forceinline__ void ffn_weight_items(const float* Wg, const float* Wu, const float* Wd, bf16* WA, bf16* WD, LAS float* scr, int gw, int NGW, int lane) {
    constexpr int I_A = (NGU / 32) * (D / 64), I_D = (D / 32) * (FF / 64);
    for (int it = gw; it < I_A + I_D; it += NGW) {
        if (it < I_A) { const int gi = it / (D / 64), kb = it % (D / 64), n0 = 32 * gi, pn = n0 >> 8, bj = (n0 >> 7) & 1, i0 = n0 & 127;
            transpose_item(bj ? Wu : Wg, FF, 128 * pn + i0, 32, WA, n0, D, 64 * kb, scr, lane); }
        else { const int r = it - I_A, gi = r / (FF / 64), kb = r % (FF / 64);
            transpose_item(Wd, D, 32 * gi, 32, WD, 32 * gi, FF, 64 * kb, scr, lane); }
    }
}
__device__ __forceinline__ void p0_prologue(const float* const* in, unsigned char* outb, unsigned char* ws, LAS unsigned char* lds, int vcu, int G, int wave, int lane) {
    LAS float* scr = (LAS float*)(lds + wave * 16384);
    const int gw = vcu * NWAVES + wave, NGW = G * NWAVES;
    ffn_weight_items(in[5], in[6], in[7], (bf16*)(outb + OS_W1A), (bf16*)(outb + OS_W1D), scr, gw, NGW, lane);
    constexpr int I_IN = (NINP / 32) * (D / 64), I_SQ = (D / 32) * (D / 64);
    for (int it = gw; it < I_IN + 3 * I_SQ; it += NGW) {
        if (it < I_IN) { const int gi = it / (D / 64), kb = it % (D / 64), n0 = 32 * gi;
            int src, ncopy;
            if (n0 < 3072) { src = n0; ncopy = 32; } else if (n0 < C_DT) { src = n0 + 16; ncopy = 32; } else if (n0 == C_DT) { src = 3072; ncopy = 16; } else { src = 0; ncopy = 0; }
            transpose_item(in[10], NIN, src, ncopy, (bf16*)(outb + OS_WIN), n0, D, 64 * kb, scr, lane); }
        else { const int r = it - I_IN, w = r / I_SQ, r2 = r % I_SQ, gi = r2 / (D / 64), kb = r2 % (D / 64);
            const float* W = in[w == 0 ? 17 : (w == 1 ? 20 : 21)]; bf16* WT = (bf16*)(ws + (w == 0 ? WS_WMO : (w == 1 ? WS_WHO : WS_WO)));
            transpose_item(W, D, 32 * gi, 32, WT, 32 * gi, D, 64 * kb, scr, lane); }
    }
    bf16* XB = (bf16*)(outb + OS_XB);
    const size_t n8 = (size_t)T * D / 8, nthr = (size_t)G * NTHR;
    for (size_t i0 = (size_t)vcu * NTHR + threadIdx.x; i0 < n8; i0 += 4 * nthr) {
        f32x4 a[4], b[4];
#pragma unroll
        for (int u = 0; u < 4; ++u) { const size_t i = i0 + u * nthr; if (i < n8) { const size_t e = i * 8; const float* src = (e < (size_t)TP * D) ? in[0] + e : in[1] + (e - (size_t)TP * D);
            a[u] = *(const f32x4*)src; b[u] = *(const f32x4*)(src + 4); } }
#pragma unroll
        for (int u = 0; u < 4; ++u) { const size_t i = i0 + u * nthr; if (i < n8) { v4u w; w.x = pk2(a[u][0], a[u][1]); w.y = pk2(a[u][2], a[u][3]); w.z = pk2(b[u][0], b[u][1]); w.w = pk2(b[u][2], b[u][3]);
            *(v4u*)(XB + i * 8) = w; } }
    }
}
__device__ __forceinline__ void ln_phase(float* X, bf16* XBo, const float* gam, const float* bet, int vcu, int G, int wave, int lane, bool dry) {
    const int gw = vcu * NWAVES + wave, NGW = G * NWAVES;
    f32x4 gv[4], bv[4];
#pragma unroll
    for (int j = 0; j < 4; ++j) { gv[j] = *(const f32x4*)(gam + 4 * lane + 256 * j); bv[j] = *(const f32x4*)(bet + 4 * lane + 256 * j); }
    f32x4 nx[4];
    { const int m0 = gw < T ? gw : 0;
#pragma unroll
        for (int j = 0; j < 4; ++j) nx[j] = ((const f32x4*)(X + (size_t)m0 * D) + lane)[64 * j]; }
    for (int m = gw; m < T; m += NGW) {
        f32x4* xr = (f32x4*)(X + (size_t)m * D) + lane;
        f32x4 v[4]; float s = 0.f;
#pragma unroll
        for (int j = 0; j < 4; ++j) v[j] = nx[j];
        { const int mn = (m + NGW < T) ? m + NGW : m;
#pragma unroll
            for (int j = 0; j < 4; ++j) nx[j] = ((const f32x4*)(X + (size_t)mn * D) + lane)[64 * j]; }
#pragma unroll
        for (int j = 0; j < 4; ++j) s += (v[j][0] + v[j][1]) + (v[j][2] + v[j][3]);
        const float mean = wave_sum(s) * (1.f / D); float s2 = 0.f;
#pragma unroll
        for (int j = 0; j < 4; ++j) { v[j] = v[j] - mean; s2 += (v[j][0] * v[j][0] + v[j][1] * v[j][1]) + (v[j][2] * v[j][2] + v[j][3] * v[j][3]); }
        const float rstd = 1.f / sqrtf(wave_sum(s2) * (1.f / D) + EPS);
#pragma unroll
        for (int j = 0; j < 4; ++j) { const f32x4 o = v[j] * rstd * gv[j] + bv[j]; if (dry) continue; xr[64 * j] = o;
            if (XBo) { v2u w; w.x = pk2(o[0], o[1]); w.y = pk2(o[2], o[3]); *((v2u*)(XBo + (size_t)m * D) + lane + 64 * j) = w; } }
    }
}
__device__ __forceinline__ void norm_phase(bf16* PROJ, const float* mw, const float* hw, int vcu, int G, int wave, int lane, bool dry) {
    const int gw = vcu * NWAVES + wave, NGW = G * NWAVES;
    float mwv[16], hwv[16];
#pragma unroll
    for (int j = 0; j < 16; ++j) { mwv[j] = mw[16 * lane + j]; hwv[j] = hw[16 * lane + j]; }
    v4u nx[8];
#define NORM_LOAD(m_) do { const bf16* r_ = PROJ + (size_t)(m_) * NIN + 16 * lane; nx[0] = *(const v4u*)(r_ + C_XM); nx[1] = *(const v4u*)(r_ + C_XM + 8); nx[2] = *(const v4u*)(r_ + C_Z); nx[3] = *(const v4u*)(r_ + C_Z + 8); \
        nx[4] = *(const v4u*)(r_ + C_I); nx[5] = *(const v4u*)(r_ + C_I + 8); nx[6] = *(const v4u*)(r_ + C_OG); nx[7] = *(const v4u*)(r_ + C_OG + 8); } while (0)
    { const int m0 = gw < T ? gw : 0; NORM_LOAD(m0); }
    for (int m = gw; m < T; m += NGW) {
        bf16* row = PROJ + (size_t)m * NIN;
        const v4u y0 = nx[0], y1 = nx[1], z0 = nx[2], z1 = nx[3], o0 = nx[4], o1 = nx[5], g0 = nx[6], g1 = nx[7];
        { const int mn = (m + NGW < T) ? m + NGW : m; NORM_LOAD(mn); }
        float a[16], b[16];
        const unsigned yw[8] = {y0.x, y0.y, y0.z, y0.w, y1.x, y1.y, y1.z, y1.w}, zw[8] = {z0.x, z0.y, z0.z, z0.w, z1.x, z1.y, z1.z, z1.w};
        const unsigned ow[8] = {o0.x, o0.y, o0.z, o0.w, o1.x, o1.y, o1.z, o1.w}, gww[8] = {g0.x, g0.y, g0.z, g0.w, g1.x, g1.y, g1.z, g1.w};
        float sa = 0.f, sb = 0.f;
#pragma unroll
        for (int j = 0; j < 8; ++j) {
            a[2 * j] = bflo(yw[j]) * siluf(bflo(zw[j])); a[2 * j + 1] = bfhi(yw[j]) * siluf(bfhi(zw[j]));
            b[2 * j] = bflo(ow[j]); b[2 * j + 1] = bfhi(ow[j]);
            sa += a[2 * j] * a[2 * j] + a[2 * j + 1] * a[2 * j + 1]; sb += b[2 * j] * b[2 * j] + b[2 * j + 1] * b[2 * j + 1];
        }
        sb += __shfl_xor(sb, 1); sb += __shfl_xor(sb, 2); sb += __shfl_xor(sb, 4);
        sa += __shfl_xor(sa, 1); sa += __shfl_xor(sa, 2); sa += __shfl_xor(sa, 4); sa += __shfl_xor(sa, 8);
        const float ra = 1.f / sqrtf(sa * (1.f / 256.f) + EPS), rb = 1.f / sqrtf(sb * (1.f / 128.f) + EPS);
        unsigned wa[8], wb[8];
#pragma unroll
        for (int j = 0; j < 8; ++j) {
            wa[j] = pk2(a[2 * j] * ra * mwv[2 * j], a[2 * j + 1] * ra * mwv[2 * j + 1]);
            wb[j] = pk2(b[2 * j] * rb * hwv[2 * j] * siluf(bflo(gww[j])), b[2 * j + 1] * rb * hwv[2 * j + 1] * siluf(bfhi(gww[j])));
        }
        if (dry) continue;
        *(v4u*)(row + C_XM + 16 * lane) = (v4u){wa[0], wa[1], wa[2], wa[3]}; *(v4u*)(row + C_XM + 16 * lane + 8) = (v4u){wa[4], wa[5], wa[6], wa[7]};
        *(v4u*)(row + C_I + 16 * lane) = (v4u){wb[0], wb[1], wb[2], wb[3]}; *(v4u*)(row + C_I + 16 * lane + 8) = (v4u){wb[4], wb[5], wb[6], wb[7]};
    }
#undef NORM_LOAD
}
typedef short v4s __attribute__((ext_vector_type(4)));
constexpr size_t WS_DECH = 7 * MiB, WS_DTF = WS_END, WS_ACF = WS_DTF + (size_t)T * 16 * 4, WS_TAIL = WS_ACF + (size_t)T * 16 * 4, WS_END2 = WS_TAIL + (size_t)256 * 3 * 2048 * 2;

__device__ __forceinline__ void unpack4(const v2u w, float (&f)[4]) { f[0] = bflo(w.x); f[1] = bfhi(w.x); f[2] = bflo(w.y); f[3] = bfhi(w.y); }

__device__ __forceinline__ void prep_chunk(int ci, bf16* PROJ, const float* const* in, float* out, unsigned char* ws, int tid, int wave, int lane, bool dry) {
    const int b = ci >> 5, c = ci & 31; const size_t r0 = (size_t)b * SEQ + (size_t)c * 64;
    float* DTF = (float*)(ws + WS_DTF); float* ACF = (float*)(ws + WS_ACF); float* DECH = (float*)(ws + WS_DECH); bf16* TAIL = (bf16*)(ws + WS_TAIL);
#pragma unroll
    for (int q = 0; q < 2; ++q) { const int h = 2 * wave + q;
        const float xr = bf2f(PROJ[(r0 + lane) * NIN + C_DT + h]) + in[13][h]; const float dt = xr > 20.f ? xr : log1pf(__expf(xr));
        float v = -__expf(in[14][h]) * dt;
#pragma unroll
        for (int o = 1; o < 64; o <<= 1) { const float tt = __shfl_up(v, o); if (lane >= o) v += tt; }
        if (!dry) { DTF[(r0 + lane) * 16 + h] = dt; ACF[(r0 + lane) * 16 + h] = v; } }
    { const int ch4 = 4 * tid; bf16* colp = PROJ + r0 * NIN + C_XM + ch4;
        const f32x4 cw0 = *(const f32x4*)(in[11] + ch4), cw1 = *(const f32x4*)(in[11] + 2048 + ch4), cw2 = *(const f32x4*)(in[11] + 4096 + ch4), cw3 = *(const f32x4*)(in[11] + 6144 + ch4), cbv = *(const f32x4*)(in[12] + ch4);
        float w0[4] = {0.f, 0.f, 0.f, 0.f}, w1[4] = {0.f, 0.f, 0.f, 0.f}, w2[4] = {0.f, 0.f, 0.f, 0.f};
        if (c > 0) { unpack4(*(const v2u*)(colp - 3 * (size_t)NIN), w0); unpack4(*(const v2u*)(colp - 2 * (size_t)NIN), w1); unpack4(*(const v2u*)(colp - (size_t)NIN), w2); }
#pragma unroll 1
        for (int tb = 0; tb < 64; tb += 16) {
            v2u raw[16];
#pragma unroll
            for (int i = 0; i < 16; ++i) raw[i] = *(const v2u*)(colp + (size_t)(tb + i) * NIN);
#pragma unroll
            for (int i = 0; i < 16; ++i) { float x[4]; unpack4(raw[i], x); float o[4];
#pragma unroll
                for (int j = 0; j < 4; ++j) { o[j] = siluf(cbv[j] + cw0[j] * w0[j] + cw1[j] * w1[j] + cw2[j] * w2[j] + cw3[j] * x[j]); w0[j] = w1[j]; w1[j] = w2[j]; w2[j] = x[j]; }
                const v2u ow = (v2u){pk2(o[0], o[1]), pk2(o[2], o[3])}; const int t = tb + i;
                if (dry) continue;
                if (t < 61) *(v2u*)(colp + (size_t)t * NIN) = ow; else *(v2u*)(TAIL + ((size_t)ci * 3 + (t - 61)) * 2048 + ch4) = ow;
                if (c == 31 && t >= 61) *(f32x4*)(out + O_CONVP + ((size_t)b * 3 + (t - 61)) * 2048 + ch4) = (f32x4){x[0], x[1], x[2], x[3]}; }
        } }
    { const int k2 = 2 * tid; bf16* qp = PROJ + r0 * NIN + C_Q + k2; bf16* fp = PROJ + r0 * NIN + C_F + k2;
        const float lb0 = sigm(in[18][k2] - in[18][1024 + k2]), lb1 = sigm(in[18][k2 + 1] - in[18][1024 + k2 + 1]);
        float run0 = 0.f, run1 = 0.f;
#pragma unroll 1
        for (int tb = 0; tb < 64; tb += 16) {
            unsigned qr[16], fr_[16];
#pragma unroll
            for (int i = 0; i < 16; ++i) { qr[i] = *(const unsigned*)(qp + (size_t)(tb + i) * NIN); fr_[i] = *(const unsigned*)(fp + (size_t)(tb + i) * NIN); }
#pragma unroll
            for (int i = 0; i < 16; ++i) {
                const float s0 = sigm(bflo(fr_[i])), s1 = sigm(bfhi(fr_[i]));
                run0 += __logf(lb0 + (1.f - lb0) * s0); run1 += __logf(lb1 + (1.f - lb1) * s1);
                const float e0 = __expf(run0), e1 = __expf(run1);
                if (dry) continue;
                *(unsigned*)(qp + (size_t)(tb + i) * NIN) = pk2(bflo(qr[i]) * e0, bfhi(qr[i]) * e1);
                *(unsigned*)(fp + (size_t)(tb + i) * NIN) = pk2((1.f - lb0) * (1.f - s0) * __builtin_amdgcn_rcpf(e0), (1.f - lb1) * (1.f - s1) * __builtin_amdgcn_rcpf(e1)); }
        }
        if (!dry) { DECH[(size_t)ci * 1024 + k2] = __expf(run0); DECH[(size_t)ci * 1024 + k2 + 1] = __expf(run1); } }
}

constexpr int S_QC = 136, S_X = 40, S_WT = 72;
constexpr int G_QC = 0, G_KB = 17408, G_X = 34816, G_XS = 39936, G_WT = 45056, G_ST = 54272, G_FA = 62976, GRP_BYTES = 64000;
static_assert(2 * GRP_BYTES <= RING_BYTES, "scan LDS map");
__device__ __forceinline__ bf16x8 row_frag(const LAS bf16* img, int stride, int row, int k) { return *(const LAS bf16x8*)(img + row * stride + k); }
__device__ __forceinline__ bf16x8 tr_frag(const LAS bf16* img, int stride, int k0, int c0, int fr) {
    const LAS bf16* p = img + (k0 + (fr >> 2)) * stride + c0 + 4 * (fr & 3);
    const v4s lo = __builtin_amdgcn_ds_read_tr16_b64_v4i16((LAS v4s*)p), hi = __builtin_amdgcn_ds_read_tr16_b64_v4i16((LAS v4s*)(p + 4 * stride));
    return (bf16x8){lo[0], lo[1], lo[2], lo[3], hi[0], hi[1], hi[2], hi[3]};
}
constexpr unsigned pack2(const int (&a)[10]) { unsigned r = 0; for (int i = 0; i < 10; ++i) r |= (unsigned)a[i] << (2 * i); return r; }
constexpr int TB_LIST[10] = {3, 3, 2, 2, 3, 3, 2, 1, 0, 1}, SB_LIST[10] = {0, 2, 0, 2, 1, 3, 1, 1, 0, 0};
constexpr unsigned TB_PK = pack2(TB_LIST), SB_PK = pack2(SB_LIST);

__device__ __forceinline__ void scan_pair_job(int pj, bf16* PROJ, float* out, unsigned char* ws, const float* const* in, LAS unsigned char* lds, int tid0, int wave, bool dry) {
    const bool ssd = wave < 4; const int w4 = wave & 3;
    LAS unsigned char* gl = lds + (ssd ? 0 : GRP_BYTES);
    LAS bf16* QC = (LAS bf16*)(gl + G_QC); LAS bf16* KB = (LAS bf16*)(gl + G_KB); LAS bf16* XN = (LAS bf16*)(gl + G_X); LAS bf16* XS = (LAS bf16*)(gl + (ssd ? G_XS : G_X));
    LAS bf16* WT = (LAS bf16*)(gl + G_WT); LAS bf16* ST = (LAS bf16*)(gl + G_ST); LAS float* ACUM = (LAS float*)(gl + G_FA); LAS float* DT = ACUM + 64; LAS float* DEC = ACUM + 128;
    const float* DTF = (const float*)(ws + WS_DTF); const float* ACF = (const float*)(ws + WS_ACF); const float* DECH = (const float*)(ws + WS_DECH); const bf16* TAIL = (const bf16*)(ws + WS_TAIL);
    int b, colC, colB, colX, chC = 0, chB = 0, chX = 0, h = 0, half = 0, hd = 0, vq = 0;
    const int xcd = pj & 7, slot = pj >> 3;
    if (ssd) { const int grp = xcd + 8 * (slot >> 3), mem = slot & 7; b = grp >> 2; const int g = grp & 3; h = 4 * g + (mem >> 1); half = mem & 1;
        colX = C_XM + h * 64 + half * 32; colB = C_B + g * 128; colC = C_C + g * 128; chX = h * 64 + half * 32; chB = 1024 + g * 128; chC = 1536 + g * 128; }
    else { const int pair = xcd + 8 * (slot >> 2); vq = slot & 3; b = pair >> 3; hd = pair & 7; colB = C_F + hd * 128; colC = C_Q + hd * 128; colX = C_I + hd * 128 + vq * 32; }
    const size_t rowbase = (size_t)b * SEQ;
    const float Dh = ssd ? in[15][h] : 0.f;
    f32x4 st[4];
#pragma unroll
    for (int i = 0; i < 4; ++i) st[i] = (f32x4){0.f, 0.f, 0.f, 0.f};
    { const int gt = tid0 & 255; for (int i = gt; i < (G_FA - G_WT) / 4; i += 256) ((LAS unsigned*)(gl + G_WT))[i] = 0u; }
    v4u pfC[4], pfB[4], pfX; float fa = 0.f, fb = 0.f, fs_a = 0.f, fs_d = 0.f, fs_l = 0.f;
#define LOAD_REGS(c_) do { const int ci_ = b * 32 + (c_); const bf16* base_ = PROJ + (rowbase + (size_t)(c_) * 64) * NIN; \
        _Pragma("unroll") for (int j = 0; j < 4; ++j) { const int i = gt + 256 * j, row = i >> 4, c16 = i & 15; const bool tl = ssd && row >= 61; \
            const bf16* tb_ = TAIL + ((size_t)ci_ * 3 + (row - 61)) * 2048 + c16 * 8; \
            pfC[j] = *(const v4u*)(tl ? tb_ + chC : base_ + (size_t)row * NIN + colC + c16 * 8); pfB[j] = *(const v4u*)(tl ? tb_ + chB : base_ + (size_t)row * NIN + colB + c16 * 8); } \
        { const int row = gt >> 2, c16 = gt & 3; const bool tl = ssd && row >= 61; \
            pfX = *(const v4u*)(tl ? TAIL + ((size_t)ci_ * 3 + (row - 61)) * 2048 + chX + c16 * 8 : base_ + (size_t)row * NIN + colX + c16 * 8); } \
        { const size_t tb2_ = (rowbase + (size_t)(c_) * 64) * 16 + h; \
          const float* pa_ = ssd ? ACF + tb2_ + (size_t)(gt & 63) * 16 : DECH + (size_t)ci_ * 1024 + hd * 128 + (gt & 127); \
          const float* pb_ = ssd ? DTF + tb2_ + (size_t)(gt & 63) * 16 : pa_; \
          const float* pc_ = ssd ? ACF + tb2_ + (size_t)(gt >> 2) * 16 : pa_; const float* pd_ = ssd ? DTF + tb2_ + (size_t)(gt >> 2) * 16 : pa_; const float* pe_ = ssd ? ACF + tb2_ + 63 * 16 : pa_; \
          fa = *pa_; fb = *pb_; fs_a = *pc_; fs_d = *pd_; fs_l = *pe_; } } while (0)
#define STORE_REGS() do { \
        _Pragma("unroll") for (int j = 0; j < 4; ++j) { const int i = gt + 256 * j, row = i >> 4, c16 = i & 15; \
            *(LAS v4u*)(QC + row * S_QC + c16 * 8) = pfC[j]; *(LAS v4u*)(KB + row * S_QC + c16 * 8) = pfB[j]; } \
        *(LAS v4u*)(XN + (gt >> 2) * S_X + (gt & 3) * 8) = pfX; \
        if (ssd) { const float sc_ = __expf(fs_l - fs_a) * fs_d; \
            *(LAS v4u*)(XS + (gt >> 2) * S_X + (gt & 3) * 8) = (v4u){pk2(bflo(pfX.x) * sc_, bfhi(pfX.x) * sc_), pk2(bflo(pfX.y) * sc_, bfhi(pfX.y) * sc_), pk2(bflo(pfX.z) * sc_, bfhi(pfX.z) * sc_), pk2(bflo(pfX.w) * sc_, bfhi(pfX.w) * sc_)}; } \
        if (ssd) { if (gt < 64) { ACUM[gt] = fa; DT[gt] = fb; } } else if (gt < 128) DEC[gt] = fa; } while (0)
    { const int gt = tid0 & 255; LOAD_REGS(0); }
    for (int c = 0; c < SEQ / 64; ++c) {
        int tid_v = tid0; asm volatile("" : "+v"(tid_v));
        const int gt = tid_v & 255, lane = tid_v & 63, fr = lane & 15, fq = lane >> 4;
        STORE_REGS();
        __syncthreads();
        { const int cn = (c + 1 < SEQ / 64) ? c + 1 : c; LOAD_REGS(cn); }
        const size_t t0 = rowbase + (size_t)c * 64;
        const float alast = ssd ? ACUM[63] : 0.f;
        for (int idx = w4; idx < 10; idx += 4) { const int tb = (TB_PK >> (2 * idx)) & 3, sb = (SB_PK >> (2 * idx)) & 3; const int t = 16 * tb + fr, s0 = 16 * sb + 4 * fq;
            f32x4 g = (f32x4){0.f, 0.f, 0.f, 0.f};
#pragma unroll
            for (int k0 = 0; k0 < 128; k0 += 32) g = __builtin_amdgcn_mfma_f32_16x16x32_bf16(row_frag(KB, S_QC, 16 * sb + fr, k0 + 8 * fq), row_frag(QC, S_QC, t, k0 + 8 * fq), g, 0, 0, 0);
            float w[4];
            if (ssd) { const float at = ACUM[t]; const f32x4 as = *(const LAS f32x4*)(ACUM + s0), ds = *(const LAS f32x4*)(DT + s0);
#pragma unroll
                for (int j = 0; j < 4; ++j) w[j] = (s0 + j <= t) ? g[j] * __expf(fminf(at - as[j], 0.f)) * ds[j] : 0.f;
            } else {
#pragma unroll
                for (int j = 0; j < 4; ++j) w[j] = (s0 + j <= t) ? g[j] : 0.f;
            }
            *(LAS v2u*)(WT + t * S_WT + s0) = (v2u){pk2(w[0], w[1]), pk2(w[2], w[3])}; }
        __syncthreads();
        { const int t = 16 * w4 + fr; const float rs = ssd ? __expf(ACUM[t]) : 1.f;
            bf16x8 qa[4];
#pragma unroll
            for (int ks = 0; ks < 4; ++ks) qa[ks] = row_frag(QC, S_QC, t, 32 * ks + 8 * fq);
            const bf16x8 wa0 = row_frag(WT, S_WT, t, 8 * fq), wa1 = row_frag(WT, S_WT, t, 32 + 8 * fq);
#pragma unroll
            for (int pb = 0; pb < 2; ++pb) {
                f32x4 y = (f32x4){0.f, 0.f, 0.f, 0.f};
#pragma unroll
                for (int ks = 0; ks < 4; ++ks) y = __builtin_amdgcn_mfma_f32_16x16x32_bf16(row_frag(ST, S_QC, 16 * pb + fr, 32 * ks + 8 * fq), qa[ks], y, 0, 0, 0);
                y = y * rs;
                y = __builtin_amdgcn_mfma_f32_16x16x32_bf16(tr_frag(XN, S_X, 8 * fq, 16 * pb, fr), wa0, y, 0, 0, 0);
                if (w4 >= 2) y = __builtin_amdgcn_mfma_f32_16x16x32_bf16(tr_frag(XN, S_X, 32 + 8 * fq, 16 * pb, fr), wa1, y, 0, 0, 0);
                const int p0 = 16 * pb + 4 * fq;
                if (ssd) { const v2u xw = *(const LAS v2u*)(XN + t * S_X + p0); y[0] += Dh * bflo(xw.x); y[1] += Dh * bfhi(xw.x); y[2] += Dh * bflo(xw.y); y[3] += Dh * bfhi(xw.y); }
                if (!dry) *(v2u*)(PROJ + (t0 + t) * NIN + colX + p0) = (v2u){pk2(y[0], y[1]), pk2(y[2], y[3])};
            } }
        { const float dsc = ssd ? __expf(alast) : 1.f;
#pragma unroll
            for (int q = 0; q < 2; ++q) { const int n0 = 16 * (2 * w4 + q);
                const bf16x8 kb0 = tr_frag(KB, S_QC, 8 * fq, n0, fr), kb1 = tr_frag(KB, S_QC, 32 + 8 * fq, n0, fr);
                f32x4 dv = (f32x4){1.f, 1.f, 1.f, 1.f}; if (!ssd) dv = *(const LAS f32x4*)(DEC + n0 + 4 * fq);
#pragma unroll
                for (int pb = 0; pb < 2; ++pb) { f32x4 a = st[2 * q + pb] * dsc;
                    a = __builtin_amdgcn_mfma_f32_16x16x32_bf16(kb0, tr_frag(XS, S_X, 8 * fq, 16 * pb, fr), a, 0, 0, 0);
                    a = __builtin_amdgcn_mfma_f32_16x16x32_bf16(kb1, tr_frag(XS, S_X, 32 + 8 * fq, 16 * pb, fr), a, 0, 0, 0);
                    st[2 * q + pb] = a * dv; } } }
        __syncthreads();
#pragma unroll
        for (int q = 0; q < 2; ++q)
#pragma unroll
            for (int pb = 0; pb < 2; ++pb) *(LAS v2u*)(ST + (16 * pb + fr) * S_QC + 16 * (2 * w4 + q) + 4 * fq) = (v2u){pk2(st[2 * q + pb][0], st[2 * q + pb][1]), pk2(st[2 * q + pb][2], st[2 * q + pb][3])};
    }
#undef LOAD_REGS
#undef STORE_REGS
    if (!dry) { const int lane = tid0 & 63, fr = lane & 15, fq = lane >> 4;
#pragma unroll
        for (int q = 0; q < 2; ++q)
#pragma unroll
            for (int pb = 0; pb < 2; ++pb) { const int n0 = 16 * (2 * w4 + q) + 4 * fq, p = 16 * pb + fr; const f32x4 v = st[2 * q + pb];
                if (ssd) *(f32x4*)(out + O_SSMP + (((size_t)(b * 16 + h) * 64 + half * 32 + p) * 128 + n0)) = v;
                else {
#pragma unroll
                    for (int j = 0; j < 4; ++j) out[O_HGP + (((size_t)(b * 8 + hd) * 128 + n0 + j) * 128 + vq * 32 + p)] = v[j]; } } }
    __syncthreads();
}
__device__ __forceinline__ void ssd_sample_jobs(int bx, int G, bf16* PROJ, const float* const* in, float* out, LAS unsigned char* lds, int tid, bool dry) {
    const int p4 = tid >> 5, f4 = tid & 31;
    f32x4 nx[4];
    { const int job = bx < DB * 16 ? bx : 0; const size_t sbase = ((size_t)job * 64 + p4) * 128 + 4 * f4;
#pragma unroll
        for (int i = 0; i < 4; ++i) nx[i] = *(const f32x4*)(in[3] + sbase + (size_t)i * 16 * 128); }
    int it = 0;
    for (int job = bx; job < DB * 16; job += G, ++it) {
        const int sb = job >> 4, h = job & 15, g = h >> 2; const size_t row0 = (size_t)TP + 4 * sb;
        LAS float* SX = (LAS float*)(lds + (it & 1) * 8192); LAS float* SBm = SX + 4 * 64; LAS float* SCm = SBm + 4 * 128; LAS float* SDT = SCm + 4 * 128;
        f32x4 hv[4];
#pragma unroll
        for (int i = 0; i < 4; ++i) hv[i] = nx[i];
        const size_t sbase = ((size_t)job * 64 + p4) * 128 + 4 * f4;
        { const int jn = (job + G < DB * 16) ? job + G : job; const size_t nb = ((size_t)jn * 64 + p4) * 128 + 4 * f4;
#pragma unroll
            for (int i = 0; i < 4; ++i) nx[i] = *(const f32x4*)(in[3] + nb + (size_t)i * 16 * 128); }
        if (tid < 320) {
            int col, cc; LAS float* dst; int dstride, di;
            if (tid < 64) { col = C_XM + h * 64 + tid; cc = h * 64 + tid; dst = SX; dstride = 64; di = tid; }
            else if (tid < 192) { col = C_B + g * 128 + (tid - 64); cc = 1024 + g * 128 + (tid - 64); dst = SBm; dstride = 128; di = tid - 64; }
            else { col = C_C + g * 128 + (tid - 192); cc = 1536 + g * 128 + (tid - 192); dst = SCm; dstride = 128; di = tid - 192; }
            float u[7];
#pragma unroll
            for (int j = 0; j < 3; ++j) u[j] = in[2][((size_t)sb * 3 + j) * 2048 + cc];
#pragma unroll
            for (int j = 0; j < 4; ++j) u[3 + j] = bf2f(PROJ[(row0 + j) * NIN + col]);
            const float w0 = in[11][cc], w1 = in[11][2048 + cc], w2 = in[11][4096 + cc], w3 = in[11][6144 + cc], bb = in[12][cc];
#pragma unroll
            for (int t = 0; t < 4; ++t) dst[t * dstride + di] = siluf(bb + w0 * u[t] + w1 * u[t + 1] + w2 * u[t + 2] + w3 * u[t + 3]);
            if (!dry && (tid < 64 || (h & 3) == 0)) {
#pragma unroll
                for (int j = 0; j < 3; ++j) out[O_CONVS + ((size_t)sb * 3 + j) * 2048 + cc] = u[4 + j];
            }
        } else if (tid < 324) { const int t = tid - 320; const float xr = bf2f(PROJ[(row0 + t) * NIN + C_DT + h]) + in[13][h]; SDT[t] = xr > 20.f ? xr : log1pf(__expf(xr)); }
        __syncthreads();
        const float a_neg = -__expf(in[14][h]), Dh = in[15][h];
#pragma unroll
        for (int t = 0; t < 4; ++t) {
            const float dt = SDT[t], dec = __expf(dt * a_neg);
            const f32x4 bv = *(const LAS f32x4*)(SBm + t * 128 + 4 * f4), cv = *(const LAS f32x4*)(SCm + t * 128 + 4 * f4);
#pragma unroll
            for (int i = 0; i < 4; ++i) { const int p = p4 + 16 * i; const float xv = SX[t * 64 + p], xb = dt * xv;
                hv[i] = hv[i] * dec + bv * xb;
                float part = (hv[i][0] * cv[0] + hv[i][1] * cv[1]) + (hv[i][2] * cv[2] + hv[i][3] * cv[3]);
                part += __shfl_xor(part, 1); part += __shfl_xor(part, 2); part += __shfl_xor(part, 4); part += __shfl_xor(part, 8); part += __shfl_xor(part, 16);
                if (f4 == 0 && !dry) PROJ[(row0 + t) * NIN + C_XM + h * 64 + p] = (bf16)f2bf(part + Dh * xv); }
        }
        if (!dry)
#pragma unroll
        for (int i = 0; i < 4; ++i) *(f32x4*)(out + O_SSMS + sbase + (size_t)i * 16 * 128) = hv[i];
    }
    __syncthreads();
}
__device__ __forceinline__ void hgrn_sample_jobs(int bx, int G, bf16* PROJ, const float* const* in, float* out, LAS unsigned char* lds, int tid, bool dry) {
    const int v4 = tid & 31, kq = tid >> 5;
    f32x4 nx[8];
    { const int job = bx < DB * 8 ? bx : 0; const size_t sbase = ((size_t)job * 128 + 8 * kq) * 128 + 4 * v4;
#pragma unroll
        for (int i = 0; i < 8; ++i) nx[i] = *(const f32x4*)(in[4] + sbase + (size_t)i * 128); }
    int it = 0;
    for (int job = bx; job < DB * 8; job += G, ++it) {
        const int sb = job >> 3, hd = job & 7; const size_t row0 = (size_t)TP + 4 * sb;
        LAS float* SQ = (LAS float*)(lds + (it & 1) * 8192); LAS float* SF = SQ + 512; LAS float* SK = SF + 512; LAS float* SV = SK + 512;
        LAS float* PP = (LAS float*)(lds + 16384 + (it & 1) * 32768);
        f32x4 s[8];
#pragma unroll
        for (int i = 0; i < 8; ++i) s[i] = nx[i];
        const size_t sbase = ((size_t)job * 128 + 8 * kq) * 128 + 4 * v4;
        { const int jn = (job + G < DB * 8) ? job + G : job; const size_t nb = ((size_t)jn * 128 + 8 * kq) * 128 + 4 * v4;
#pragma unroll
            for (int i = 0; i < 8; ++i) nx[i] = *(const f32x4*)(in[4] + nb + (size_t)i * 128); }
        if (tid < 128) { const int k = tid; const float lb = sigm(in[18][hd * 128 + k] - in[18][1024 + hd * 128 + k]);
#pragma unroll
            for (int t = 0; t < 4; ++t) { const float frw = bf2f(PROJ[(row0 + t) * NIN + C_F + hd * 128 + k]), q = bf2f(PROJ[(row0 + t) * NIN + C_Q + hd * 128 + k]);
                const float sg = sigm(frw); SF[t * 128 + k] = lb + (1.f - lb) * sg; SK[t * 128 + k] = (1.f - lb) * (1.f - sg); SQ[t * 128 + k] = q; } }
        else if (tid < 256) { const int v = tid - 128;
#pragma unroll
            for (int t = 0; t < 4; ++t) SV[t * 128 + v] = bf2f(PROJ[(row0 + t) * NIN + C_I + hd * 128 + v]); }
        __syncthreads();
#pragma unroll
        for (int t = 0; t < 4; ++t) { const f32x4 vv = *(const LAS f32x4*)(SV + t * 128 + 4 * v4); f32x4 part = (f32x4){0.f, 0.f, 0.f, 0.f};
#pragma unroll
            for (int i = 0; i < 8; ++i) { const float f = SF[t * 128 + 8 * kq + i], kk = SK[t * 128 + 8 * kq + i], q = SQ[t * 128 + 8 * kq + i];
                s[i] = s[i] * f + vv * kk; part += s[i] * q; }
            *(LAS f32x4*)(PP + (t * 16 + kq) * 128 + 4 * v4) = part; }
        if (!dry)
#pragma unroll
        for (int i = 0; i < 8; ++i) *(f32x4*)(out + O_HGS + sbase + (size_t)i * 128) = s[i];
        __syncthreads();
        { const int t = tid >> 7, v = tid & 127; float o = 0.f;
#pragma unroll
            for (int q = 0; q < 16; ++q) o += PP[(t * 16 + q) * 128 + v];
            if (!dry) PROJ[(row0 + t) * NIN + C_I + hd * 128 + v] = (bf16)f2bf(o); }
    }
    __syncthreads();
}
#ifndef MK_N_LAUNCHES
#define MK_N_LAUNCHES 1
#endif
constexpr int NPH = 15;
struct Args { const float* in[29]; float* out; unsigned char* ws; int ph_lo, ph_hi; };
static_assert(sizeof(Args) == 29 * 8 + 8 + 8 + 8, "Args has no padding");

__global__ void __launch_bounds__(NTHR, 2) mk_fwd(Args args) {
    extern __shared__ __attribute__((aligned(16))) unsigned char lds_raw[];
    LAS unsigned char* lds = (LAS unsigned char*)lds_raw;
    volatile LAS unsigned* MISC = (volatile LAS unsigned*)(lds + MISC_OFF);
    const int tid = threadIdx.x, lane = tid & 63, wave = __builtin_amdgcn_readfirstlane(tid >> 6);
    const int G = gridDim.x; const int bx = blockIdx.x; const int vcu = (G % 8 == 0) ? (bx % 8) * (G / 8) + bx / 8 : bx;
    const float* const* in = args.in; float* out = args.out; unsigned char* outb = (unsigned char*)args.out; unsigned char* ws = args.ws;
    for (int u = tid; u < (LDS_BYTES - LDSCTL_OFF) / 4; u += NTHR) ((LAS unsigned*)(lds + LDSCTL_OFF))[u] = 0u;
    __syncthreads();
    const int lo = args.ph_lo, hi = args.ph_hi;
    XcdBarrier bar; bar.bar = (unsigned*)(ws + WS_CTL) + CW_BAR; bar.x = 0; bar.st = nullptr;
    if (hi - lo > 1) bar = xcd_barrier_post((unsigned*)(ws + WS_CTL) + CW_BAR, MISC + 8);
#ifndef PH_MASK
#define PH_MASK 0x7fff
#endif
#define IN(k) ((((PH_MASK) >> (k)) & 1) && lo <= (k) && (k) < hi)
#ifndef DUP_MASK
#define DUP_MASK 0
#endif
#define DUPN(k) ((((DUP_MASK) >> (k)) & 1) ? 2 : 1)
#ifndef TIME_PHASE
#define TIME_PHASE -1
#endif
#ifndef TIME_MULT
#define TIME_MULT 4
#endif
    unsigned long long tp_a = (TIME_PHASE == 0) ? __builtin_amdgcn_s_memrealtime() : 0ull, tp_d = 0;
#define SEAM(k) do { if (IN(k) && IN((k) + 1)) xcd_barrier(bar); \
        if (TIME_PHASE >= 0) { if ((k) + 1 == TIME_PHASE) tp_a = __builtin_amdgcn_s_memrealtime(); if ((k) == TIME_PHASE) tp_d = __builtin_amdgcn_s_memrealtime() - tp_a; } } while (0)
    bf16* PROJ = (bf16*)(ws + WS_PROJ);
    float* Y = out + O_Y;

#define REPS(k) _Pragma("unroll 1") for (int rep_ = DUPN(k) - 1; rep_ >= 0; --rep_)
#define DRY ((rep_ > 0) && (args.ph_hi != 12345))
    if (IN(0)) REPS(0) { p0_prologue(in, outb, ws, lds, vcu, G, wave, lane); } SEAM(0);
    if (IN(1)) REPS(1) { pg8::Gemm g{(const bf16*)(outb + OS_XB), (const bf16*)(outb + OS_W1A), T, NGU, D, D}; pg8::StaticOrder S; S.init(T, NGU, G, bx);
        EpiSwiGLU E{(bf16*)(ws + WS_H)}; pg8::gemm_phase<EpiSwiGLU, pg8::StaticOrder, true, true>(lds, g, S, E); } SEAM(1);
    if (IN(2)) REPS(2) { pg8::Gemm g{(const bf16*)(ws + WS_H), (const bf16*)(outb + OS_W1D), TP, D, FF, FF}; pg8::StaticOrder S; S.init(TP, D, G, bx);
        EpiResid E{in[0], in[1], Y, 0.5f, false}; pg8::gemm_phase<EpiResid, pg8::StaticOrder, true, true>(lds, g, S, E);
        small_gemm<11>((const bf16*)(ws + WS_H), FF, (const bf16*)(outb + OS_W1D), FF, E, lds, bx, G, tid, wave, lane); } SEAM(2);
    if (IN(3)) REPS(3) { ln_phase(Y, (bf16*)(outb + OS_XB), in[8], in[9], vcu, G, wave, lane, DRY); } SEAM(3);
    if (IN(4)) REPS(4) { pg8::Gemm g{(const bf16*)(outb + OS_XB), (const bf16*)(outb + OS_WIN), T, NINP, D, D}; pg8::StaticOrder S; S.init(T, NINP, G, bx);
        EpiBf16N E{PROJ, NIN, NIN}; pg8::gemm_phase<EpiBf16N, pg8::StaticOrder, true, true>(lds, g, S, E); } SEAM(4);
    if (IN(5)) REPS(5) { for (int ci = bx; ci < 256; ci += G) prep_chunk(ci, PROJ, in, out, ws, tid, wave, lane, DRY);
        ssd_sample_jobs(bx, G, PROJ, in, out, lds, tid, DRY); hgrn_sample_jobs(bx, G, PROJ, in, out, lds, tid, DRY); } SEAM(5);
    if (IN(6)) REPS(6) {
        const bool dry = DRY;
#ifndef DRY_SCAN_MASK
#define DRY_SCAN_MASK 7
#endif
        const int smask = (rep_ > 0) ? (DRY_SCAN_MASK) : 7;
        if (smask & 1) for (int pj = bx; pj < 256; pj += G) scan_pair_job(pj, PROJ, out, ws, in, lds, tid, wave, dry);
    } SEAM(6);
    if (IN(7)) REPS(7) { norm_phase(PROJ, in[16], in[19], vcu, G, wave, lane, DRY); } SEAM(7);
    if (IN(8)) REPS(8) { pg8::Gemm g{PROJ + C_XM, (const bf16*)(ws + WS_WMO), TP, D, D, NIN}; pg8::StaticOrder S; S.init(TP, D, G, bx);
        EpiGate<false> E{PROJ + C_GM, PROJ + C_Z, false}; pg8::gemm_phase<EpiGate<false>, pg8::StaticOrder, true, true>(lds, g, S, E);
        small_gemm<4>(PROJ + C_XM, NIN, (const bf16*)(ws + WS_WMO), D, E, lds, bx, G, tid, wave, lane); } SEAM(8);
    if (IN(9)) REPS(9) { pg8::Gemm g{PROJ + C_I, (const bf16*)(ws + WS_WHO), TP, D, D, NIN}; pg8::StaticOrder S; S.init(TP, D, G, bx);
        EpiGate<true> E{PROJ + C_GH, PROJ + C_Z, DRY}; pg8::gemm_phase<EpiGate<true>, pg8::StaticOrder, true, true>(lds, g, S, E);
        small_gemm<4>(PROJ + C_I, NIN, (const bf16*)(ws + WS_WHO), D, E, lds, bx, G, tid, wave, lane); } SEAM(9);
    if (IN(10)) REPS(10) { pg8::Gemm g{PROJ + C_Z, (const bf16*)(ws + WS_WO), TP, D, D, NIN}; pg8::StaticOrder S; S.init(TP, D, G, bx);
        EpiResid E{Y, nullptr, Y, 1.0f, DRY}; pg8::gemm_phase<EpiResid, pg8::StaticOrder, true, true>(lds, g, S, E);
        small_gemm<4>(PROJ + C_Z, NIN, (const bf16*)(ws + WS_WO), D, E, lds, bx, G, tid, wave, lane); } SEAM(10);
    if (IN(11)) REPS(11) { ln_phase(Y, (bf16*)(ws + WS_X2B), in[22], in[23], vcu, G, wave, lane, DRY);
        ffn_weight_items(in[24], in[25], in[26], (bf16*)(ws + WS_W2A), (bf16*)(ws + WS_W2D), (LAS float*)(lds + wave * 16384), vcu * NWAVES + wave, G * NWAVES, lane); } SEAM(11);
    if (IN(12)) REPS(12) { pg8::Gemm g{(const bf16*)(ws + WS_X2B), (const bf16*)(ws + WS_W2A), T, NGU, D, D}; pg8::StaticOrder S; S.init(T, NGU, G, bx);
        EpiSwiGLU E{(bf16*)(ws + WS_H)}; pg8::gemm_phase<EpiSwiGLU, pg8::StaticOrder, true, true>(lds, g, S, E); } SEAM(12);
    if (IN(13)) REPS(13) { pg8::Gemm g{(const bf16*)(ws + WS_H), (const bf16*)(ws + WS_W2D), TP, D, FF, FF}; pg8::StaticOrder S; S.init(TP, D, G, bx);
        EpiResid E{Y, nullptr, Y, 0.5f, DRY}; pg8::gemm_phase<EpiResid, pg8::StaticOrder, true, true>(lds, g, S, E);
        small_gemm<11>((const bf16*)(ws + WS_H), FF, (const bf16*)(ws + WS_W2D), FF, E, lds, bx, G, tid, wave, lane); } SEAM(13);
    if (IN(14)) REPS(14) { ln_phase(Y, nullptr, in[27], in[28], vcu, G, wave, lane, DRY); }
    if (TIME_PHASE >= 0 && bx == 0 && tid == 0) { const unsigned long long te = __builtin_amdgcn_s_memrealtime();
        while (__builtin_amdgcn_s_memrealtime() - te < (unsigned long long)TIME_MULT * tp_d) __builtin_amdgcn_s_sleep(8); }
#undef REPS
#undef DRY
#undef IN
#undef SEAM
}

extern "C" void kernel_launch(void* const* d_in, const int* in_sizes, int n_in, void* d_out, int out_size, void* d_ws, size_t ws_size, hipStream_t stream) {
    static int grid = 0;
    if (grid == 0) {
        if (n_in != 29 || out_size != (int)O_END || ws_size < WS_END2) { fprintf(stderr, "kernel_launch: unexpected shapes (n_in %d, out %d, ws %zu < %zu)\n", n_in, out_size, ws_size, (size_t)WS_END2); grid = -1; return; }
        int dev = 0, cus = 0, per_cu = 0;
        if (hipGetDevice(&dev) != hipSuccess || hipDeviceGetAttribute(&cus, hipDeviceAttributeMultiprocessorCount, dev) != hipSuccess) { grid = -1; return; }
        if (hipFuncSetAttribute((const void*)mk_fwd, hipFuncAttributeMaxDynamicSharedMemorySize, LDS_BYTES) != hipSuccess) { fprintf(stderr, "kernel_launch: hipFuncSetAttribute failed\n"); grid = -1; return; }
        if (hipOccupancyMaxActiveBlocksPerMultiprocessor(&per_cu, (const void*)mk_fwd, NTHR, LDS_BYTES) != hipSuccess || per_cu < 1) { fprintf(stderr, "kernel_launch: occupancy query says %d\n", per_cu); }
        (void)hipGetLastError();
        grid = cus;
    }
    if (grid < 0) return;
    (void)hipMemsetAsync((char*)d_ws + WS_CTL, 0, CTL_ZERO_BYTES, stream);
    Args a{};
    for (int i = 0; i < 29; ++i) a.in[i] = (const float*)d_in[i];
    a.out = (float*)d_out; a.ws = (unsigned char*)d_ws;
    if (MK_N_LAUNCHES == 1) { a.ph_lo = 0; a.ph_hi = NPH; hipLaunchKernelGGL(mk_fwd, dim3(grid), dim3(NTHR), LDS_BYTES, stream, a); }
    else { for (int p = 0; p < NPH; ++p) { a.ph_lo = p; a.ph_hi = p + 1; hipLaunchKernelGGL(mk_fwd, dim3(grid), dim3(NTHR), LDS_BYTES, stream, a); } }
}
```
